# Optimizing an MI355X kernel written in HIP

```python
import math
import jax, jax.numpy as jnp
from jax import lax
import numpy as np

D_MODEL = 2048
BATCH = 8
SEQ = 4096
DEPTH = 2

CHUNK = 64
QBLOCK = 128
N_MIXERS = 2
N_MLA_LAYERS = (DEPTH + 1) // 2
N_POOL_LAYERS = DEPTH // 2
N_HEADS = 16
Q_LORA = 512
KV_LORA = 512
NOPE_DIM = 128
ROPE_DIM = 64
V_DIM = 128
QK_HEAD = NOPE_DIM + ROPE_DIM
MLA_IN = Q_LORA + KV_LORA + ROPE_DIM
ROPE_THETA = 10000.0
POOL_WINDOWS = (2, 4, 8, 16)
N_POOL_GROUPS = len(POOL_WINDOWS)
POOL_GROUP_DIM = D_MODEL // N_POOL_GROUPS
N_GROUPS = 8
EXPERTS_PER_GROUP = 8
N_EXPERTS = N_GROUPS * EXPERTS_PER_GROUP
TOP_K_IN_GROUP = 2
D_EXPERT = 512
EXPERT_BLOCK = 256
EPS = 1e-6
NEG_INF = -1e30

kernel_name = "hybrid_mla_pool_hmoe_streaming"


def rms_norm(x, g):
    xf = x.astype(jnp.float32)
    y = xf * lax.rsqrt(jnp.mean(xf * xf, axis=-1, keepdims=True) + EPS)
    return (y * g.astype(jnp.float32)).astype(x.dtype)


def apply_rope(x, cos, sin):
    half = x.shape[-1] // 2
    xf = x.astype(jnp.float32)
    x1, x2 = xf[..., :half], xf[..., half:]
    return jnp.concatenate([x1 * cos - x2 * sin, x2 * cos + x1 * sin], axis=-1).astype(x.dtype)


def mla_mixer(h, positions, w_in, q_lat_norm, kv_lat_norm, w_q_up, w_kv_up, q_norm, k_norm, w_out):
    B, S, _ = h.shape
    c = h @ w_in
    cq = rms_norm(c[..., :Q_LORA], q_lat_norm)
    ckv = rms_norm(c[..., Q_LORA:Q_LORA + KV_LORA], kv_lat_norm)
    k_rope = c[..., Q_LORA + KV_LORA:]
    q = (cq @ w_q_up).reshape(B, S, N_HEADS, QK_HEAD)
    kv = (ckv @ w_kv_up).reshape(B, S, N_HEADS, NOPE_DIM + V_DIM)
    k_nope, v = kv[..., :NOPE_DIM], kv[..., NOPE_DIM:]
    k = jnp.concatenate(
        [k_nope, jnp.broadcast_to(k_rope[:, :, None, :], (B, S, N_HEADS, ROPE_DIM))], axis=-1)
    q = rms_norm(q, q_norm)
    k = rms_norm(k, k_norm)
    inv_freq = 1.0 / (ROPE_THETA ** (jnp.arange(0, ROPE_DIM, 2, dtype=jnp.float32) / ROPE_DIM))
    ang = positions.astype(jnp.float32)[..., None] * inv_freq
    cos = jnp.cos(ang)[:, :, None, :]
    sin = jnp.sin(ang)[:, :, None, :]
    q = jnp.concatenate([q[..., :NOPE_DIM], apply_rope(q[..., NOPE_DIM:], cos, sin)], axis=-1)
    k = jnp.concatenate([k[..., :NOPE_DIM], apply_rope(k[..., NOPE_DIM:], cos, sin)], axis=-1)
    scale = QK_HEAD ** -0.5
    outs = []
    for qb in range(S // QBLOCK):
        q0 = qb * QBLOCK
        kend = q0 + QBLOCK
        qblk = q[:, q0:kend]
        s = jnp.einsum('bqhd,bkhd->bhqk', qblk, k[:, :kend],
                       preferred_element_type=jnp.float32) * scale
        qi = q0 + jnp.arange(QBLOCK)
        kj = jnp.arange(kend)
        allowed = (kj[None, :] // CHUNK) <= (qi[:, None] // CHUNK)
        s = jnp.where(allowed[None, None], s, NEG_INF)
        p = jax.nn.softmax(s, axis=-1)
        outs.append(jnp.einsum('bhqk,bkhd->bqhd', p.astype(v.dtype), v[:, :kend]))
    o = jnp.concatenate(outs, axis=1).reshape(B, S, N_HEADS * V_DIM)
    return o @ w_out


def pool_mixer(h, w_in, w_group, scale, w_out):
    B, S, D = h.shape
    u = (h @ w_in).reshape(B, S, N_POOL_GROUPS, POOL_GROUP_DIM)
    uf = u.astype(jnp.float32)
    cs = jnp.concatenate(
        [jnp.zeros((B, 1, N_POOL_GROUPS, POOL_GROUP_DIM), jnp.float32), jnp.cumsum(uf, axis=1)],
        axis=1)
    t = jnp.arange(S)
    pooled = []
    for gi, w in enumerate(POOL_WINDOWS):
        lo = jnp.maximum(t + 1 - w, 0)
        cnt = jnp.minimum(t + 1, w).astype(jnp.float32)
        cg = cs[:, :, gi]
        pooled.append((cg[:, 1:] - cg[:, lo]) / cnt[None, :, None])
    p = jnp.stack(pooled, axis=2) - uf
    y = jnp.einsum('bsgc,gcd->bsgd', p.astype(h.dtype), w_group).reshape(B, S, D) * scale
    return y @ w_out


def hier_moe(h2, w_rg, b_rg, w_re, b_re, w_gate, w_up, w_down):
    T, D = h2.shape
    lg = jnp.einsum('td,dg->tg', h2, w_rg).astype(jnp.float32) + b_rg.astype(jnp.float32)
    pg = jax.nn.softmax(lg, axis=-1)
    g_sel = jnp.argmax(pg, axis=-1)
    p_sel = jnp.take_along_axis(pg, g_sel[:, None], axis=-1)[:, 0]
    le = jnp.einsum('td,de->te', h2, w_re).astype(jnp.float32).reshape(
        T, N_GROUPS, EXPERTS_PER_GROUP) + b_re.astype(jnp.float32)[None]
    le_sel = jnp.take_along_axis(le, g_sel[:, None, None], axis=1)[:, 0]
    qv, qi = lax.top_k(jax.nn.softmax(le_sel, axis=-1), TOP_K_IN_GROUP)
    qv = qv / jnp.sum(qv, axis=-1, keepdims=True)
    gate_w = p_sel[:, None] * qv
    eid = g_sel[:, None] * EXPERTS_PER_GROUP + qi
    A = T * TOP_K_IN_GROUP
    e_flat = eid.reshape(-1).astype(jnp.int32)
    tok_flat = jnp.repeat(jnp.arange(T, dtype=jnp.int32), TOP_K_IN_GROUP)
    w_flat = gate_w.reshape(-1)
    order = jnp.argsort(e_flat)
    e_s, tok_s, w_s = e_flat[order], tok_flat[order], w_flat[order]
    counts = jnp.bincount(e_flat, length=N_EXPERTS)
    starts = jnp.cumsum(counts) - counts
    padded = ((counts + EXPERT_BLOCK - 1) // EXPERT_BLOCK) * EXPERT_BLOCK
    pends = jnp.cumsum(padded)
    pstarts = pends - padded
    dest = pstarts[e_s] + (jnp.arange(A) - starts[e_s])
    P = A + N_EXPERTS * EXPERT_BLOCK
    n_blocks = P // EXPERT_BLOCK
    buf_tok = jnp.full((P,), T, jnp.int32).at[dest].set(tok_s)
    buf_w = jnp.zeros((P,), jnp.float32).at[dest].set(w_s)
    block_exp = jnp.minimum(
        jnp.searchsorted(pends, jnp.arange(n_blocks) * EXPERT_BLOCK, side='right'),
        N_EXPERTS - 1)
    h_pad = jnp.concatenate([h2, jnp.zeros((1, D), h2.dtype)], axis=0)

    def run_block(args):
        tok, e = args
        xb = h_pad[tok]
        return (jax.nn.silu(xb @ w_gate[e]) * (xb @ w_up[e])) @ w_down[e]

    yb = lax.map(run_block, (buf_tok.reshape(n_blocks, EXPERT_BLOCK), block_exp))
    y = yb.reshape(P, D) * buf_w[:, None].astype(yb.dtype)
    return jax.ops.segment_sum(y, buf_tok, num_segments=T + 1)[:T]


def setup_inputs(seed: int = 0) -> dict:
    key = jax.random.key(seed)
    ks = iter(jax.random.split(key, 32))
    f32 = jnp.float32

    def nrm(shape, fan_in):
        return jax.random.normal(next(ks), shape, f32) * (fan_in ** -0.5)

    def gain(shape):
        return 1.0 + 0.02 * jax.random.normal(next(ks), shape, f32)

    x = jax.random.normal(next(ks), (BATCH, SEQ, D_MODEL), f32)
    offs = jax.random.randint(next(ks), (BATCH, 1), 0, 16384, dtype=jnp.int32)
    positions = offs + jnp.arange(SEQ, dtype=jnp.int32)[None, :]
    na, npl = N_MLA_LAYERS, N_POOL_LAYERS
    return {
        "x": x,
        "positions": positions,
        "mix_norm": gain((DEPTH, D_MODEL)),
        "mla_w_in": nrm((na, D_MODEL, MLA_IN), D_MODEL),
        "mla_q_lat_norm": gain((na, Q_LORA)),
        "mla_kv_lat_norm": gain((na, KV_LORA)),
        "mla_w_q_up": nrm((na, Q_LORA, N_HEADS * QK_HEAD), Q_LORA),
        "mla_w_kv_up": nrm((na, KV_LORA, N_HEADS * (NOPE_DIM + V_DIM)), KV_LORA),
        "mla_q_norm": gain((na, QK_HEAD)),
        "mla_k_norm": gain((na, QK_HEAD)),
        "mla_w_out": nrm((na, N_HEADS * V_DIM, D_MODEL), N_HEADS * V_DIM),
        "pool_w_in": nrm((npl, D_MODEL, D_MODEL), D_MODEL),
        "pool_w_group": nrm((npl, N_POOL_GROUPS, POOL_GROUP_DIM, POOL_GROUP_DIM), POOL_GROUP_DIM),
        "pool_scale": gain((npl, D_MODEL)),
        "pool_w_out": nrm((npl, D_MODEL, D_MODEL), D_MODEL),
        "ffn_norm": gain((DEPTH, D_MODEL)),
        "moe_w_router_group": nrm((DEPTH, D_MODEL, N_GROUPS), D_MODEL),
        "moe_b_router_group": 0.01 * jax.random.normal(next(ks), (DEPTH, N_GROUPS), f32),
        "moe_w_router_expert": nrm((DEPTH, D_MODEL, N_EXPERTS), D_MODEL),
        "moe_b_router_expert": 0.01 * jax.random.normal(next(ks), (DEPTH, N_GROUPS, EXPERTS_PER_GROUP), f32),
        "moe_w_gate": nrm((DEPTH, N_EXPERTS, D_MODEL, D_EXPERT), D_MODEL),
        "moe_w_up": nrm((DEPTH, N_EXPERTS, D_MODEL, D_EXPERT), D_MODEL),
        "moe_w_down": nrm((DEPTH, N_EXPERTS, D_EXPERT, D_MODEL), D_EXPERT),
    }


def reference(x, positions, mix_norm, mla_w_in, mla_q_lat_norm, mla_kv_lat_norm, mla_w_q_up,
              mla_w_kv_up, mla_q_norm, mla_k_norm, mla_w_out, pool_w_in, pool_w_group, pool_scale,
              pool_w_out, ffn_norm, moe_w_router_group, moe_b_router_group, moe_w_router_expert,
              moe_b_router_expert, moe_w_gate, moe_w_up, moe_w_down):
    B, S, D = x.shape
    for layer in range(DEPTH):
        h = rms_norm(x, mix_norm[layer])
        if layer % N_MIXERS == 0:
            a = layer // N_MIXERS
            mixed = mla_mixer(h, positions, mla_w_in[a], mla_q_lat_norm[a], mla_kv_lat_norm[a],
                              mla_w_q_up[a], mla_w_kv_up[a], mla_q_norm[a], mla_k_norm[a],
                              mla_w_out[a])
        else:
            p = layer // N_MIXERS
            mixed = pool_mixer(h, pool_w_in[p], pool_w_group[p], pool_scale[p], pool_w_out[p])
        x = x + mixed
        h = rms_norm(x, ffn_norm[layer])
        y = hier_moe(h.reshape(B * S, D), moe_w_router_group[layer], moe_b_router_group[layer],
                     moe_w_router_expert[layer], moe_b_router_expert[layer], moe_w_gate[layer],
                     moe_w_up[layer], moe_w_down[layer])
        x = x + y.reshape(B, S, D)
    return x
```

```cpp
#include <hip/hip_runtime.h>
#include <cstdio>
#include <cstdint>

namespace pg8 {
#define PG8_LAS __attribute__((address_space(3)))
typedef unsigned short bf16_t;
typedef short bf16x8 __attribute__((ext_vector_type(8)));
typedef float f32x4 __attribute__((ext_vector_type(4)));
typedef unsigned u32x4 __attribute__((ext_vector_type(4)));
typedef int i32x4 __attribute__((ext_vector_type(4)));
template <bool I8> struct AccT { typedef f32x4 type; };
template <> struct AccT<true> { typedef i32x4 type; };
constexpr int BM = 256, BK = 64, HALF = 128, HTB = HALF * BK * 2  , STAGE_BYTES = 8 * HTB, NXCD = 8, WGM = 8;

__host__ __device__ __forceinline__ int lds_byte(int r, int c) { const int st = (r >> 4) * 2 + (c >> 5), rr = r & 15, cc = c & 31, ob = rr * 64 + cc * 2; return st * 1024 + (ob ^ (((ob >> 9) & 1) << 5)); }
__host__ __device__ __forceinline__ void stage_rc(int b, int& R, int& C) { const int st = b / 1024, sb = b % 1024, swz = sb ^ (((sb >> 9) & 1) << 5); R = (st >> 1) * 16 + swz / 64; C = (st & 1) * 32 + (swz % 64) / 2; }
__host__ __device__ __forceinline__ int perm32(int rho) { const int n = rho >> 4, i = rho & 15; return 8 * (i >> 2) + 4 * n + (i & 3); }

struct Unit { int pm, pn, aux; };
struct Gemm { const bf16_t* A; const bf16_t* Bt; int K; int lda; int ldb; const int* rowtab; };

struct StaticOrder {
    int nM, nN, nwg, G, c;
    __device__ void init(int M, int N, int G_, int c_) { nM = M / BM; nN = N / BM; nwg = nM * nN; G = G_; c = c_; }
    __device__ bool next(int i, Unit& u) const {
        const long L = (long)i * G + c; if (L >= nwg) return false;
        int wgid = (int)L; { const int q = nwg / NXCD, r = nwg % NXCD, xcd = wgid % NXCD, off = wgid / NXCD; wgid = (xcd < r ? xcd * (q + 1) : r * (q + 1) + (xcd - r) * q) + off; }
        const int nig = WGM * nN, gid = wgid / nig, fm = gid * WGM, gsz = (nM - fm) < WGM ? (nM - fm) : WGM;
        u.pm = fm + ((wgid % nig) % gsz); u.pn = (wgid % nig) / gsz; u.aux = 0; return true;
    }
    __device__ __forceinline__ const char* abase(const Gemm& g, const Unit& u) const { return (const char*)g.A + (size_t)u.pm * BM * g.lda * 2; }
    __device__ __forceinline__ const char* bbase(const Gemm& g, const Unit& u) const { return (const char*)g.Bt + (size_t)u.pn * BM * g.ldb * 2; }
};

__device__ __forceinline__ unsigned cvt_pk_bf16(float lo, float hi) { unsigned r; asm volatile("v_cvt_pk_bf16_f32 %0, %1, %2" : "=v"(r) : "v"(lo), "v"(hi)); return r; }

__device__ __forceinline__ float lo16(unsigned w) { return __uint_as_float(w << 16); }
__device__ __forceinline__ float hi16(unsigned w) { return __uint_as_float(w & 0xffff0000u); }
__device__ __forceinline__ unsigned q8x4(float a, float b, float c, float d) {
    unsigned w = __builtin_amdgcn_cvt_pk_u8_f32((a + 128.f), 0, 0u); w = __builtin_amdgcn_cvt_pk_u8_f32((b + 128.f), 1, w);
    w = __builtin_amdgcn_cvt_pk_u8_f32((c + 128.f), 2, w); w = __builtin_amdgcn_cvt_pk_u8_f32((d + 128.f), 3, w); return w ^ 0x80808080u; }
template <class A> __device__ __forceinline__ A pin(const A& v) { A t = v; asm volatile("" : "+v"(t) :: "memory"); return t; }
typedef unsigned u32x2v __attribute__((ext_vector_type(2)));
__device__ __forceinline__ void store16_pair(unsigned char* pa, unsigned char* pb, u32x2v xa, u32x2v xb, int fq) {
    auto r0 = __builtin_amdgcn_permlane16_swap(xa.x, xb.x, false, false);
    auto r1 = __builtin_amdgcn_permlane16_swap(xa.y, xb.y, false, false);
    u32x4 w; w.x = r0[0]; w.y = r1[0]; w.z = r0[1]; w.w = r1[1];
    *(u32x4*)((fq & 1) ? pb - 8 : pa) = w;
}
template <class F> __device__ __forceinline__ void rows8(int fq, F f, float (&out)[8]) {
    const unsigned v0 = __float_as_uint(f(2 * fq)), v1 = __float_as_uint(f(2 * fq + 1));
    auto p0 = __builtin_amdgcn_permlane16_swap(v0, v0, false, false); auto p1 = __builtin_amdgcn_permlane16_swap(v1, v1, false, false);
    const unsigned w[4] = {p0[0], p1[0], p0[1], p1[1]};
#pragma unroll
    for (int k = 0; k < 4; ++k) { auto q = __builtin_amdgcn_permlane32_swap(w[k], w[k], false, false); out[k] = __uint_as_float(q[0]); out[4 + k] = __uint_as_float(q[1]); }
}
__device__ __forceinline__ f32x4 tof(const f32x4& v) { return v; }
__device__ __forceinline__ f32x4 tof(const i32x4& v) { return (f32x4){(float)v[0], (float)v[1], (float)v[2], (float)v[3]}; }
template <class ACC = f32x4, bool CS = false, bool RS = false, bool SSQI = false, bool SSQO = false, bool Q8 = false, bool BF = true, int BFPN = -1, bool NH = false>
struct EpiBf16 {   static constexpr bool NHALF = NH;       static constexpr int NSTORE = (Q8 ? 8 : 0) + ((BF && BFPN < 0) ? (NH ? 8 : 16) : 0) + (SSQO ? 2 : 0);
    static constexpr bool PERM = true;
    bf16_t* O; int ldc; int tile_cs; int bj_s; const float* cscale; const float* rscale; const float* ssq_in; int ssq_off; int ssq_ld; float* ssq_out; float dq; unsigned char* q8out; int q8ld; float q8scale; int bf_only_pn;
    __device__ __forceinline__ void operator()(const ACC (&acc)[2][2][4][2], const Unit& u, int wr, int wc, int fr, int fq) const {
        asm volatile("" : "+v"(fr), "+v"(fq));
        const int row0 = u.pm * BM + wr * 64 + fr;
        const int col0 = u.pn * tile_cs + wc * 32 + 8 * fq, lcol0 = u.pn * BM + wc * 32 + 8 * fq;
        f32x4 sv[2][2]; float ssv[8] = {0.f, 0.f, 0.f, 0.f, 0.f, 0.f, 0.f, 0.f}; float rs8[8] = {0.f, 0.f, 0.f, 0.f, 0.f, 0.f, 0.f, 0.f};
        if (RS || SSQI) rows8(fq, [&](int i) -> float { const size_t row = (size_t)(row0 + (i >> 2) * HALF + (i & 3) * 16); float r = RS ? rscale[row] : 1.f;
            if (SSQI) { const f32x4 a = *(const f32x4*)(ssq_in + row * ssq_ld + ssq_off), b = *(const f32x4*)(ssq_in + row * ssq_ld + ssq_off + 4);
                r = __builtin_amdgcn_rsqf(((a[0] + a[1]) + (a[2] + a[3]) + (b[0] + b[1]) + (b[2] + b[3])) * (1.0f / 512.f) + 1e-6f); }
            return r * dq; }, rs8);
#pragma unroll
        for (int bj = 0; bj < (NH ? 1 : 2); ++bj)
#pragma unroll
            for (int n = 0; n < 2; ++n) sv[bj][n] = CS ? *(const f32x4*)(cscale + lcol0 + bj * HALF + 4 * n) : (f32x4){1.f, 1.f, 1.f, 1.f};
#pragma unroll
        for (int ai = 0; ai < 2; ++ai)
#pragma unroll
            for (int m = 0; m < 4; ++m) { const int row = row0 + ai * HALF + m * 16; bf16_t* rowp = O + (size_t)row * ldc + col0;
                const float rs = (RS || SSQI) ? rs8[ai * 4 + m] : dq;
                float ss = 0.f; u32x2v xq8[2];
#pragma unroll
                for (int bj = 0; bj < (NH ? 1 : 2); ++bj) { const f32x4 v0 = tof(pin(acc[ai][bj][m][0])) * sv[bj][0] * rs, v1 = tof(pin(acc[ai][bj][m][1])) * sv[bj][1] * rs;
                    ss += (v0[0] * v0[0] + v0[1] * v0[1]) + (v0[2] * v0[2] + v0[3] * v0[3]) + (v1[0] * v1[0] + v1[1] * v1[1]) + (v1[2] * v1[2] + v1[3] * v1[3]);
                    if (BF && (BFPN < 0 || u.pn == BFPN)) { u32x4 w; w.x = cvt_pk_bf16(v0[0], v0[1]); w.y = cvt_pk_bf16(v0[2], v0[3]); w.z = cvt_pk_bf16(v1[0], v1[1]); w.w = cvt_pk_bf16(v1[2], v1[3]);
                        *(u32x4*)(rowp + bj * bj_s) = w; }
                    if (Q8) { xq8[bj].x = q8x4(v0[0] * q8scale, v0[1] * q8scale, v0[2] * q8scale, v0[3] * q8scale); xq8[bj].y = q8x4(v1[0] * q8scale, v1[1] * q8scale, v1[2] * q8scale, v1[3] * q8scale); } }
                if (Q8) { unsigned char* qp = q8out + (size_t)row * q8ld + col0; store16_pair(qp, qp + bj_s, xq8[0], xq8[1], fq); }
                if (SSQO) {
                    ss += __int_as_float(__builtin_amdgcn_ds_swizzle(__float_as_int(ss), (16 << 10) | 0x1F));
                    { auto rr = __builtin_amdgcn_permlane32_swap(__float_as_uint(ss), __float_as_uint(ss), false, false); ss = __uint_as_float(rr[0]) + __uint_as_float(rr[1]); }
                    ssv[ai * 4 + m] = ss; } }
        if (SSQO) {
#pragma unroll
            for (int j = 0; j < 2; ++j) { const float sv = (fq & 2) ? ((fq & 1) ? ssv[6 + j] : ssv[4 + j]) : ((fq & 1) ? ssv[2 + j] : ssv[j]);
                const int i = 2 * fq + j; ssq_out[(size_t)(row0 + (i >> 2) * HALF + (i & 3) * 16) * ssq_ld + u.pn * 4 + wc] = sv; } }
    }
};
template <class ACC = f32x4>
struct EpiKV {
    static constexpr bool PERM = true; static constexpr int NSTORE = 14;
    bf16_t* KV; const float* ssqc; const bf16_t* C; const float* CS; const float* gk; PG8_LAS unsigned char* xl; mutable int par; float dq;
    __device__ __forceinline__ void operator()(const ACC (&acc)[2][2][4][2], const Unit& u, int wr, int wc, int fr, int fq) const {
        asm volatile("" : "+v"(fr), "+v"(fq));
        PG8_LAS float* P = (PG8_LAS float*)xl;
        PG8_LAS float* RS = P + 1024;
        const int rl0 = wr * 64 + fr, col0 = wc * 32 + 8 * fq;
        const int tid = (wr * 4 + wc) * 64 + fq * 16 + fr;
        f32x4 sa = {0.f, 0.f, 0.f, 0.f}, sb = sa, sr = sa;
        if (wr == 0) { const float* sp = ssqc + ((size_t)u.pm * BM + tid) * 20; sa = *(const f32x4*)(sp + 8); sb = *(const f32x4*)(sp + 12); sr = *(const f32x4*)(sp + 16); }
        PG8_LAS const float* gl = (PG8_LAS const float*)(xl + 6144);
        const f32x4 g0 = *(PG8_LAS const f32x4*)(gl + col0), g1 = *(PG8_LAS const f32x4*)(gl + col0 + 4);
#pragma unroll
        for (int ai = 0; ai < 2; ++ai)
#pragma unroll
            for (int m = 0; m < 4; ++m) {
                const f32x4 k0 = tof(pin(acc[ai][0][m][0])), k1 = tof(pin(acc[ai][0][m][1]));
                float ss = (k0[0] * k0[0] + k0[1] * k0[1]) + (k0[2] * k0[2] + k0[3] * k0[3]) + (k1[0] * k1[0] + k1[1] * k1[1]) + (k1[2] * k1[2] + k1[3] * k1[3]);
                ss += __int_as_float(__builtin_amdgcn_ds_swizzle(__float_as_int(ss), (16 << 10) | 0x1F));
                { auto rr = __builtin_amdgcn_permlane32_swap(__float_as_uint(ss), __float_as_uint(ss), false, false); ss = __uint_as_float(rr[0]) + __uint_as_float(rr[1]); }
                if (fq == 0) P[(rl0 + ai * HALF + m * 16) * 4 + wc] = ss; }
        asm volatile("s_waitcnt lgkmcnt(0)" ::: "memory"); __builtin_amdgcn_s_barrier(); asm volatile("" ::: "memory");
        if (wr == 0) { const f32x4 pp = *(const PG8_LAS f32x4*)(P + tid * 4);
            const float rs = dq * __builtin_amdgcn_rsqf(((sa[0] + sa[1]) + (sa[2] + sa[3]) + (sb[0] + sb[1]) + (sb[2] + sb[3])) * (1.0f / 512.f) + 1e-6f);
            const float rkn = __builtin_amdgcn_rsqf((((pp[0] + pp[1]) + (pp[2] + pp[3])) * (rs * rs) + (sr[0] + sr[1]) + (sr[2] + sr[3])) * (1.0f / 192.f) + 1e-6f);
            typedef float f32x2v __attribute__((ext_vector_type(2))); *(PG8_LAS f32x2v*)(RS + 2 * tid) = (f32x2v){rs, rkn}; }
        asm volatile("s_waitcnt lgkmcnt(0)" ::: "memory"); __builtin_amdgcn_s_barrier(); asm volatile("" ::: "memory");
        unsigned char* tb = (unsigned char*)KV + (size_t)u.pm * BM * 8192 + u.pn * 512;
#pragma unroll
        for (int ai = 0; ai < 2; ++ai)
#pragma unroll
            for (int mp = 0; mp < 2; ++mp) { u32x2v wk[2];
#pragma unroll
                for (int mm = 0; mm < 2; ++mm) { const int m = 2 * mp + mm; const int rl = rl0 + ai * HALF + m * 16;
                    typedef float f32x2v __attribute__((ext_vector_type(2))); const f32x2v st = *(const PG8_LAS f32x2v*)(RS + 2 * rl);
                    const float rs = st[0], rk = st[0] * st[1];
                    bf16_t* rowp = (bf16_t*)(tb + (unsigned)rl * 8192u + 256) + col0;
                    const f32x4 k0 = tof(pin(acc[ai][0][m][0])) * rk * g0, k1 = tof(pin(acc[ai][0][m][1])) * rk * g1, v0 = tof(pin(acc[ai][1][m][0])) * rs, v1 = tof(pin(acc[ai][1][m][1])) * rs;
                    wk[mm].x = q8x4(k0[0] * 16.f, k0[1] * 16.f, k0[2] * 16.f, k0[3] * 16.f); wk[mm].y = q8x4(k1[0] * 16.f, k1[1] * 16.f, k1[2] * 16.f, k1[3] * 16.f);
                    u32x4 x; x.x = cvt_pk_bf16(v0[0], v0[1]); x.y = cvt_pk_bf16(v0[2], v0[3]); x.z = cvt_pk_bf16(v1[0], v1[1]); x.w = cvt_pk_bf16(v1[2], v1[3]); *(u32x4*)rowp = x; }
                unsigned char* ka = tb + (unsigned)(rl0 + ai * HALF + 2 * mp * 16) * 8192u + col0;
                store16_pair(ka, ka + 16 * 8192, wk[0], wk[1], fq);
                asm volatile("" ::: "memory"); }
        { const int rl = tid >> 1, j0 = 16 * (tid & 1); const size_t row = (size_t)u.pm * BM + rl;
          const float rk = RS[2 * rl + 1];
          const bf16_t* cr = C + row * 1280 + 1024 + j0; const float* cs = CS + row * 64 + j0; unsigned char* kp = tb + (unsigned)rl * 8192u + 128 + j0;
          u32x2v w1[2], w2[2];
#pragma unroll
          for (int q = 0; q < 2; ++q) { const u32x4 a = *(const u32x4*)(cr + 8 * q), b = *(const u32x4*)(cr + 32 + 8 * q);
              const f32x4 c0 = *(const f32x4*)(cs + 8 * q), c1 = *(const f32x4*)(cs + 8 * q + 4), s0 = *(const f32x4*)(cs + 32 + 8 * q), s1 = *(const f32x4*)(cs + 32 + 8 * q + 4);
              const f32x4 ga0 = *(PG8_LAS const f32x4*)(gl + 128 + j0 + 8 * q), ga1 = *(PG8_LAS const f32x4*)(gl + 128 + j0 + 8 * q + 4), gb0 = *(PG8_LAS const f32x4*)(gl + 160 + j0 + 8 * q), gb1 = *(PG8_LAS const f32x4*)(gl + 160 + j0 + 8 * q + 4);
              const f32x4 x10 = (f32x4){lo16(a.x), hi16(a.x), lo16(a.y), hi16(a.y)} * rk * ga0, x11 = (f32x4){lo16(a.z), hi16(a.z), lo16(a.w), hi16(a.w)} * rk * ga1;
              const f32x4 x20 = (f32x4){lo16(b.x), hi16(b.x), lo16(b.y), hi16(b.y)} * rk * gb0, x21 = (f32x4){lo16(b.z), hi16(b.z), lo16(b.w), hi16(b.w)} * rk * gb1;
              const f32x4 o10 = x10 * c0 - x20 * s0, o11 = x11 * c1 - x21 * s1, o20 = x20 * c0 + x10 * s0, o21 = x21 * c1 + x11 * s1;
              w1[q].x = q8x4(o10[0] * 16.f, o10[1] * 16.f, o10[2] * 16.f, o10[3] * 16.f); w1[q].y = q8x4(o11[0] * 16.f, o11[1] * 16.f, o11[2] * 16.f, o11[3] * 16.f);
              w2[q].x = q8x4(o20[0] * 16.f, o20[1] * 16.f, o20[2] * 16.f, o20[3] * 16.f); w2[q].y = q8x4(o21[0] * 16.f, o21[1] * 16.f, o21[2] * 16.f, o21[3] * 16.f); }
          { u32x4 w; w.x = w1[0].x; w.y = w1[0].y; w.z = w1[1].x; w.w = w1[1].y; *(u32x4*)kp = w; }
          { u32x4 w; w.x = w2[0].x; w.y = w2[0].y; w.z = w2[1].x; w.w = w2[1].y; *(u32x4*)(kp + 32) = w; } }
    }
};
struct EpiSwiGLU8 {   static constexpr int NSTORE = 4;
    static constexpr bool PERM = true;
    unsigned char* O; int ldc; const float* rscale; float dq; float hscale;
    __device__ __forceinline__ static float sg(float g, float u) { return g * u * __builtin_amdgcn_rcpf(1.f + __builtin_amdgcn_exp2f(-1.4426950408889634f * g)); }
    __device__ __forceinline__ void operator()(const i32x4 (&acc)[2][2][4][2], const Unit& u, int wr, int wc, int fr, int fq) const {
        asm volatile("" : "+v"(fr), "+v"(fq));
        const int row0 = u.pm * BM + wr * 64 + fr, col0 = u.pn * HALF + wc * 32 + 8 * fq;
        float rs8[8]; rows8(fq, [&](int i) -> float { return rscale[row0 + (i >> 2) * HALF + (i & 3) * 16] * dq; }, rs8);
#pragma unroll
        for (int ai = 0; ai < 2; ++ai)
#pragma unroll
            for (int mp = 0; mp < 2; ++mp) { u32x2v w[2];
#pragma unroll
                for (int mm = 0; mm < 2; ++mm) { const int m = 2 * mp + mm; const float rs = rs8[ai * 4 + m]; float h[8];
#pragma unroll
                    for (int n = 0; n < 2; ++n)
#pragma unroll
                        for (int e = 0; e < 4; ++e) h[4 * n + e] = sg((float)acc[ai][0][m][n][e] * rs, (float)acc[ai][1][m][n][e] * rs) * hscale;
                    w[mm].x = q8x4(h[0], h[1], h[2], h[3]); w[mm].y = q8x4(h[4], h[5], h[6], h[7]); }
                unsigned char* pa = O + (size_t)(row0 + ai * HALF + 2 * mp * 16) * ldc + col0;
                store16_pair(pa, pa + (size_t)16 * ldc, w[0], w[1], fq); }
    }
};
struct EpiY8 {   static constexpr int NSTORE = 8;
    static constexpr bool PERM = true;
    unsigned char* O; int ldc; float dq;
    __device__ __forceinline__ void operator()(const i32x4 (&acc)[2][2][4][2], const Unit& u, int wr, int wc, int fr, int fq) const {
        asm volatile("" : "+v"(fr), "+v"(fq));
        const int row0 = u.pm * BM + wr * 64 + fr, col0 = u.pn * BM + wc * 32 + 8 * fq;
#pragma unroll
        for (int ai = 0; ai < 2; ++ai)
#pragma unroll
            for (int m = 0; m < 4; ++m) { unsigned char* rowp = O + (size_t)(row0 + ai * HALF + m * 16) * ldc + col0;
                u32x2v w[2];
#pragma unroll
                for (int bj = 0; bj < 2; ++bj) { const i32x4 a0 = acc[ai][bj][m][0], a1 = acc[ai][bj][m][1];
                    w[bj].x = q8x4((float)a0[0] * dq, (float)a0[1] * dq, (float)a0[2] * dq, (float)a0[3] * dq); w[bj].y = q8x4((float)a1[0] * dq, (float)a1[1] * dq, (float)a1[2] * dq, (float)a1[3] * dq); }
                store16_pair(rowp, rowp + HALF, w[0], w[1], fq); }
    }
};
struct EpiSwiGLU {
    static constexpr bool PERM = true;
    bf16_t* O; int ldc; const float* rscale;
    __device__ __forceinline__ static float sg(float g, float u) { return g * u * __builtin_amdgcn_rcpf(1.f + __builtin_amdgcn_exp2f(-1.4426950408889634f * g)); }
    __device__ __forceinline__ void operator()(const f32x4 (&acc)[2][2][4][2], const Unit& u, int wr, int wc, int fr, int fq) const {
        asm volatile("" : "+v"(fr), "+v"(fq));
        const int row0 = u.pm * BM + wr * 64 + fr, col0 = u.pn * HALF + wc * 32 + 8 * fq;
#pragma unroll
        for (int ai = 0; ai < 2; ++ai)
#pragma unroll
            for (int m = 0; m < 4; ++m) { const int row = row0 + ai * HALF + m * 16; bf16_t* rowp = O + (size_t)row * ldc + col0; const float rs = rscale[row];
                const f32x4 g0 = acc[ai][0][m][0] * rs, g1 = acc[ai][0][m][1] * rs, u0 = acc[ai][1][m][0] * rs, u1 = acc[ai][1][m][1] * rs;
                u32x4 w; w.x = cvt_pk_bf16(sg(g0[0], u0[0]), sg(g0[1], u0[1])); w.y = cvt_pk_bf16(sg(g0[2], u0[2]), sg(g0[3], u0[3]));
                w.z = cvt_pk_bf16(sg(g1[0], u1[0]), sg(g1[1], u1[1])); w.w = cvt_pk_bf16(sg(g1[2], u1[2]), sg(g1[3], u1[3]));
                *(u32x4*)rowp = w; }
    }
};
constexpr float QS_O = 96.f;
__device__ __forceinline__ float o_row_scale(int row) { return QS_O * sqrtf((float)(((row & 4095) >> 6) + 1)); }
template <class ACC = f32x4>
struct EpiResBf16 {
    static constexpr bool PERM = true; static constexpr int NSTORE = 26;
    const bf16_t* base; bf16_t* out; int ldc; float* ssqp; const float* qgain; unsigned char* xq; float qscale; float dq;
    __device__ __forceinline__ void operator()(const ACC (&acc)[2][2][4][2], const Unit& u, int wr, int wc, int fr, int fq) const {
        asm volatile("" : "+v"(fr), "+v"(fq));
        const int row0 = u.pm * BM + wr * 64 + fr, col0 = u.pn * BM + wc * 32 + 8 * fq;
        f32x4 gv[2][2]; float ssv[8];
#pragma unroll
        for (int bj = 0; bj < 2; ++bj)
#pragma unroll
            for (int n = 0; n < 2; ++n) gv[bj][n] = *(const f32x4*)(qgain + col0 + bj * HALF + 4 * n) * qscale;
#pragma unroll
        for (int ai = 0; ai < 2; ++ai)
#pragma unroll
            for (int m = 0; m < 4; ++m) { const int row = row0 + ai * HALF + m * 16; const size_t off = (size_t)row * ldc + col0; float ss = 0.f; u32x2v xq8[2];
                const float as = dq > 0.f ? dq * (1.0f / QS_O) * __builtin_amdgcn_rsqf((float)(((row & 4095) >> 6) + 1)) : 1.f;
#pragma unroll
                for (int bj = 0; bj < 2; ++bj) { const u32x4 b = *(const u32x4*)(base + off + bj * HALF);
                    const f32x4 v0 = tof(acc[ai][bj][m][0]) * as + (f32x4){lo16(b.x), hi16(b.x), lo16(b.y), hi16(b.y)}, v1 = tof(acc[ai][bj][m][1]) * as + (f32x4){lo16(b.z), hi16(b.z), lo16(b.w), hi16(b.w)};
                    ss += (v0[0] * v0[0] + v0[1] * v0[1]) + (v0[2] * v0[2] + v0[3] * v0[3]) + (v1[0] * v1[0] + v1[1] * v1[1]) + (v1[2] * v1[2] + v1[3] * v1[3]);
                    u32x4 w; w.x = cvt_pk_bf16(v0[0], v0[1]); w.y = cvt_pk_bf16(v0[2], v0[3]); w.z = cvt_pk_bf16(v1[0], v1[1]); w.w = cvt_pk_bf16(v1[2], v1[3]);
                    *(u32x4*)(out + off + bj * HALF) = w;
                    const f32x4 q0 = v0 * gv[bj][0], q1 = v1 * gv[bj][1];
                    xq8[bj].x = q8x4(q0[0], q0[1], q0[2], q0[3]); xq8[bj].y = q8x4(q1[0], q1[1], q1[2], q1[3]); }
                store16_pair(xq + off, xq + off + HALF, xq8[0], xq8[1], fq);
                ss += __int_as_float(__builtin_amdgcn_ds_swizzle(__float_as_int(ss), (16 << 10) | 0x1F));
                { auto rr = __builtin_amdgcn_permlane32_swap(__float_as_uint(ss), __float_as_uint(ss), false, false); ss = __uint_as_float(rr[0]) + __uint_as_float(rr[1]); }
                ssv[ai * 4 + m] = ss;
                if (m == 3) asm volatile("" ::: "memory"); }
#pragma unroll
        for (int j = 0; j < 2; ++j) { const float sv = (fq & 2) ? ((fq & 1) ? ssv[6 + j] : ssv[4 + j]) : ((fq & 1) ? ssv[2 + j] : ssv[j]);
            const int i = 2 * fq + j; ssqp[(size_t)(row0 + (i >> 2) * HALF + (i & 3) * 16) * 32 + u.pn * 4 + wc] = sv; }
    }
};
struct EpiResF32 {
    static constexpr bool PERM = false;
    const float* base; float* out; int ldc;
    __device__ __forceinline__ void operator()(const f32x4 (&acc)[2][2][4][2], const Unit& u, int wr, int wc, int fr, int fq) const {
        asm volatile("" : "+v"(fr), "+v"(fq));
        const int col0 = u.pn * BM + wc * 32 + 4 * fq;
#pragma unroll
        for (int ai = 0; ai < 2; ++ai)
#pragma unroll
            for (int m = 0; m < 4; ++m) { const size_t off = (size_t)(u.pm * BM + ai * HALF + wr * 64 + m * 16 + fr) * ldc + col0;
#pragma unroll
                for (int bj = 0; bj < 2; ++bj)
#pragma unroll
                    for (int n = 0; n < 2; ++n) { const f32x4 bs = *(const f32x4*)(base + off + bj * HALF + n * 16); *(f32x4*)(out + off + bj * HALF + n * 16) = bs + acc[ai][bj][m][n]; } }
    }
};
struct EpiLogits {   static constexpr bool NHALF = true;
    static constexpr bool PERM = false;
    float* out; int ldc; int ncol; size_t bstride;
    __device__ __forceinline__ void operator()(const f32x4 (&acc)[2][2][4][2], const Unit& u, int wr, int wc, int fr, int fq) const {
        asm volatile("" : "+v"(fr), "+v"(fq));
        const int col0 = wc * 32 + 4 * fq;
        if (wc * 32 >= ncol) return;
#pragma unroll
        for (int ai = 0; ai < 2; ++ai)
#pragma unroll
            for (int m = 0; m < 4; ++m) { const size_t off = (size_t)u.aux * bstride + (size_t)(u.pm * BM + ai * HALF + wr * 64 + m * 16 + fr) * ldc;
#pragma unroll
                for (int n = 0; n < 2; ++n) { const int c = col0 + n * 16; if (c < ncol) *(f32x4*)(out + off + c) = acc[ai][0][m][n]; } }
    }
};

template <class E, class = void> struct EpiHalfN { static constexpr bool v = false; };
template <class E> struct EpiHalfN<E, decltype((void)E::NHALF)> { static constexpr bool v = E::NHALF; };
template <class E, class = void> struct EpiStores { static constexpr int v = 0; };
template <class E> struct EpiStores<E, decltype((void)E::NSTORE)> { static constexpr int v = E::NSTORE; };
template <class Epi, class Sched, bool GATHER = false, bool I8 = false>
__device__ __forceinline__ void gemm_phase(PG8_LAS unsigned char* lds, const Gemm g, const Sched& S, const Epi& E) {
    int tid = threadIdx.x; asm volatile("" : "+v"(tid));
    const int wid = __builtin_amdgcn_readfirstlane(tid >> 6), lane = tid & 63, wr = wid >> 2, wc = wid & 3, fr = lane & 15, fq = lane >> 4;
    const int K = g.K, nt = K / BK, lda = g.lda, ldb = g.ldb;
    unsigned voffA[2], voffB[2]; int gR[2], gC[2];
#pragma unroll
    for (int i = 0; i < 2; ++i) { int R, C; stage_rc(tid * 16 + i * 8192, R, C); const int Rb = Epi::PERM ? ((R & ~31) + perm32(R & 31)) : R; gR[i] = R; gC[i] = C;
        voffA[i] = (unsigned)(R * lda + C) * 2u; voffB[i] = (unsigned)(Rb * ldb + C) * 2u; }
    unsigned cao[2][2], xao[2][2];
    PG8_LAS unsigned* stash = (PG8_LAS unsigned*)(lds + STAGE_BYTES + 4096) + tid;
#define PG8_GOFF(u, ao) do { _Pragma("unroll") for (int h_ = 0; h_ < 2; ++h_) _Pragma("unroll") for (int i_ = 0; i_ < 2; ++i_) { \
        const unsigned row_ = __hip_atomic_load((const unsigned*)g.rowtab + (u).pm * BM + h_ * HALF + gR[i_], __ATOMIC_RELAXED, __HIP_MEMORY_SCOPE_AGENT); \
        ao[h_][i_] = row_ * (unsigned)(lda * 2) + (unsigned)(gC[i_] * 2); } } while (0)
#define PG8_STAGE_A(bufoff, ptr, h, nx, kt) do { if constexpr (GATHER) { _Pragma("unroll") for (int _i = 0; _i < 2; ++_i) { const unsigned o_ = (nx) ? xao[h][_i] : cao[h][_i]; \
        __builtin_amdgcn_global_load_lds((const unsigned*)((const char*)g.A + o_ + (size_t)(kt) * (BK * 2)), (PG8_LAS unsigned*)(lds + (bufoff) + ldsw + _i * 8192), 16, 0, 0); } } \
        else PG8_STAGE(bufoff, ptr, voffA); } while (0)
    const size_t kstep = (size_t)(BK * 2);
    const size_t hstepA = (size_t)HALF * lda * 2, hstepB = (size_t)HALF * ldb * 2;
    const unsigned ldsw = (unsigned)wid * 1024u;
    const int aoff = lds_byte(wr * 64 + fr, fq * 8), boff = lds_byte(wc * 32 + fr, fq * 8);
#define PG8_SA(b, h) (((b) * 2 + (h)) * HTB)
#define PG8_SB(b, h) ((4 + (b) * 2 + (h)) * HTB)
#define PG8_STAGE(bufoff, gbase, voff) do { _Pragma("unroll") for (int _i = 0; _i < 2; ++_i) \
        __builtin_amdgcn_global_load_lds((const unsigned*)((const char*)(gbase) + (voff)[_i]), (PG8_LAS unsigned*)(lds + (bufoff) + ldsw + _i * 8192), 16, 0, 0); } while (0)
#define PG8_LDA(dst, b, h) do { _Pragma("unroll") for (int m = 0; m < 4; ++m) _Pragma("unroll") for (int k = 0; k < 2; ++k) dst[m][k] = *(const PG8_LAS bf16x8*)(lds + PG8_SA(b, h) + aoff + m * 2048 + k * 1024); } while (0)
#define PG8_LDB(dst, b, h) do { _Pragma("unroll") for (int n = 0; n < 2; ++n) _Pragma("unroll") for (int k = 0; k < 2; ++k) dst[n][k] = *(const PG8_LAS bf16x8*)(lds + PG8_SB(b, h) + boff + n * 2048 + k * 1024); } while (0)
#define PG8_MMA(ai, bj, At, Bt) do { __builtin_amdgcn_s_setprio(1); _Pragma("unroll") for (int m = 0; m < 4; ++m) _Pragma("unroll") for (int n = 0; n < 2; ++n) _Pragma("unroll") for (int k = 0; k < 2; ++k) \
        { if constexpr (I8) acc[ai][bj][m][n] = __builtin_bit_cast(acc_t, __builtin_amdgcn_mfma_i32_16x16x64_i8(__builtin_bit_cast(i32x4, Bt[n][k]), __builtin_bit_cast(i32x4, At[m][k]), __builtin_bit_cast(i32x4, acc[ai][bj][m][n]), 0, 0, 0)); \
          else acc[ai][bj][m][n] = __builtin_bit_cast(acc_t, __builtin_amdgcn_mfma_f32_16x16x32_bf16(Bt[n][k], At[m][k], __builtin_bit_cast(f32x4, acc[ai][bj][m][n]), 0, 0, 0)); } __builtin_amdgcn_s_setprio(0); } while (0)
#define PG8_WAIT_V(n) asm volatile("s_waitcnt vmcnt(" #n ")" ::: "memory")
#define PG8_WAIT_L(n) asm volatile("s_waitcnt lgkmcnt(" #n ")" ::: "memory")
#define PG8_WAIT_VE asm volatile("s_waitcnt vmcnt(%0)" :: "n"(8 + EpiStores<Epi>::v) : "memory")
#define PG8_BAR __builtin_amdgcn_s_barrier()
#define PG8_SCHED __builtin_amdgcn_sched_barrier(0)
    Unit cur, nxt; int ui = 0;
    if (!S.next(0, cur)) return;
    typedef typename AccT<I8>::type acc_t;
    acc_t acc[2][2][4][2];
#pragma unroll
    for (int a = 0; a < 2; ++a)
#pragma unroll
        for (int b = 0; b < 2; ++b)
#pragma unroll
            for (int m = 0; m < 4; ++m)
#pragma unroll
                for (int n = 0; n < 2; ++n) acc[a][b][m][n] = __builtin_bit_cast(acc_t, (f32x4){0.f, 0.f, 0.f, 0.f});
    bf16x8 At[4][2], B0[2][2], B1[2][2];
    const char* cA = S.abase(g, cur); const char* cB = S.bbase(g, cur);
    if constexpr (GATHER) { PG8_GOFF(cur, cao); }
    PG8_STAGE(PG8_SB(0, 0), cB, voffB); PG8_STAGE(PG8_SB(0, 1), cB + hstepB, voffB); PG8_STAGE_A(PG8_SA(0, 0), cA, 0, false, 0); PG8_STAGE_A(PG8_SA(0, 1), cA + hstepA, 1, false, 0);
    if (wr == 1) PG8_BAR;
    PG8_WAIT_V(2); PG8_BAR;
    PG8_STAGE(PG8_SB(1, 0), cB + kstep, voffB); PG8_STAGE_A(PG8_SA(1, 0), cA + kstep, 0, false, 1); PG8_STAGE(PG8_SB(1, 1), cB + hstepB + kstep, voffB);
    if constexpr (GATHER || EpiStores<Epi>::v == 0) { PG8_WAIT_V(6); } else { PG8_WAIT_V(0); }
    PG8_BAR;
    for (;;) {
        const bool has_next = S.next(ui + 1, nxt);
        const char* nA = has_next ? S.abase(g, nxt) : cA; const char* nB = has_next ? S.bbase(g, nxt) : cB;
        if constexpr (GATHER) { if (has_next) { unsigned nao[2][2]; PG8_GOFF(nxt, nao); stash[0] = nao[0][0]; stash[512] = nao[0][1]; stash[1024] = nao[1][0]; stash[1536] = nao[1][1]; } }
#define PG8_KPAIR(t, last, WAITA) do { \
            const char* a1 = cA + (size_t)((t) + 1) * kstep;                                             \
            const char* a2 = (last) ? nA : cA + (size_t)((t) + 2) * kstep; const char* b2 = (last) ? nB : cB + (size_t)((t) + 2) * kstep;     \
            const char* a3 = a2 + kstep; const char* b3 = b2 + kstep;                                \
            const int k2 = (last) ? 0 : (t) + 2; \
            if constexpr (GATHER) { if (last) { if (has_next) { xao[0][0] = stash[0]; xao[0][1] = stash[512]; xao[1][0] = stash[1024]; xao[1][1] = stash[1536]; } \
                else { xao[0][0] = cao[0][0]; xao[0][1] = cao[0][1]; xao[1][0] = cao[1][0]; xao[1][1] = cao[1][1]; } } } \
              \
            PG8_LDB(B0, 0, 0); if constexpr (!EpiHalfN<Epi>::v) PG8_LDB(B1, 0, 1); PG8_SCHED; PG8_LDA(At, 0, 0); PG8_STAGE_A(PG8_SA(1, 1), a1 + hstepA, 1, false, (t) + 1); \
            WAITA; PG8_WAIT_L(0); PG8_BAR; PG8_MMA(0, 0, At, B0); if constexpr (!EpiHalfN<Epi>::v) PG8_MMA(0, 1, At, B1); PG8_BAR; PG8_SCHED; \
            PG8_LDA(At, 0, 1); PG8_STAGE(PG8_SB(0, 0), b2, voffB); PG8_STAGE(PG8_SB(0, 1), b2 + hstepB, voffB); PG8_STAGE_A(PG8_SA(0, 0), a2, 0, last, k2); \
            WAITA; PG8_WAIT_L(0); PG8_BAR; PG8_MMA(1, 0, At, B0); if constexpr (!EpiHalfN<Epi>::v) PG8_MMA(1, 1, At, B1); PG8_BAR; PG8_SCHED; \
              \
            PG8_LDB(B0, 1, 0); if constexpr (!EpiHalfN<Epi>::v) PG8_LDB(B1, 1, 1); PG8_SCHED; PG8_LDA(At, 1, 0); PG8_STAGE_A(PG8_SA(0, 1), a2 + hstepA, 1, last, k2); \
            PG8_WAIT_V(8); PG8_WAIT_L(0); PG8_BAR; PG8_MMA(0, 0, At, B0); if constexpr (!EpiHalfN<Epi>::v) PG8_MMA(0, 1, At, B1); PG8_BAR; PG8_SCHED; \
            PG8_LDA(At, 1, 1); PG8_STAGE(PG8_SB(1, 0), b3, voffB); PG8_STAGE(PG8_SB(1, 1), b3 + hstepB, voffB); PG8_STAGE_A(PG8_SA(1, 0), a3, 0, last, k2 + 1); \
            PG8_WAIT_V(8); PG8_WAIT_L(0); PG8_BAR; PG8_MMA(1, 0, At, B0); if constexpr (!EpiHalfN<Epi>::v) PG8_MMA(1, 1, At, B1); PG8_BAR; PG8_SCHED; } while (0)
        if constexpr (GATHER || EpiStores<Epi>::v == 0) { for (int t = 0; t < nt; t += 2) { const bool last = (t == nt - 2); PG8_KPAIR(t, last, PG8_WAIT_V(8)); } }
        else { PG8_KPAIR(0, false, PG8_WAIT_VE);
               for (int t = 2; t < nt; t += 2) { const bool last = (t == nt - 2); PG8_KPAIR(t, last, PG8_WAIT_V(8)); } }
        if (wr == 0) PG8_BAR;
        { int l2 = threadIdx.x; asm volatile("" : "+v"(l2)); E(acc, cur, wr, wc, l2 & 15, (l2 >> 4) & 3); }
        if (!has_next) break;
#pragma unroll
        for (int a = 0; a < 2; ++a)
#pragma unroll
            for (int b = 0; b < 2; ++b)
#pragma unroll
                for (int m = 0; m < 4; ++m)
#pragma unroll
                    for (int n = 0; n < 2; ++n) acc[a][b][m][n] = __builtin_bit_cast(acc_t, (f32x4){0.f, 0.f, 0.f, 0.f});
        cur = nxt; cA = nA; cB = nB; ++ui;
        if constexpr (GATHER) { cao[0][0] = xao[0][0]; cao[0][1] = xao[0][1]; cao[1][0] = xao[1][0]; cao[1][1] = xao[1][1]; }
        if (wr == 1) PG8_BAR;
    }
    PG8_WAIT_V(0);
    PG8_BAR;
#undef PG8_SA
#undef PG8_SB
#undef PG8_STAGE
#undef PG8_STAGE_A
#undef PG8_GOFF
#undef PG8_LDA
#undef PG8_LDB
#undef PG8_MMA
#undef PG8_WAIT_V
#undef PG8_WAIT_L
#undef PG8_WAIT_VE
#undef PG8_KPAIR
#undef PG8_BAR
#undef PG8_SCHED
}
}
namespace att {
#define ATT_LAS __attribute__((address_space(3)))
typedef unsigned short bf16_t;
typedef short bf16x8 __attribute__((ext_vector_type(8)));
typedef short s16x4 __attribute__((ext_vector_type(4)));
typedef float f32x16 __attribute__((ext_vector_type(16)));
typedef unsigned u32x4 __attribute__((ext_vector_type(4)));
typedef unsigned u32x2 __attribute__((ext_vector_type(2)));
constexpr int SEQ = 4096, NHEAD = 16, QPITCH = 3072, KVPITCH = 4096, OPITCH = 2048, HQK = 192, HKV = 256, VOFF = 128, HV = 128;
constexpr int KT_BYTES = 64 * 256, VT_BYTES = 64 * 128 * 2;
constexpr float QK8 = 16.f;
typedef int i32x4 __attribute__((ext_vector_type(4)));
typedef int i32x16 __attribute__((ext_vector_type(16)));
constexpr int SLOT_BYTES = KT_BYTES + VT_BYTES, NSLOT = 4, LDS_BYTES = NSLOT * SLOT_BYTES;
constexpr float THR = 8.f;

typedef __bf16 bf16x2_t __attribute__((ext_vector_type(2)));
typedef float f32x2_t __attribute__((ext_vector_type(2)));
__device__ __forceinline__ unsigned cvtpk(float lo, float hi) { f32x2_t v = {lo, hi}; bf16x2_t r = __builtin_convertvector(v, bf16x2_t); return __builtin_bit_cast(unsigned, r); }
__device__ __forceinline__ bf16x8 pack8(const f32x16& p, int b) {
    u32x4 w = {cvtpk(p[b + 0], p[b + 1]), cvtpk(p[b + 2], p[b + 3]), cvtpk(p[b + 4], p[b + 5]), cvtpk(p[b + 6], p[b + 7])};
    return __builtin_bit_cast(bf16x8, w);
}
typedef float f32x4v __attribute__((ext_vector_type(4)));
__device__ __forceinline__ float bf2f(short s) { return __uint_as_float(((unsigned)(unsigned short)s) << 16); }
__device__ __forceinline__ bf16x8 pack8f(const float (&v)[8]) { u32x4 w = {cvtpk(v[0], v[1]), cvtpk(v[2], v[3]), cvtpk(v[4], v[5]), cvtpk(v[6], v[7])}; return __builtin_bit_cast(bf16x8, w); }
__device__ __forceinline__ i32x4 pack16q(const float (&v)[16]) { i32x4 w;
    w[0] = (int)pg8::q8x4(v[0], v[1], v[2], v[3]); w[1] = (int)pg8::q8x4(v[4], v[5], v[6], v[7]); w[2] = (int)pg8::q8x4(v[8], v[9], v[10], v[11]); w[3] = (int)pg8::q8x4(v[12], v[13], v[14], v[15]); return w; }
__device__ __forceinline__ int xhalf_imax(int v) { auto rr = __builtin_amdgcn_permlane32_swap((unsigned)v, (unsigned)v, false, false); const int a = (int)rr[0], b = (int)rr[1]; return a > b ? a : b; }
__device__ __forceinline__ s16x4 vtr(ATT_LAS const unsigned char* p) {
    typedef short v4i16_t __attribute__((ext_vector_type(4)));
    return __builtin_bit_cast(s16x4, __builtin_amdgcn_ds_read_tr16_b64_v4i16((ATT_LAS v4i16_t*)p));
}
__device__ __forceinline__ float xhalf_max(float v) { auto rr = __builtin_amdgcn_permlane32_swap(__float_as_uint(v), __float_as_uint(v), false, false); return fmaxf(__uint_as_float(rr[0]), __uint_as_float(rr[1])); }
__device__ __forceinline__ float xhalf_sum(float v) { auto rr = __builtin_amdgcn_permlane32_swap(__float_as_uint(v), __float_as_uint(v), false, false); return __uint_as_float(rr[0]) + __uint_as_float(rr[1]); }

__device__ __forceinline__ void attn_unit(ATT_LAS unsigned char* lds, const bf16_t* __restrict__ Q, const bf16_t* __restrict__ KV, bf16_t* __restrict__ O, const float* __restrict__ qn, const float* __restrict__ CS, int b, int h, int qb) {
    int tid = threadIdx.x; asm volatile("" : "+v"(tid));
    const int lane = tid & 63, c = lane & 31, hi = lane >> 5;
    const int wid = __builtin_amdgcn_readfirstlane(tid >> 6);
    const size_t row0 = (size_t)b * SEQ;
    const int q0 = qb * 256;
    const int NT = 4 * qb + 4;
    const int my_nt = 4 * qb + (wid >> 1) + 1;
    const char* kvh = (const char*)(KV + row0 * KVPITCH + h * HKV);
    unsigned koff[2], voff[2];
#pragma unroll
    for (int i = 0; i < 2; ++i) { const int qi = 64 * (wid + 8 * i) + lane, krow = qi >> 4, pos = qi & 15, kc = pos ^ (krow & 15);
        koff[i] = (unsigned)(krow * KVPITCH * 2 + kc * 16); }
#pragma unroll
    for (int j = 0; j < 2; ++j) { const int sg = 2 * (wid + 8 * j) + (lane >> 5), kb = sg >> 2, cg = sg & 3, vrow = kb * 8 + ((lane & 31) >> 2), vcol = cg * 32 + (lane & 3) * 8;
        voff[j] = (unsigned)(vrow * KVPITCH * 2 + (VOFF + vcol) * 2); }
#define ATT_DMA_K(t, kbuf) do { const char* tb_ = kvh + (size_t)(t) * 64 * KVPITCH * 2; \
        _Pragma("unroll") for (int i_ = 0; i_ < 2; ++i_) __builtin_amdgcn_global_load_lds((const unsigned*)(tb_ + koff[i_]), (ATT_LAS unsigned*)(lds + (kbuf) + 1024 * (wid + 8 * i_)), 16, 0, 0); } while (0)
#define ATT_DMA_V(t, vbuf) do { const char* tb_ = kvh + (size_t)(t) * 64 * KVPITCH * 2; \
        _Pragma("unroll") for (int j_ = 0; j_ < 2; ++j_) __builtin_amdgcn_global_load_lds((const unsigned*)(tb_ + voff[j_]), (ATT_LAS unsigned*)(lds + (vbuf) + 1024 * (wid + 8 * j_)), 16, 0, 0); } while (0)
    asm volatile("s_waitcnt lgkmcnt(0)\n\ts_barrier" ::: "memory");
    ATT_DMA_K(0, 0); ATT_DMA_K(1, KT_BYTES); ATT_DMA_V(0, 4 * KT_BYTES);
    i32x4 qf[6];
    { const size_t trow = row0 + q0 + 32 * wid + c;
      const unsigned char* qp = (const unsigned char*)Q + trow * QPITCH + h * HQK + 16 * hi;
      float qr[6][16];
#pragma unroll
      for (int s = 0; s < 6; ++s) { const i32x4 w = *(const i32x4*)(qp + 32 * s);
#pragma unroll
          for (int e = 0; e < 16; ++e) qr[s][e] = (float)((w[e >> 2] << (24 - 8 * (e & 3))) >> 24); }
      float ss = 0.f;
#pragma unroll
      for (int s = 0; s < 6; ++s)
#pragma unroll
          for (int e = 0; e < 16; ++e) { const float v = qr[s][e]; ss += v * v; }
      ss = xhalf_sum(ss);
      const float rs = (1.0f / sqrtf(ss * (1.0f / 192.f) + 1e-6f * 256.f)) * QK8;
#pragma unroll
      for (int s = 0; s < 4; ++s) { float v[16];
#pragma unroll
          for (int q4 = 0; q4 < 4; ++q4) { const f32x4v g = *(const f32x4v*)(qn + 32 * s + 16 * hi + 4 * q4);
#pragma unroll
              for (int e = 0; e < 4; ++e) v[4 * q4 + e] = qr[s][4 * q4 + e] * rs * g[e]; }
          qf[s] = pack16q(v); }
      const float* csr = CS + trow * 64 + 16 * hi;
      { float o1[16], o2[16];
#pragma unroll
        for (int q4 = 0; q4 < 4; ++q4) { const f32x4v ga = *(const f32x4v*)(qn + 128 + 16 * hi + 4 * q4), gb = *(const f32x4v*)(qn + 160 + 16 * hi + 4 * q4);
            const f32x4v cc = *(const f32x4v*)(csr + 4 * q4), sn = *(const f32x4v*)(csr + 32 + 4 * q4);
#pragma unroll
            for (int e = 0; e < 4; ++e) { const int idx = 4 * q4 + e; const float n1 = qr[4][idx] * rs * ga[e], n2 = qr[5][idx] * rs * gb[e];
                o1[idx] = n1 * cc[e] - n2 * sn[e]; o2[idx] = n2 * cc[e] + n1 * sn[e]; } }
        qf[4] = pack16q(o1); qf[5] = pack16q(o2); } }
    unsigned ko[6];
#pragma unroll
    for (int s = 0; s < 6; ++s) ko[s] = (unsigned)(c * 256 + 16 * ((2 * s + hi) ^ (c & 15)));
    const unsigned vbase = (unsigned)(hi * 256 + ((lane >> 2) & 3) * 64 + ((lane >> 4) & 1) * 32 + (lane & 3) * 8);
    f32x16 o[4];
#pragma unroll
    for (int d = 0; d < 4; ++d)
#pragma unroll
        for (int r = 0; r < 16; ++r) o[d][r] = 0.f;
    float l_run = 0.f;
    constexpr float CSC = 0.07216878364870322f * 1.4426950408889634f / (QK8 * QK8);
#define ATT_QKH(A, koff_) do { ATT_LAS const unsigned char* kp = lds + (koff_); \
            { const i32x16 z = {0, 0, 0, 0, 0, 0, 0, 0, 0, 0, 0, 0, 0, 0, 0, 0}; const i32x4 k0 = *(ATT_LAS const i32x4*)(kp + ko[0]); A = __builtin_amdgcn_mfma_i32_32x32x32_i8(k0, qf[0], z, 0, 0, 0); } \
            _Pragma("unroll") for (int s = 1; s < 6; ++s) { const i32x4 k0 = *(ATT_LAS const i32x4*)(kp + ko[s]); A = __builtin_amdgcn_mfma_i32_32x32x32_i8(k0, qf[s], A, 0, 0, 0); } } while (0)
#define ATT_EXPH(A, P0, P1) do { float pe[16]; \
            _Pragma("unroll") for (int r = 0; r < 16; ++r) pe[r] = __builtin_amdgcn_exp2f((float)A[r] * CSC); \
            { u32x4 w = {cvtpk(pe[0], pe[1]), cvtpk(pe[2], pe[3]), cvtpk(pe[4], pe[5]), cvtpk(pe[6], pe[7])}; P0 = __builtin_bit_cast(bf16x8, w); } \
            { u32x4 w = {cvtpk(pe[8], pe[9]), cvtpk(pe[10], pe[11]), cvtpk(pe[12], pe[13]), cvtpk(pe[14], pe[15])}; P1 = __builtin_bit_cast(bf16x8, w); } \
            float ps = 0.f; \
            _Pragma("unroll") for (int r = 0; r < 16; ++r) ps += pe[r]; \
            l_run += ps; } while (0)
#define ATT_PVH(P0, P1, voff_) do { ATT_LAS const unsigned char* vp = lds + (voff_) + vbase; \
            _Pragma("unroll") for (int d = 0; d < 4; ++d) { \
                    const s16x4 lo = vtr(vp + d * 512), hh = vtr(vp + 2048 + d * 512); \
                    const bf16x8 a = {lo[0], lo[1], lo[2], lo[3], hh[0], hh[1], hh[2], hh[3]}; \
                    o[d] = __builtin_amdgcn_mfma_f32_32x32x16_bf16(a, P0, o[d], 0, 0, 0); } \
            _Pragma("unroll") for (int d = 0; d < 4; ++d) { \
                    const s16x4 lo = vtr(vp + 4096 + d * 512), hh = vtr(vp + 4096 + 2048 + d * 512); \
                    const bf16x8 a = {lo[0], lo[1], lo[2], lo[3], hh[0], hh[1], hh[2], hh[3]}; \
                    o[d] = __builtin_amdgcn_mfma_f32_32x32x16_bf16(a, P1, o[d], 0, 0, 0); } } while (0)
#define ATT_VF(j_) ({ const int d_ = (j_) & 3, h_ = (j_) >> 2; const s16x4 lo_ = vtr(vp_s + h_ * 4096 + d_ * 512), hh_ = vtr(vp_s + h_ * 4096 + 2048 + d_ * 512); \
        bf16x8 a_ = {lo_[0], lo_[1], lo_[2], lo_[3], hh_[0], hh_[1], hh_[2], hh_[3]}; a_; })
#define ATT_PV1(j_, vf_, P0, P1) o[(j_) & 3] = __builtin_amdgcn_mfma_f32_32x32x16_bf16(vf_, ((j_) < 4 ? P0 : P1), o[(j_) & 3], 0, 0, 0)
#define ATT_E(r_) pe[r_] = __builtin_amdgcn_exp2f((float)Ain_[r_] * CSC)
#define ATT_HALF(A, koff_, P0, P1, voff_, AinV, Pout0, Pout1) do { \
        ATT_LAS const unsigned char* kp_s = lds + (koff_); ATT_LAS const unsigned char* vp_s = lds + (voff_) + vbase; const i32x16 Ain_ = AinV; float pe[16]; \
        i32x4 kf = *(ATT_LAS const i32x4*)(kp_s + ko[0]); bf16x8 va_ = ATT_VF(0), vb_ = ATT_VF(1); \
        __builtin_amdgcn_sched_barrier(0); \
        { const i32x16 z = {0, 0, 0, 0, 0, 0, 0, 0, 0, 0, 0, 0, 0, 0, 0, 0}; A = __builtin_amdgcn_mfma_i32_32x32x32_i8(kf, qf[0], z, 0, 0, 0); } asm volatile("" : "+v"(A)); ATT_PV1(0, va_, P0, P1); ATT_PV1(1, vb_, P0, P1); \
        kf = *(ATT_LAS const i32x4*)(kp_s + ko[1]); va_ = ATT_VF(2); ATT_E(0); ATT_E(1); ATT_E(2); \
        __builtin_amdgcn_sched_barrier(0); \
        A = __builtin_amdgcn_mfma_i32_32x32x32_i8(kf, qf[1], A, 0, 0, 0); asm volatile("" : "+v"(A)); ATT_PV1(2, va_, P0, P1); \
        kf = *(ATT_LAS const i32x4*)(kp_s + ko[2]); va_ = ATT_VF(3); ATT_E(3); ATT_E(4); ATT_E(5); \
        __builtin_amdgcn_sched_barrier(0); \
        A = __builtin_amdgcn_mfma_i32_32x32x32_i8(kf, qf[2], A, 0, 0, 0); asm volatile("" : "+v"(A)); ATT_PV1(3, va_, P0, P1); \
        kf = *(ATT_LAS const i32x4*)(kp_s + ko[3]); va_ = ATT_VF(4); vb_ = ATT_VF(5); ATT_E(6); ATT_E(7); \
        { u32x4 w = {cvtpk(pe[0], pe[1]), cvtpk(pe[2], pe[3]), cvtpk(pe[4], pe[5]), cvtpk(pe[6], pe[7])}; Pout0 = __builtin_bit_cast(bf16x8, w); } \
        __builtin_amdgcn_sched_barrier(0); \
        A = __builtin_amdgcn_mfma_i32_32x32x32_i8(kf, qf[3], A, 0, 0, 0); asm volatile("" : "+v"(A)); ATT_PV1(4, va_, P0, P1); ATT_PV1(5, vb_, P0, P1); \
        kf = *(ATT_LAS const i32x4*)(kp_s + ko[4]); va_ = ATT_VF(6); ATT_E(8); ATT_E(9); ATT_E(10); \
        __builtin_amdgcn_sched_barrier(0); \
        A = __builtin_amdgcn_mfma_i32_32x32x32_i8(kf, qf[4], A, 0, 0, 0); asm volatile("" : "+v"(A)); ATT_PV1(6, va_, P0, P1); \
        kf = *(ATT_LAS const i32x4*)(kp_s + ko[5]); va_ = ATT_VF(7); ATT_E(11); ATT_E(12); ATT_E(13); \
        __builtin_amdgcn_sched_barrier(0); \
        A = __builtin_amdgcn_mfma_i32_32x32x32_i8(kf, qf[5], A, 0, 0, 0); asm volatile("" : "+v"(A)); ATT_PV1(7, va_, P0, P1); \
        ATT_E(14); ATT_E(15); \
        { u32x4 w = {cvtpk(pe[8], pe[9]), cvtpk(pe[10], pe[11]), cvtpk(pe[12], pe[13]), cvtpk(pe[14], pe[15])}; Pout1 = __builtin_bit_cast(bf16x8, w); } \
        { float ps = 0.f; _Pragma("unroll") for (int r = 0; r < 16; ++r) ps += pe[r]; l_run += ps; } \
        __builtin_amdgcn_sched_barrier(0); } while (0)
    { i32x16 aX, aY; bf16x8 pX0, pX1, pY0, pY1;
      for (int t = -1; t <= NT; ++t) {
          if (t + 2 < NT) asm volatile("s_waitcnt vmcnt(4) lgkmcnt(0)\n\ts_barrier" ::: "memory");
          else if (t + 1 < NT) asm volatile("s_waitcnt vmcnt(2) lgkmcnt(0)\n\ts_barrier" ::: "memory");
          else asm volatile("s_waitcnt vmcnt(0) lgkmcnt(0)\n\ts_barrier" ::: "memory");
          if (t + 3 < NT) ATT_DMA_K(t + 3, ((t + 3) & 3) * KT_BYTES);
          if (t + 2 < NT) ATT_DMA_V(t + 2, 4 * KT_BYTES + ((t + 2) & 3) * VT_BYTES);
          const int kc = (t & 3) * KT_BYTES + 32 * 256, kn = ((t + 1) & 3) * KT_BYTES;
          const int vp_ = 4 * KT_BYTES + ((t - 1) & 3) * VT_BYTES + 2 * 4096, vc = 4 * KT_BYTES + (t & 3) * VT_BYTES;
          const bool act = (t >= 0 && t < my_nt), v0 = (t >= 1 && t <= my_nt), q1 = (t + 1 < my_nt);
          if (act && v0 && q1) {
              ATT_HALF(aY, kc, pY0, pY1, vp_, aX, pX0, pX1);
              ATT_HALF(aX, kn, pX0, pX1, vc, aY, pY0, pY1);
          } else {
              if (act) ATT_QKH(aY, kc);
              if (v0) ATT_PVH(pY0, pY1, vp_);
              if (act) ATT_EXPH(aX, pX0, pX1);
              __builtin_amdgcn_sched_barrier(0);
              if (q1) ATT_QKH(aX, kn);
              if (act) { ATT_PVH(pX0, pX1, vc); ATT_EXPH(aY, pY0, pY1); }
              __builtin_amdgcn_sched_barrier(0);
          }
      } }
#undef ATT_HALF
#undef ATT_E
#undef ATT_PV1
#undef ATT_VF
#undef ATT_PVH
#undef ATT_EXPH
#undef ATT_QKH
    l_run = xhalf_sum(l_run);
#undef ATT_STEP
#undef ATT_STAGES
#undef ATT_CHUNK
#undef ATT_QK1
    { const int spos = q0 + 32 * wid + c; const float sc = pg8::o_row_scale(spos) / l_run;
      unsigned char* op = (unsigned char*)O + (row0 + spos) * 2048 + h * HV;
#pragma unroll
      for (int d = 0; d < 4; ++d)
          { u32x4 w;
#pragma unroll
            for (int j = 0; j < 2; ++j) { const int g0 = j, g1 = j + 2;
              const unsigned w0 = pg8::q8x4(o[d][4 * g0] * sc, o[d][4 * g0 + 1] * sc, o[d][4 * g0 + 2] * sc, o[d][4 * g0 + 3] * sc);
              const unsigned w1 = pg8::q8x4(o[d][4 * g1] * sc, o[d][4 * g1 + 1] * sc, o[d][4 * g1 + 2] * sc, o[d][4 * g1 + 3] * sc);
              auto rr = __builtin_amdgcn_permlane32_swap(w0, w1, false, false);
              if (j == 0) { w.x = rr[0]; w.y = rr[1]; } else { w.z = rr[0]; w.w = rr[1]; } }
            *(u32x4*)(op + 32 * d + (hi ? 16 : 0)) = w; } }
#undef ATT_DMA_K
#undef ATT_DMA_V
}
__device__ __forceinline__ void attn_phase(ATT_LAS unsigned char* lds, const bf16_t* Q, const bf16_t* KV, bf16_t* O, const float* qn, const float* CS, unsigned* queues, int xcc) {
    ATT_LAS unsigned* tk = (ATT_LAS unsigned*)(lds + LDS_BYTES);
    for (int s = 0; s < 8; ++s) {
        const int qx = (xcc + s) & 7;
        for (;;) {
            if (threadIdx.x == 0) *tk = __hip_atomic_fetch_add(queues + 64 * qx, 1u, __ATOMIC_RELAXED, __HIP_MEMORY_SCOPE_AGENT);
            asm volatile("s_waitcnt vmcnt(0) lgkmcnt(0)\n\ts_barrier" ::: "memory");
            const unsigned pr = (unsigned)__builtin_amdgcn_readfirstlane((int)*tk);
            asm volatile("s_waitcnt lgkmcnt(0)\n\ts_barrier" ::: "memory");
            if (pr >= 128u) break;
            const int pair = qx * 128 + (int)pr, bh = pair >> 3, x = pair & 7, b = bh >> 4, h = bh & 15;
#pragma nounroll
            for (int u = 0; u < 2; ++u) attn_unit(lds, Q, KV, O, qn, CS, b, h, u ? x : 15 - x);
        }
    }
    asm volatile("s_waitcnt vmcnt(0) lgkmcnt(0)\n\ts_barrier" ::: "memory");
}
}
#ifndef MK_MULTI
#define MK_MULTI 0
#endif
constexpr int NWAVES = 8;
constexpr int T = 32768, DM = 2048, SEQ = 4096, NB = 8, NH = 16;
constexpr int NPHASE = 20;
constexpr float EPS = 1e-6f;
constexpr int PSLOTS = 81920;
constexpr size_t MiB = 1u << 20;
constexpr size_t WS_CTL = 0, CTL_ZERO_BYTES = 1 * MiB;
constexpr size_t WS_WIN = 1 * MiB;
constexpr size_t WS_WQ = 6 * MiB;
constexpr size_t WS_WKV = 9 * MiB;
constexpr size_t WS_WO = 13 * MiB;
constexpr size_t WS_PWIN = 21 * MiB;
constexpr size_t WS_WG = 29 * MiB;
constexpr size_t WS_PWO = 31 * MiB;
constexpr size_t WS_RW = 39 * MiB;
constexpr size_t WS_CS = 41 * MiB;
constexpr size_t WS_GUT = 50 * MiB;
constexpr size_t WS_DT = 562 * MiB;
constexpr size_t WS_XB0 = 818 * MiB;
constexpr size_t WS_LOG = 946 * MiB;
constexpr size_t WS_MISC = 956 * MiB;
constexpr size_t WS_U = 960 * MiB;
constexpr size_t WS_C = WS_U, WS_CQ = WS_U + 80 * MiB, WS_CKV = WS_U + 112 * MiB, WS_Q = WS_U + 144 * MiB, WS_KV = WS_U + 336 * MiB, WS_O = WS_U + 656 * MiB;
constexpr size_t WS_CQ8 = WS_U + 80 * MiB;
constexpr size_t WS_XQ = WS_U;
constexpr size_t WS_XS = WS_U, WS_H = WS_U + 320 * MiB, WS_Y = WS_U + 400 * MiB;
constexpr size_t WS_LOG1 = WS_U + 736 * MiB;
constexpr size_t WS_SSQC = WS_U + 746 * MiB;
constexpr size_t WS_UU = WS_U, WS_PM = WS_U + 128 * MiB, WS_Y2 = WS_U + 256 * MiB;
constexpr size_t WS_XB1 = WS_U + 784 * MiB;
constexpr size_t WS_SSQP = WS_XB1 + 128 * MiB;
constexpr size_t WS_WPT = WS_SSQP + 4 * MiB;
constexpr size_t WS_END = WS_WPT + 8 * MiB;
constexpr size_t MS_TOKE = 0;
constexpr size_t MS_TOKW = 256 * 1024;
constexpr size_t MS_SLOT = 512 * 1024;
constexpr size_t MS_BC = 768 * 1024;
constexpr size_t MS_TILE = 896 * 1024;
constexpr size_t MS_RSTD0 = 1024 * 1024;
constexpr size_t MS_RSTD2 = 1152 * 1024;
constexpr size_t MS_RSTOK = 1280 * 1024;
constexpr size_t MS_RSSLOT = 1408 * 1024;
constexpr size_t MS_STOK = 1792 * 1024;
constexpr int CW_BAR = 4096;
constexpr int CW_ATTQ = 8192;
constexpr int CW_CONVQ = 8192 + 1024;
constexpr int NCONV = 6;

#define GAS __attribute__((address_space(1)))
#define LAS __attribute__((address_space(3)))
typedef unsigned short bf16;
typedef unsigned v4u __attribute__((ext_vector_type(4)));
typedef unsigned v2u __attribute__((ext_vector_type(2)));
typedef float f32x4 __attribute__((ext_vector_type(4)));
#define RLX_AGENT __ATOMIC_RELAXED, __HIP_MEMORY_SCOPE_AGENT
__device__ __forceinline__ unsigned pk2(float lo, float hi) { return pg8::cvt_pk_bf16(lo, hi); }
__device__ __forceinline__ float bf_lo(unsigned w) { return __uint_as_float(w << 16); }
__device__ __forceinline__ float bf_hi(unsigned w) { return __uint_as_float(w & 0xffff0000u); }

#define XB_TMO      128
#define XB_XCNT(j)  (256  + 64 * (j))
#define XB_XSUB(j)  (1280 + 64 * (j))
#define XB_XGEN(j)  (2304 + 64 * (j))
#define XB_TOP      3328
#define XB_TOPGEN   3392
#define XCD_BAR_WORDS 3456
#define XB_SPIN_CAP (1u << 18)
__device__ __forceinline__ unsigned xb_ld(unsigned* p)              { return __hip_atomic_load(p, __ATOMIC_RELAXED, __HIP_MEMORY_SCOPE_AGENT); }
__device__ __forceinline__ unsigned xb_add(unsigned* p, unsigned v) { return __hip_atomic_fetch_add(p, v, __ATOMIC_RELAXED, __HIP_MEMORY_SCOPE_AGENT); }
__device__ __forceinline__ unsigned xb_xcc_id() { return (unsigned)__builtin_amdgcn_s_getreg((3 << 11) | 20) & 0xFu; }
#define XB_SPIN(cond, bar) do { unsigned _sp = 0; while (cond) { __builtin_amdgcn_s_sleep(1); \
    if ((++_sp & 255u) == 0u) { if (xb_ld(&(bar)[XB_TMO])) break; if (_sp > XB_SPIN_CAP) { atomicAdd(&(bar)[XB_TMO], 1u); break; } } } } while (0)
struct XcdBarrier { unsigned* bar; unsigned x; volatile LAS unsigned* st; };
__device__ __forceinline__ XcdBarrier xcd_barrier_post(unsigned* bar, volatile LAS unsigned* st) {
    XcdBarrier b; b.bar = bar; b.x = xb_xcc_id(); b.st = st;
    if (threadIdx.x == 0) (void)xb_add(&bar[XB_XCNT(b.x)], 1u);
    return b;
}
__device__ __forceinline__ void xcd_barrier_complete(unsigned* bar, unsigned x, unsigned& nloc, unsigned& nx) {
    const unsigned G = gridDim.x * gridDim.y * gridDim.z;
    unsigned sum, cnt, mine, sp = 0u;
    for (;;) {
        sum = 0u; cnt = 0u; mine = 0u;
#pragma unroll
        for (unsigned j = 0; j < 16; ++j) { const unsigned c = xb_ld(&bar[XB_XCNT(j)]); sum += c; cnt += (c > 0u) ? 1u : 0u; mine = (j == x) ? c : mine; }
        if (sum == G) break;
        __builtin_amdgcn_s_sleep(1);
        if ((++sp & 255u) == 0u) { if (xb_ld(&bar[XB_TMO])) break; if (sp > XB_SPIN_CAP) { atomicAdd(&bar[XB_TMO], 1u); break; } }
    }
    nloc = mine > 0u ? mine : 1u; nx = cnt > 0u ? cnt : 1u;
}
__device__ __forceinline__ void xcd_barrier(const XcdBarrier& b) {
    asm volatile("s_waitcnt vmcnt(0)" ::: "memory");
    __syncthreads();
    if (threadIdx.x == 0) {
        unsigned* bar = b.bar;
        __builtin_amdgcn_s_waitcnt(0);
        unsigned nloc = b.st[0], nx = b.st[1];
        if (nloc == 0u) { xcd_barrier_complete(bar, b.x, nloc, nx); b.st[0] = nloc; b.st[1] = nx; }
        const unsigned old = xb_add(&bar[XB_XSUB(b.x)], 1u);
        const unsigned gen = old / nloc;
        if (old + 1u == (gen + 1u) * nloc) {
            __builtin_amdgcn_fence(__ATOMIC_RELEASE, "agent");
            asm volatile("s_waitcnt vmcnt(0)" ::: "memory");
            const unsigned og = xb_add(&bar[XB_TOP], 1u);
            const unsigned tg = og / nx;
            if (og + 1u == (tg + 1u) * nx) xb_add(&bar[XB_TOPGEN], 1u);
            else XB_SPIN(xb_ld(&bar[XB_TOPGEN]) == tg, bar);
            __builtin_amdgcn_fence(__ATOMIC_ACQUIRE, "agent");
            xb_add(&bar[XB_XGEN(b.x)], 1u);
            asm volatile("s_waitcnt vmcnt(0)" ::: "memory");
        } else {
            XB_SPIN(xb_ld(&bar[XB_XGEN(b.x)]) == gen, bar);
            __builtin_amdgcn_fence(__ATOMIC_ACQUIRE, "agent");
            asm volatile("s_waitcnt vmcnt(0)" ::: "memory");
        }
    }
    __syncthreads();
}

__device__ __forceinline__ void ld8(const bf16* p, float (&v)[8]) { const v4u a = *(const v4u*)p;
    v[0] = bf_lo(a.x); v[1] = bf_hi(a.x); v[2] = bf_lo(a.y); v[3] = bf_hi(a.y); v[4] = bf_lo(a.z); v[5] = bf_hi(a.z); v[6] = bf_lo(a.w); v[7] = bf_hi(a.w); }
#define SWZ_XOR(k) (((k) << 10) | 0x1F)
__device__ __forceinline__ float wave_sum(float v) {
    v += __int_as_float(__builtin_amdgcn_ds_swizzle(__float_as_int(v), SWZ_XOR(1)));
    v += __int_as_float(__builtin_amdgcn_ds_swizzle(__float_as_int(v), SWZ_XOR(2)));
    v += __int_as_float(__builtin_amdgcn_ds_swizzle(__float_as_int(v), SWZ_XOR(4)));
    v += __int_as_float(__builtin_amdgcn_ds_swizzle(__float_as_int(v), SWZ_XOR(8)));
    v += __int_as_float(__builtin_amdgcn_ds_swizzle(__float_as_int(v), SWZ_XOR(16)));
    auto rr = __builtin_amdgcn_permlane32_swap(__float_as_uint(v), __float_as_uint(v), false, false);
    return __uint_as_float(rr[0]) + __uint_as_float(rr[1]);
}
struct Ctx { LAS unsigned char* lds; int tid, lane, wave, vcu, G, gw, NGW, bx; };
__device__ __forceinline__ Ctx make_ctx(LAS unsigned char* lds) {
    Ctx X; X.lds = lds;
    int tid = threadIdx.x, G = gridDim.x, bx = blockIdx.x; asm volatile("" : "+v"(tid)); asm volatile("" : "+s"(G), "+s"(bx));
    X.tid = tid; X.lane = tid & 63; X.wave = __builtin_amdgcn_readfirstlane(tid >> 6); X.G = G; X.bx = bx;
    X.vcu = (G % 8 == 0) ? (bx % 8) * (G / 8) + bx / 8 : bx;
    X.gw = X.vcu * NWAVES + X.wave; X.NGW = G * NWAVES;
    return X;
}

__device__ __forceinline__ void tr_item(const float* __restrict__ W, int N, bf16* __restrict__ WT, int ldk, int k0, int n0, int orow0, const float* __restrict__ kscale, int lane) {
    const int c = lane & 15, g = lane >> 4;
    const float* src = W + (size_t)(k0 + 8 * g) * N + n0 + 4 * c;
    f32x4 v[2][8];
#pragma unroll
    for (int hh = 0; hh < 2; ++hh)
#pragma unroll
        for (int j = 0; j < 8; ++j) v[hh][j] = *(const f32x4*)(src + (size_t)(32 * hh + j) * N);
    if (kscale) {
#pragma unroll
        for (int hh = 0; hh < 2; ++hh) { const f32x4 s0 = *(const f32x4*)(kscale + k0 + 32 * hh + 8 * g), s1 = *(const f32x4*)(kscale + k0 + 32 * hh + 8 * g + 4);
#pragma unroll
            for (int j = 0; j < 8; ++j) v[hh][j] = v[hh][j] * (j < 4 ? s0[j & 3] : s1[j & 3]); }
    }
#pragma unroll
    for (int hh = 0; hh < 2; ++hh)
#pragma unroll
        for (int jj = 0; jj < 4; ++jj) {
            v4u o; o.x = pk2(v[hh][0][jj], v[hh][1][jj]); o.y = pk2(v[hh][2][jj], v[hh][3][jj]); o.z = pk2(v[hh][4][jj], v[hh][5][jj]); o.w = pk2(v[hh][6][jj], v[hh][7][jj]);
            *(v4u*)(WT + (size_t)(orow0 + 4 * c + jj) * ldk + k0 + 32 * hh + 8 * g) = o;
        }
}
__device__ __forceinline__ float store_row_rstd(const f32x4 (&v)[8], bf16* __restrict__ orow, int lane) {
    float s = 0.f;
#pragma unroll
    for (int j = 0; j < 8; ++j) s += (v[j][0] * v[j][0] + v[j][1] * v[j][1]) + (v[j][2] * v[j][2] + v[j][3] * v[j][3]);
#pragma unroll
    for (int j = 0; j < 8; ++j) { v2u w; w.x = pk2(v[j][0], v[j][1]); w.y = pk2(v[j][2], v[j][3]); *(v2u*)(orow + 4 * lane + 256 * j) = w; }
    return 1.0f / sqrtf(wave_sum(s) * (1.0f / DM) + EPS);
}

struct Params {
    const float* in[23]; float* out; unsigned char* ws; int ph_lo, ph_hi;
};
typedef const __attribute__((address_space(4))) Params* KP;
__device__ __forceinline__ KP kargs() { KP k = (KP)__builtin_amdgcn_kernarg_segment_ptr(); asm volatile("" : "+s"(k)); return k; }

constexpr int MOE_ITEMS = 128 * 768, CONV_CHUNK = 8, CONV_TICKETS = MOE_ITEMS / CONV_CHUNK;
struct TrJob { const float* W; unsigned char* WT; int N, ldk, k0, n0, orow0; float scale; const float* ks; };
constexpr float QS_Q = 16.f;
constexpr float QS_Y = 32.f;
constexpr float QS_A = 16.f, QS_WGU = 1024.f, QS_H = 16.f, QS_WD = 512.f, QS_X = 16.f, QS_WIN = 1024.f, QS_C = 16.f, QS_WQK = 512.f;
__device__ __forceinline__ TrJob moe_job(KP p, int r) {
    unsigned char* GUT = (unsigned char*)(p->ws + WS_GUT); unsigned char* DT = (unsigned char*)(p->ws + WS_DT);
    const int le = r / 768, rr = r % 768, which = rr / 256, id = rr % 256; TrJob j;
    if (which < 2) { const int kb = id / 16, nb = id % 16, n0 = 32 * nb;
        j.W = p->in[20 + which] + (size_t)le * 2048 * 512; j.N = 512; j.WT = GUT + (size_t)le * 1024 * 2048; j.ldk = 2048; j.k0 = 128 * kb; j.n0 = n0; j.orow0 = 256 * (n0 >> 7) + (n0 & 127) + 128 * which; j.scale = QS_WGU; j.ks = nullptr;
    } else { const int kb = id / 64, nb = id % 64;
        j.W = p->in[22] + (size_t)le * 512 * 2048; j.N = 2048; j.WT = DT + (size_t)le * 2048 * 512; j.ldk = 512; j.k0 = 128 * kb; j.n0 = 32 * nb; j.orow0 = 32 * nb; j.scale = QS_WD; j.ks = nullptr; }
    return j;
}
__device__ __forceinline__ void tr_load(const TrJob& j, f32x4 (&v)[16], int lane) {
    const int c = lane & 7, g = lane >> 3; const float* src = j.W + (size_t)(j.k0 + 16 * g) * j.N + j.n0 + 4 * c;
#pragma unroll
    for (int q = 0; q < 16; ++q) v[q] = __builtin_nontemporal_load((const f32x4*)(src + (size_t)q * j.N));
}
__device__ __forceinline__ void tr_store(const TrJob& j, f32x4 (&v)[16], int lane) {
    const int c = lane & 7, g = lane >> 3;
    if (j.ks) {
#pragma unroll
        for (int q4 = 0; q4 < 4; ++q4) { const f32x4 s = *(const f32x4*)(j.ks + j.k0 + 16 * g + 4 * q4);
#pragma unroll
            for (int e = 0; e < 4; ++e) v[4 * q4 + e] = v[4 * q4 + e] * s[e]; } }
#pragma unroll
    for (int jj = 0; jj < 4; ++jj) {
        v4u o; o.x = pg8::q8x4(v[0][jj] * j.scale, v[1][jj] * j.scale, v[2][jj] * j.scale, v[3][jj] * j.scale); o.y = pg8::q8x4(v[4][jj] * j.scale, v[5][jj] * j.scale, v[6][jj] * j.scale, v[7][jj] * j.scale);
        o.z = pg8::q8x4(v[8][jj] * j.scale, v[9][jj] * j.scale, v[10][jj] * j.scale, v[11][jj] * j.scale); o.w = pg8::q8x4(v[12][jj] * j.scale, v[13][jj] * j.scale, v[14][jj] * j.scale, v[15][jj] * j.scale);
        *(v4u*)(j.WT + (size_t)(j.orow0 + 4 * c + jj) * j.ldk + j.k0 + 16 * g) = o;
    }
}
__device__ __forceinline__ void moe_convert_drain(KP p, unsigned* q, int lane) {
    for (;;) {
        unsigned t = 0u; if (lane == 0) t = __hip_atomic_fetch_add(q, 1u, RLX_AGENT);
        t = (unsigned)__builtin_amdgcn_readfirstlane((int)t);
        if (t >= (unsigned)CONV_TICKETS) break;
        for (int i = 0; i < CONV_CHUNK; i += 2) {
            const TrJob ja = moe_job(p, (int)t * CONV_CHUNK + i), jb = moe_job(p, (int)t * CONV_CHUNK + i + 1);
            f32x4 va[16], vb[16]; tr_load(ja, va, lane); tr_load(jb, vb, lane); tr_store(ja, va, lane); tr_store(jb, vb, lane); }
    }
}

__device__ __forceinline__ void phase_prologue(const Ctx& X, KP p) {
    unsigned char* ws = p->ws;
    bf16* WinT = (bf16*)(ws + WS_WIN); bf16* WqT = (bf16*)(ws + WS_WQ); bf16* WkvT = (bf16*)(ws + WS_WKV); bf16* WoT = (bf16*)(ws + WS_WO);
    bf16* PwinT = (bf16*)(ws + WS_PWIN); bf16* WgT = (bf16*)(ws + WS_WG); bf16* PwoT = (bf16*)(ws + WS_PWO); bf16* RW = (bf16*)(ws + WS_RW);
    float* CS = (float*)(ws + WS_CS); bf16* XB0 = (bf16*)(ws + WS_XB0); float* RSTD0 = (float*)(ws + WS_MISC + MS_RSTD0);
    constexpr int I_WIN = 16 * 34, I_WQ = 4 * 96, I_WKV = 4 * 128, I_SQ = 32 * 32, I_WG = 4 * 64;
    constexpr int NITEMS = I_WIN + I_WQ + I_WKV + 2 * I_SQ + I_WG;
    const int lane = X.lane;
#pragma clang loop unroll(disable)
    for (int it = X.gw; it < NITEMS; it += X.NGW) {
        int r = it;
        if (r < I_WIN) { const int kb = r / 34, nb = r % 34; TrJob j{p->in[3], (unsigned char*)WinT, 1088, 2048, 128 * kb, 32 * nb, 32 * nb, QS_WIN, p->in[2]}; f32x4 v[16]; tr_load(j, v, lane); tr_store(j, v, lane); continue; } r -= I_WIN;
        if (r < I_WQ) { const int kb = r / 96, nb = r % 96; TrJob j{p->in[6], (unsigned char*)WqT, 3072, 512, 128 * kb, 32 * nb, 32 * nb, QS_WQK, p->in[4]}; f32x4 v[16]; tr_load(j, v, lane); tr_store(j, v, lane); continue; } r -= I_WQ;
        if (r < I_WKV) { const int kb = r / 128, nb = r % 128; TrJob j{p->in[7], (unsigned char*)WkvT, 4096, 512, 128 * kb, 32 * nb, 32 * nb, QS_WQK, p->in[5]}; f32x4 v[16]; tr_load(j, v, lane); tr_store(j, v, lane); continue; } r -= I_WKV;
        if (r < I_SQ) { const int kb = r / 64, nb = r % 64; TrJob j{p->in[10], (unsigned char*)WoT, 2048, 2048, 128 * kb, 32 * nb, 32 * nb, QS_WIN, nullptr}; f32x4 v[16]; tr_load(j, v, lane); tr_store(j, v, lane); continue; } r -= I_SQ;
        if (r < I_SQ) { const int kb = r / 32, nb = r % 32; tr_item(p->in[14], 2048, PwoT, 2048, 64 * kb, 64 * nb, 64 * nb, nullptr, lane); continue; } r -= I_SQ;
        if (r < I_WG) { const int g = r / 64, q = r % 64, kb = q / 8, nb = q % 8; tr_item(p->in[12] + (size_t)g * 512 * 512, 512, WgT, 512, 64 * kb, 64 * nb, g * 512 + 64 * nb, nullptr, lane); }
    }
    const int gt = X.vcu * (NWAVES * 64) + X.tid, NGT = X.G * NWAVES * 64;
    for (int i = gt; i < 2048 * 2048 / 8; i += NGT) { const f32x4 a = *(const f32x4*)(p->in[11] + (size_t)i * 8), b = *(const f32x4*)(p->in[11] + (size_t)i * 8 + 4);
        v4u o; o.x = pk2(a[0], a[1]); o.y = pk2(a[2], a[3]); o.z = pk2(b[0], b[1]); o.w = pk2(b[2], b[3]); *(v4u*)(PwinT + (size_t)i * 8) = o; }
    for (int i = gt; i < 192 * 128; i += NGT) *(v4u*)((unsigned char*)WinT + (size_t)1088 * 2048 + (size_t)i * 16) = (v4u){0u, 0u, 0u, 0u};
    for (int i = gt; i < 2 * 256 * 256; i += NGT) {
        const int l = i >> 16, n = (i >> 8) & 255, k0 = (i & 255) * 8; float v[8];
#pragma unroll
        for (int j = 0; j < 8; ++j) v[j] = (n < 8 ? p->in[16][((size_t)l * 2048 + k0 + j) * 8 + n] : (n < 72 ? p->in[18][((size_t)l * 2048 + k0 + j) * 64 + (n - 8)] : 0.f)) * p->in[15][l * 2048 + k0 + j];
        v4u o; o.x = pk2(v[0], v[1]); o.y = pk2(v[2], v[3]); o.z = pk2(v[4], v[5]); o.w = pk2(v[6], v[7]);
        *(v4u*)(RW + ((size_t)l * 256 + n) * 2048 + k0) = o;
    }
    { const int* pos = (const int*)p->in[1];
      for (int i = gt; i < T * 32; i += NGT) { const int t = i >> 5, j = i & 31;
          const float inv_freq = __builtin_amdgcn_exp2f(-(float)j * 0.41524101186092029f);
          const float ang = (float)pos[t] * inv_freq;
          double rev = (double)ang * 0.15915494309189535; rev -= rint(rev);
          const float xr = (float)rev;
          CS[(size_t)t * 64 + j] = __builtin_amdgcn_cosf(xr); CS[(size_t)t * 64 + 32 + j] = __builtin_amdgcn_sinf(xr); } }
#pragma clang loop unroll(disable)
    for (int m = X.gw; m < T; m += X.NGW) { const float* xr = p->in[0] + (size_t)m * DM; f32x4 v[8];
#pragma unroll
        for (int j = 0; j < 8; ++j) v[j] = *(const f32x4*)(xr + 4 * lane + 256 * j);
        const float rs = store_row_rstd(v, XB0 + (size_t)m * DM, lane);
        if (lane == 0) RSTD0[m] = rs;
        unsigned char* xq0 = (unsigned char*)(p->ws + WS_XB1) + (size_t)m * DM;
#pragma unroll
        for (int j = 0; j < 8; ++j) *(unsigned*)(xq0 + 4 * lane + 256 * j) = pg8::q8x4(v[j][0] * QS_X, v[j][1] * QS_X, v[j][2] * QS_X, v[j][3] * QS_X); }
}

__device__ __forceinline__ void phase_latent(const Ctx& X, KP p) {
    const bf16* C = (const bf16*)(p->ws + WS_C); bf16* CQ = (bf16*)(p->ws + WS_CQ); bf16* CKV = (bf16*)(p->ws + WS_CKV);
    const int lane = X.lane;
#pragma clang loop unroll(disable)
    for (int t = X.gw; t < T; t += X.NGW) {
        const v4u a = *(const v4u*)(C + (size_t)t * 1280 + 8 * lane), b = *(const v4u*)(C + (size_t)t * 1280 + 512 + 8 * lane);
        float xa[8] = {bf_lo(a.x), bf_hi(a.x), bf_lo(a.y), bf_hi(a.y), bf_lo(a.z), bf_hi(a.z), bf_lo(a.w), bf_hi(a.w)};
        float xb[8] = {bf_lo(b.x), bf_hi(b.x), bf_lo(b.y), bf_hi(b.y), bf_lo(b.z), bf_hi(b.z), bf_lo(b.w), bf_hi(b.w)};
        float sa = 0.f, sb = 0.f;
#pragma unroll
        for (int j = 0; j < 8; ++j) { sa += xa[j] * xa[j]; sb += xb[j] * xb[j]; }
        const float ra = 1.0f / sqrtf(wave_sum(sa) * (1.0f / 512.f) + EPS), rb = 1.0f / sqrtf(wave_sum(sb) * (1.0f / 512.f) + EPS);
        const f32x4 ga0 = *(const f32x4*)(p->in[4] + 8 * lane), ga1 = *(const f32x4*)(p->in[4] + 8 * lane + 4);
        const f32x4 gb0 = *(const f32x4*)(p->in[5] + 8 * lane), gb1 = *(const f32x4*)(p->in[5] + 8 * lane + 4);
        v4u oa, ob;
        oa.x = pk2(xa[0] * ra * ga0[0], xa[1] * ra * ga0[1]); oa.y = pk2(xa[2] * ra * ga0[2], xa[3] * ra * ga0[3]); oa.z = pk2(xa[4] * ra * ga1[0], xa[5] * ra * ga1[1]); oa.w = pk2(xa[6] * ra * ga1[2], xa[7] * ra * ga1[3]);
        ob.x = pk2(xb[0] * rb * gb0[0], xb[1] * rb * gb0[1]); ob.y = pk2(xb[2] * rb * gb0[2], xb[3] * rb * gb0[3]); ob.z = pk2(xb[4] * rb * gb1[0], xb[5] * rb * gb1[1]); ob.w = pk2(xb[6] * rb * gb1[2], xb[7] * rb * gb1[3]);
        *(v4u*)(CQ + (size_t)t * 512 + 8 * lane) = oa; *(v4u*)(CKV + (size_t)t * 512 + 8 * lane) = ob;
    }
}

__device__ __forceinline__ void phase_knorm(const Ctx& X, KP p) {
    bf16* KV = (bf16*)(p->ws + WS_KV); const bf16* C = (const bf16*)(p->ws + WS_C); const float* CS = (const float*)(p->ws + WS_CS); const float* gain = p->in[9];
    const int lane = X.lane, hd = lane >> 2, q = lane & 3;
    float gk[32], g1[8], g2[8];
#pragma unroll
    for (int i = 0; i < 32; ++i) gk[i] = gain[32 * q + i];
#pragma unroll
    for (int i = 0; i < 8; ++i) { g1[i] = gain[128 + 8 * q + i]; g2[i] = gain[160 + 8 * q + i]; }
#pragma clang loop unroll(disable)
    for (int t = X.gw; t < T; t += X.NGW) {
        bf16* kp = KV + (size_t)t * 5120 + hd * 320 + 32 * q;
        float kx[32], r1[8], r2[8];
#pragma unroll
        for (int i = 0; i < 4; ++i) { float v[8]; ld8(kp + 8 * i, v);
#pragma unroll
            for (int e = 0; e < 8; ++e) kx[8 * i + e] = v[e]; }
        ld8(C + (size_t)t * 1280 + 1024 + 8 * q, r1); ld8(C + (size_t)t * 1280 + 1056 + 8 * q, r2);
        float ss = 0.f;
#pragma unroll
        for (int i = 0; i < 32; ++i) ss += kx[i] * kx[i];
#pragma unroll
        for (int i = 0; i < 8; ++i) ss += r1[i] * r1[i] + r2[i] * r2[i];
        ss += __int_as_float(__builtin_amdgcn_ds_swizzle(__float_as_int(ss), SWZ_XOR(1))); ss += __int_as_float(__builtin_amdgcn_ds_swizzle(__float_as_int(ss), SWZ_XOR(2)));
        const float rstd = 1.0f / sqrtf(ss * (1.0f / 192.f) + EPS);
#pragma unroll
        for (int i = 0; i < 4; ++i) { v4u w;
            w.x = pk2(kx[8 * i] * rstd * gk[8 * i], kx[8 * i + 1] * rstd * gk[8 * i + 1]); w.y = pk2(kx[8 * i + 2] * rstd * gk[8 * i + 2], kx[8 * i + 3] * rstd * gk[8 * i + 3]);
            w.z = pk2(kx[8 * i + 4] * rstd * gk[8 * i + 4], kx[8 * i + 5] * rstd * gk[8 * i + 5]); w.w = pk2(kx[8 * i + 6] * rstd * gk[8 * i + 6], kx[8 * i + 7] * rstd * gk[8 * i + 7]);
            *(v4u*)(kp + 8 * i) = w; }
        const float* cs = CS + (size_t)t * 64 + 8 * q;
        const f32x4 c0 = *(const f32x4*)cs, c1 = *(const f32x4*)(cs + 4), s0 = *(const f32x4*)(cs + 32), s1 = *(const f32x4*)(cs + 36);
        float o1[8], o2[8];
#pragma unroll
        for (int e = 0; e < 8; ++e) { const float n1 = r1[e] * rstd * g1[e], n2 = r2[e] * rstd * g2[e], cc = e < 4 ? c0[e & 3] : c1[e & 3], sn = e < 4 ? s0[e & 3] : s1[e & 3];
            o1[e] = n1 * cc - n2 * sn; o2[e] = n2 * cc + n1 * sn; }
        v4u w1, w2; w1.x = pk2(o1[0], o1[1]); w1.y = pk2(o1[2], o1[3]); w1.z = pk2(o1[4], o1[5]); w1.w = pk2(o1[6], o1[7]);
        w2.x = pk2(o2[0], o2[1]); w2.y = pk2(o2[2], o2[3]); w2.z = pk2(o2[4], o2[5]); w2.w = pk2(o2[6], o2[7]);
        bf16* rp = KV + (size_t)t * 5120 + hd * 320 + 128 + 8 * q;
        *(v4u*)rp = w1; *(v4u*)(rp + 32) = w2;
    }
}

__device__ __forceinline__ unsigned dpp_x1(unsigned v) { return (unsigned)__builtin_amdgcn_mov_dpp((int)v, 0xB1, 0xF, 0xF, true); }
__device__ __forceinline__ unsigned dpp_x2(unsigned v) { return (unsigned)__builtin_amdgcn_mov_dpp((int)v, 0x4E, 0xF, 0xF, true); }
__device__ __forceinline__ void quad_tr(unsigned (&a)[4], int lane) {
    const bool o1 = lane & 1, o2 = lane & 2;
    unsigned b[4];
#pragma unroll
    for (int m = 0; m < 2; ++m) { const unsigned r = dpp_x1(o1 ? a[2 * m] : a[2 * m + 1]); b[2 * m] = o1 ? r : a[2 * m]; b[2 * m + 1] = o1 ? a[2 * m + 1] : r; }
#pragma unroll
    for (int j = 0; j < 2; ++j) { const unsigned r = dpp_x2(o2 ? b[j] : b[2 + j]); a[j] = o2 ? r : b[j]; a[2 + j] = o2 ? b[2 + j] : r; }
}
__device__ __forceinline__ void pair_tr(v2u& a0, v2u& a1, int lane) {
    const bool o1 = lane & 1; v2u s = o1 ? a0 : a1, r; r.x = dpp_x1(s.x); r.y = dpp_x1(s.y);
    if (o1) a0 = r; else a1 = r;
}
template <bool FINAL>
__device__ __forceinline__ void phase_combine(const Ctx& X, KP p, const bf16* __restrict__ xin, bf16* __restrict__ xout, float* __restrict__ rstd, float* __restrict__ outf) {
    const unsigned char* Y = (const unsigned char*)(p->ws + WS_Y); const int* SLOT = (const int*)(p->ws + WS_MISC + MS_SLOT); const float* TOKW = (const float*)(p->ws + WS_MISC + MS_TOKW);
    const int lane = X.lane;
    const int xo = 256 * (lane & 1) + 8 * (lane >> 1), yo = 256 * (lane & 3) + 16 * (lane >> 2);
    int m = X.gw; v2u nsl = {0u, 0u}, nwt = {0u, 0u};
    if (m < T) { nsl = *(const v2u*)((const unsigned*)SLOT + 2 * m); nwt = *(const v2u*)((const unsigned*)TOKW + 2 * m); }
#pragma clang loop unroll(disable)
    for (; m < T; m += X.NGW) {
        const int s0 = (int)nsl.x, s1 = (int)nsl.y; const float w0 = __uint_as_float(nwt.x), w1 = __uint_as_float(nwt.y);
        { const int mn = m + X.NGW < T ? m + X.NGW : m; nsl = *(const v2u*)((const unsigned*)SLOT + 2 * mn); nwt = *(const v2u*)((const unsigned*)TOKW + 2 * mn); }
        const bf16* xr = xin + (size_t)m * DM; const unsigned char* y0 = Y + (size_t)s0 * DM, * y1 = Y + (size_t)s1 * DM; f32x4 v[8];
        const float u0 = w0 * (1.0f / QS_Y), u1 = w1 * (1.0f / QS_Y);
        v4u xw[4], ya[2], yb[2];
#pragma unroll
        for (int g = 0; g < 4; ++g) xw[g] = *(const v4u*)(xr + 512 * g + xo);
#pragma unroll
        for (int g = 0; g < 2; ++g) { ya[g] = *(const v4u*)(y0 + 1024 * g + yo); yb[g] = *(const v4u*)(y1 + 1024 * g + yo); }
#pragma unroll
        for (int g = 0; g < 2; ++g) { unsigned a[4] = {ya[g].x, ya[g].y, ya[g].z, ya[g].w}, b[4] = {yb[g].x, yb[g].y, yb[g].z, yb[g].w}; quad_tr(a, lane); quad_tr(b, lane);
#pragma unroll
            for (int k = 0; k < 4; ++k) { const int j = 4 * g + k; v2u lo, hi; lo.x = xw[j >> 1].x; lo.y = xw[j >> 1].y; hi.x = xw[j >> 1].z; hi.y = xw[j >> 1].w;
                if ((k & 1) == 0) { pair_tr(lo, hi, lane); xw[j >> 1].x = lo.x; xw[j >> 1].y = lo.y; xw[j >> 1].z = hi.x; xw[j >> 1].w = hi.y; }
                v2u xv; xv.x = (k & 1) ? xw[j >> 1].z : xw[j >> 1].x; xv.y = (k & 1) ? xw[j >> 1].w : xw[j >> 1].y;
                const int aa = (int)a[k], bb = (int)b[k];
                f32x4 q;
                q[0] = bf_lo(xv.x) + (u0 * (float)((aa << 24) >> 24) + u1 * (float)((bb << 24) >> 24)); q[1] = bf_hi(xv.x) + (u0 * (float)((aa << 16) >> 24) + u1 * (float)((bb << 16) >> 24));
                q[2] = bf_lo(xv.y) + (u0 * (float)((aa << 8) >> 24) + u1 * (float)((bb << 8) >> 24)); q[3] = bf_hi(xv.y) + (u0 * (float)(aa >> 24) + u1 * (float)(bb >> 24));
                v[j] = q; if (FINAL) *(f32x4*)(outf + (size_t)m * DM + 4 * lane + 256 * j) = q; } }
        if (!FINAL) { const float rs = store_row_rstd(v, xout + (size_t)m * DM, lane); if (lane == 0) rstd[m] = rs; }
    }
}

__device__ __forceinline__ void phase_pool(const Ctx& X, KP p) {
    const bf16* U = (const bf16*)(p->ws + WS_UU); bf16* PM = (bf16*)(p->ws + WS_Y2); const float* scl = p->in[13];
    const int gt = X.vcu * (NWAVES * 64) + X.tid, NGT = X.G * NWAVES * 64;
#pragma clang loop unroll(disable)
    for (int task = gt; task < (T / 32) * 256; task += NGT) {
        const int run = task >> 8, cc = task & 255, col = cc * 8, w = 2 << (col >> 9);
        const int t0 = run * 32, s0 = t0 & (SEQ - 1);
        const f32x4 sc0 = *(const f32x4*)(scl + col), sc1 = *(const f32x4*)(scl + col + 4);
        float sum[8];
#pragma unroll
        for (int e = 0; e < 8; ++e) sum[e] = 0.f;
        { v4u wu[16];
#pragma unroll
          for (int j = 0; j < 16; ++j) { const int i = s0 - 1 - j; const bool ok = (j < w) && (i >= 0); wu[j] = *(const v4u*)(U + (size_t)(ok ? t0 - s0 + i : t0) * DM + col); }
#pragma unroll
          for (int j = 0; j < 16; ++j) { const int i = s0 - 1 - j; const bool ok = (j < w) && (i >= 0);
              if (ok) { sum[0] += bf_lo(wu[j].x); sum[1] += bf_hi(wu[j].x); sum[2] += bf_lo(wu[j].y); sum[3] += bf_hi(wu[j].y); sum[4] += bf_lo(wu[j].z); sum[5] += bf_hi(wu[j].z); sum[6] += bf_lo(wu[j].w); sum[7] += bf_hi(wu[j].w); } } }
#pragma clang loop unroll(disable)
        for (int kb = 0; kb < 32; kb += 8) {
            v4u cur[8], old_[8];
#pragma unroll
            for (int j = 0; j < 8; ++j) { const int t = t0 + kb + j, s = s0 + kb + j; cur[j] = *(const v4u*)(U + (size_t)t * DM + col);
                old_[j] = *(const v4u*)(U + (size_t)(s >= w ? t - w : t) * DM + col); }
#pragma unroll
            for (int j = 0; j < 8; ++j) { const int t = t0 + kb + j, s = s0 + kb + j; float v[8], o[8];
                v[0] = bf_lo(cur[j].x); v[1] = bf_hi(cur[j].x); v[2] = bf_lo(cur[j].y); v[3] = bf_hi(cur[j].y); v[4] = bf_lo(cur[j].z); v[5] = bf_hi(cur[j].z); v[6] = bf_lo(cur[j].w); v[7] = bf_hi(cur[j].w);
                o[0] = bf_lo(old_[j].x); o[1] = bf_hi(old_[j].x); o[2] = bf_lo(old_[j].y); o[3] = bf_hi(old_[j].y); o[4] = bf_lo(old_[j].z); o[5] = bf_hi(old_[j].z); o[6] = bf_lo(old_[j].w); o[7] = bf_hi(old_[j].w);
#pragma unroll
                for (int e = 0; e < 8; ++e) sum[e] += v[e];
                if (s >= w) {
#pragma unroll
                    for (int e = 0; e < 8; ++e) sum[e] -= o[e]; }
                const float ic = 1.0f / (float)(s + 1 < w ? s + 1 : w);
                v4u r; r.x = pk2((sum[0] * ic - v[0]) * sc0[0], (sum[1] * ic - v[1]) * sc0[1]); r.y = pk2((sum[2] * ic - v[2]) * sc0[2], (sum[3] * ic - v[3]) * sc0[3]);
                r.z = pk2((sum[4] * ic - v[4]) * sc1[0], (sum[5] * ic - v[5]) * sc1[1]); r.w = pk2((sum[6] * ic - v[6]) * sc1[2], (sum[7] * ic - v[7]) * sc1[3]);
                *(v4u*)(PM + (size_t)t * DM + col) = r; } }
    }
}

__device__ __forceinline__ void phase_route(const Ctx& X, KP p, int layer) {
    const float* LOG = (const float*)(p->ws + WS_LOG); const float* LOG1 = (const float*)(p->ws + WS_LOG1); unsigned* TOKE = (unsigned*)(p->ws + WS_MISC + MS_TOKE); float* TOKW = (float*)(p->ws + WS_MISC + MS_TOKW);
    unsigned* BC = (unsigned*)(p->ws + WS_MISC + MS_BC);
    const float* brg = p->in[17] + layer * 8; const float* bre = p->in[19] + layer * 64;
    const float* SSQP = (const float*)(p->ws + WS_SSQP); float* RSTOK = (float*)(p->ws + WS_MISC + MS_RSTOK);
    LAS unsigned* hist = (LAS unsigned*)X.lds;
    { int* STOK = (int*)(p->ws + WS_MISC + MS_STOK); for (int i = X.vcu * (NWAVES * 64) + X.tid; i < PSLOTS; i += X.G * NWAVES * 64) STOK[i] = 0; }
#pragma clang loop unroll(disable)
    for (int ch = X.vcu; ch < 256; ch += X.G) {
        if (X.tid < 64) hist[X.tid] = 0u;
        __syncthreads();
        if (X.tid < 128) {
            const int t = ch * 128 + X.tid; const float* lg = LOG + (size_t)t * 72; const float* lh = LOG1 + (size_t)t * 72;
            float ssq = 0.f;
#pragma unroll
            for (int j = 0; j < 8; ++j) { const f32x4 q = *(const f32x4*)(SSQP + (size_t)t * 32 + 4 * j); ssq += (q[0] + q[1]) + (q[2] + q[3]); }
            const float rstd = 1.0f / sqrtf(ssq * (1.0f / DM) + EPS);
            RSTOK[t] = rstd;
            float g[8]; int gs = 0; float gm;
#pragma unroll
            for (int j = 0; j < 8; ++j) g[j] = (lg[j] + lh[j]) * rstd + brg[j];
            gm = g[0];
#pragma unroll
            for (int j = 1; j < 8; ++j) if (g[j] > gm) { gm = g[j]; gs = j; }
            float den = 0.f;
#pragma unroll
            for (int j = 0; j < 8; ++j) den += expf(g[j] - gm);
            const float psel = 1.0f / den;
            float e[8];
#pragma unroll
            for (int j = 0; j < 8; ++j) e[j] = (lg[8 + gs * 8 + j] + lh[8 + gs * 8 + j]) * rstd + bre[gs * 8 + j];
            int i1 = 0; float m1 = e[0];
#pragma unroll
            for (int j = 1; j < 8; ++j) if (e[j] > m1) { m1 = e[j]; i1 = j; }
            int i2 = -1; float m2 = -3.0e38f;
#pragma unroll
            for (int j = 0; j < 8; ++j) if (j != i1 && e[j] > m2) { m2 = e[j]; i2 = j; }
            const float a2 = expf(m2 - m1), q1 = 1.0f / (1.0f + a2), q2 = a2 / (1.0f + a2);
            const unsigned e1 = (unsigned)(gs * 8 + i1), e2 = (unsigned)(gs * 8 + i2);
            const unsigned r1 = __hip_atomic_fetch_add(&hist[e1], 1u, __ATOMIC_RELAXED, __HIP_MEMORY_SCOPE_WORKGROUP), r2 = __hip_atomic_fetch_add(&hist[e2], 1u, __ATOMIC_RELAXED, __HIP_MEMORY_SCOPE_WORKGROUP);
            TOKE[t] = e1 | (e2 << 8) | (r1 << 16) | (r2 << 24);
            TOKW[2 * t] = psel * q1; TOKW[2 * t + 1] = psel * q2;
        }
        __syncthreads();
        if (X.tid < 64) BC[ch * 64 + X.tid] = hist[X.tid];
        __syncthreads();
    }
}
__device__ __forceinline__ void phase_slots(const Ctx& X, KP p) {
    const unsigned* TOKE = (const unsigned*)(p->ws + WS_MISC + MS_TOKE); int* SLOT = (int*)(p->ws + WS_MISC + MS_SLOT);
    const unsigned* BC = (const unsigned*)(p->ws + WS_MISC + MS_BC); int* TILE = (int*)(p->ws + WS_MISC + MS_TILE);
    const bf16* HN = (const bf16*)(p->ws + WS_XB1); bf16* XS = (bf16*)(p->ws + WS_XS);
    const float* RSTOK = (const float*)(p->ws + WS_MISC + MS_RSTOK); float* RSSLOT = (float*)(p->ws + WS_MISC + MS_RSSLOT); int* STOK = (int*)(p->ws + WS_MISC + MS_STOK);
    LAS unsigned* part = (LAS unsigned*)X.lds;
    LAS unsigned* pstart = part + 512;
    LAS unsigned* cbase = pstart + 64;
    LAS int* slots = (LAS int*)(cbase + 64);
    { const int e = X.tid & 63, g = X.tid >> 6; unsigned s = 0u;
#pragma unroll
      for (int i = 0; i < 32; ++i) s += BC[(32 * g + i) * 64 + e];
      part[g * 64 + e] = s; }
    __syncthreads();
    if (X.tid < 64) { const int e = X.tid; unsigned tot = 0u;
#pragma unroll
        for (int g = 0; g < 8; ++g) tot += part[g * 64 + e];
        const unsigned ntile = (tot + 255u) >> 8;
        cbase[e] = ntile;
        __builtin_amdgcn_fence(__ATOMIC_RELEASE, "workgroup"); __builtin_amdgcn_wave_barrier(); __builtin_amdgcn_fence(__ATOMIC_ACQUIRE, "workgroup");
        unsigned excl = 0u;
#pragma unroll
        for (int j = 0; j < 64; ++j) { const unsigned v = cbase[j]; excl += (j < e) ? v : 0u; }
        pstart[e] = excl << 8;
        if (blockIdx.x == 0) { for (unsigned k = 0; k < ntile; ++k) TILE[64 + excl + k] = e; if (e == 63) TILE[0] = (int)(excl + ntile); } }
    __syncthreads();
#pragma clang loop unroll(disable)
    for (int ch = X.vcu; ch < 256; ch += X.G) {
        if (X.tid < 64) { const int e = X.tid, g = ch >> 5; unsigned s = 0u;
            for (int gg = 0; gg < g; ++gg) s += part[gg * 64 + e];
#pragma unroll
            for (int i = 0; i < 31; ++i) { const int c = 32 * g + i; const unsigned v = BC[(c < ch ? c : 32 * g) * 64 + e]; s += (c < ch) ? v : 0u; }
            cbase[e] = s; }
        __syncthreads();
        if (X.tid < 128) { const int t = ch * 128 + X.tid; const unsigned te = TOKE[t];
            const unsigned e1 = te & 255u, e2 = (te >> 8) & 255u, r1 = (te >> 16) & 255u, r2 = te >> 24;
            const int s1 = (int)(pstart[e1] + cbase[e1] + r1), s2 = (int)(pstart[e2] + cbase[e2] + r2);
            SLOT[2 * t] = s1; SLOT[2 * t + 1] = s2; slots[2 * X.tid] = s1; slots[2 * X.tid + 1] = s2;
            const float rs = RSTOK[t]; RSSLOT[s1] = rs; RSSLOT[s2] = rs; STOK[s1] = t; STOK[s2] = t; }
        __syncthreads();
        __syncthreads();
    }
}

struct MoeOrder {
    const int* tile; int ntile, nN, G, c; size_t bstride;
    __device__ void init(const int* tile_, int nN_, int G_, int c_, size_t bstride_) { tile = tile_; nN = nN_; G = G_; c = c_; bstride = bstride_;
        ntile = (int)__hip_atomic_load((const unsigned*)tile_, RLX_AGENT); ntile = ntile < 320 ? ntile : 320; }
    __device__ bool next(int i, pg8::Unit& u) const {
        const long L = (long)i * G + c; if (L >= (long)ntile * nN) return false;
        u.pm = (int)(L / nN); u.pn = (int)(L % nN); u.aux = (int)__hip_atomic_load((const unsigned*)tile + 64 + u.pm, RLX_AGENT) & 63; return true;
    }
    __device__ __forceinline__ const char* abase(const pg8::Gemm& g, const pg8::Unit& u) const { return (const char*)g.A + (size_t)u.pm * 256 * g.lda * 2; }
    __device__ __forceinline__ const char* bbase(const pg8::Gemm& g, const pg8::Unit& u) const { return (const char*)g.Bt + (size_t)u.aux * bstride + (size_t)u.pn * 256 * g.K * 2; }
};
struct RouterOrder {
    int G, c;
    __device__ bool next(int i, pg8::Unit& u) const { const int L = i * G + c; if (L >= 256) return false; u.pm = L >> 1; u.pn = 0; u.aux = L & 1; return true; }
    __device__ __forceinline__ const char* abase(const pg8::Gemm& g, const pg8::Unit& u) const { return (const char*)g.A + (size_t)u.pm * 256 * g.lda * 2 + (size_t)u.aux * g.K * 2; }
    __device__ __forceinline__ const char* bbase(const pg8::Gemm& g, const pg8::Unit& u) const { return (const char*)g.Bt + (size_t)u.aux * g.K * 2; }
};
struct ProdOrder {
    int bx, G;
    __device__ bool next(int i, pg8::Unit& u) const { const int c = (bx + G - (128 % G)) % G, L = i * G + c; if (L >= 64) return false; u.pm = L >> 3; u.pn = L & 7; u.aux = 0; return true; }
    __device__ __forceinline__ const char* abase(const pg8::Gemm& g, const pg8::Unit& u) const { return (const char*)g.A + (size_t)u.pm * 256 * g.lda * 2; }
    __device__ __forceinline__ const char* bbase(const pg8::Gemm& g, const pg8::Unit& u) const { return (const char*)g.Bt + (size_t)u.pn * 256 * g.ldb * 2 + (size_t)(u.pm >> 1) * 512 * 2; }
};
struct Col4Order {
    int bx, G;
    __device__ bool next(int i, pg8::Unit& u) const { const int L = i * G + bx; if (L >= 128) return false; u.pm = L; u.pn = 4; u.aux = 0; return true; }
    __device__ __forceinline__ const char* abase(const pg8::Gemm& g, const pg8::Unit& u) const { return (const char*)g.A + (size_t)u.pm * 256 * g.lda * 2; }
    __device__ __forceinline__ const char* bbase(const pg8::Gemm& g, const pg8::Unit& u) const { return (const char*)g.Bt + (size_t)u.pn * 256 * g.ldb * 2; }
};
struct GroupOrder {
    pg8::StaticOrder so;
    __device__ bool next(int i, pg8::Unit& u) const { return so.next(i, u); }
    __device__ __forceinline__ const char* abase(const pg8::Gemm& g, const pg8::Unit& u) const { return (const char*)g.A + (size_t)u.pm * 256 * g.lda * 2 + (size_t)(u.pn >> 1) * 512 * 2; }
    __device__ __forceinline__ const char* bbase(const pg8::Gemm& g, const pg8::Unit& u) const { return (const char*)g.Bt + (size_t)u.pn * 256 * g.K * 2; }
};

constexpr int RING_BYTES = 131072, MISC_OFF = RING_BYTES, LDS_BYTES = 147456;
__global__ void __launch_bounds__(NWAVES * 64, 2) mk_fwd(Params p_unused) {
    extern __shared__ __attribute__((aligned(16))) unsigned char lds_raw[];
    LAS unsigned char* const lds0 = (LAS unsigned char*)lds_raw;
    volatile LAS unsigned* MISC = (volatile LAS unsigned*)(lds0 + MISC_OFF);
    for (int u = threadIdx.x; u < (LDS_BYTES - MISC_OFF) / 4; u += NWAVES * 64) ((LAS unsigned*)(lds0 + MISC_OFF))[u] = 0u;
    __syncthreads();
    XcdBarrier bar; int lo, hi;
    { KP k = kargs(); lo = k->ph_lo; hi = k->ph_hi; unsigned* bw = (unsigned*)(k->ws + WS_CTL) + CW_BAR;
      bar.bar = bw; bar.x = 0; bar.st = nullptr;
      if (!MK_MULTI) bar = xcd_barrier_post(bw, MISC + 8); }
#define IN(k_) (lo <= (k_) && (k_) < hi)
#define SEAM(k_) do { if (IN(k_) && IN((k_) + 1)) xcd_barrier(bar); } while (0)
#define PH_BEGIN KP k = kargs(); const Ctx X = make_ctx(lds0); unsigned char* ws = k->ws; const int G = X.G, bx = X.bx, vcu = X.vcu; (void)ws; (void)G; (void)bx; (void)vcu;
#ifdef PROBE_ATT
#define PROBE_ATT_BODY xcd_barrier(bar); if (bx == 0 && threadIdx.x < 8) __hip_atomic_store(ctl + CW_ATTQ + 64 * threadIdx.x, 0u, __ATOMIC_RELAXED, __HIP_MEMORY_SCOPE_AGENT); xcd_barrier(bar); \
    att::attn_phase(X.lds, (const bf16*)(ws + WS_Q), (const bf16*)(ws + WS_KV), (bf16*)(ws + WS_O), k->in[8], (const float*)(ws + WS_CS), ctl + CW_ATTQ, (int)(xb_xcc_id() & 7u));
#else
#define PROBE_ATT_BODY
#endif
#ifndef PROBE_REP
#define PROBE_REP 0u
#endif
#define PHASE(k_, ...) do { if (IN(k_)) { { PH_BEGIN __VA_ARGS__ } if ((PROBE_REP >> (k_)) & 1u) { xcd_barrier(bar); { PH_BEGIN __VA_ARGS__ } } } } while (0)

    PHASE(0, phase_prologue(X, k);); SEAM(0);
    PHASE(1, pg8::Gemm g{(const bf16*)(ws + WS_XB1), (const bf16*)(ws + WS_WIN), 1024, 1024, 1024, nullptr}; pg8::StaticOrder S; S.init(T, 1024, G, bx);
        typedef pg8::EpiBf16<pg8::i32x4, false, true, false, true, true, true, 4> EC; EC E{(bf16*)(ws + WS_C), 1280, 256, 128, nullptr, (const float*)(ws + WS_MISC + MS_RSTD0), nullptr, 0, 20, (float*)(ws + WS_SSQC), 1.0f / (QS_X * QS_WIN), (unsigned char*)(ws + WS_CQ8), 1280, QS_C, 4}; pg8::gemm_phase<EC, pg8::StaticOrder, false, true>(X.lds, g, S, E);
        { Col4Order S4; S4.bx = bx; S4.G = G;
          typedef pg8::EpiBf16<pg8::i32x4, false, true, false, true, false, true, -1, true> EC4; EC4 E4{(bf16*)(ws + WS_C), 1280, 256, 128, nullptr, (const float*)(ws + WS_MISC + MS_RSTD0), nullptr, 0, 20, (float*)(ws + WS_SSQC), 1.0f / (QS_X * QS_WIN), nullptr, 0, 0.f, -1};
          pg8::gemm_phase<EC4, Col4Order, false, true>(X.lds, g, S4, E4); }
        { pg8::Gemm g2{(const bf16*)(ws + WS_WG), (const bf16*)(ws + WS_PWIN), 512, 512, 2048, nullptr}; ProdOrder S2; S2.bx = bx; S2.G = G;
          typedef pg8::EpiBf16<pg8::f32x4, true> EP; EP E2{(bf16*)(ws + WS_WPT), 2048, 256, 128, k->in[2] + 2048, nullptr, nullptr, 0, 0, nullptr, 1.f, nullptr, 0, 0.f, -1}; pg8::gemm_phase(X.lds, g2, S2, E2); }); SEAM(1);
    PHASE(2,
        { pg8::Gemm g{(const bf16*)(ws + WS_CQ8), (const bf16*)(ws + WS_WQ), 256, 640, 256, nullptr}; pg8::StaticOrder S; S.init(T, 3072, G, bx);
          typedef pg8::EpiBf16<pg8::i32x4, false, false, true, false, true, false> EQ; EQ E{(bf16*)(ws + WS_Q), 3072, 256, 128, nullptr, nullptr, (const float*)(ws + WS_SSQC), 0, 20, nullptr, 1.0f / (QS_C * QS_WQK), (unsigned char*)(ws + WS_Q), 3072, QS_Q, 9999}; pg8::gemm_phase<EQ, pg8::StaticOrder, false, true>(X.lds, g, S, E); }
        { if (threadIdx.x < 48) ((LAS f32x4*)(X.lds + pg8::STAGE_BYTES + 4096 + 6144))[threadIdx.x] = *(const f32x4*)(k->in[9] + 4 * threadIdx.x);
          __syncthreads();
          pg8::Gemm g{(const bf16*)(ws + WS_CQ8) + 256, (const bf16*)(ws + WS_WKV), 256, 640, 256, nullptr}; pg8::StaticOrder S; S.init(T, 4096, G, bx);
          pg8::EpiKV<pg8::i32x4> E{(bf16*)(ws + WS_KV), (const float*)(ws + WS_SSQC), (const bf16*)(ws + WS_C), (const float*)(ws + WS_CS), k->in[9], X.lds + pg8::STAGE_BYTES + 4096, 0, 1.0f / (QS_C * QS_WQK)}; pg8::gemm_phase<pg8::EpiKV<pg8::i32x4>, pg8::StaticOrder, false, true>(X.lds, g, S, E); }); SEAM(2);
    PHASE(3, unsigned* ctl = (unsigned*)(ws + WS_CTL);
        if ((vcu & 31) >= 32 - NCONV) moe_convert_drain(k, ctl + CW_CONVQ, X.lane);
        att::attn_phase(X.lds, (const bf16*)(ws + WS_Q), (const bf16*)(ws + WS_KV), (bf16*)(ws + WS_O), k->in[8], (const float*)(ws + WS_CS), ctl + CW_ATTQ, (int)(xb_xcc_id() & 7u));
        { int ln = threadIdx.x; asm volatile("" : "+v"(ln)); moe_convert_drain(k, ctl + CW_CONVQ, ln & 63); }
        PROBE_ATT_BODY); SEAM(3);
    PHASE(4, pg8::Gemm g{(const bf16*)(ws + WS_O), (const bf16*)(ws + WS_WO), 1024, 1024, 1024, nullptr}; pg8::StaticOrder S; S.init(T, 2048, G, bx);
        pg8::EpiResBf16<pg8::i32x4> E{(const bf16*)(ws + WS_XB0), (bf16*)(ws + WS_XB1), 2048, (float*)(ws + WS_SSQP), k->in[15], (unsigned char*)(ws + WS_XQ), QS_A, 1.0f / QS_WIN}; pg8::gemm_phase<pg8::EpiResBf16<pg8::i32x4>, pg8::StaticOrder, false, true>(X.lds, g, S, E);); SEAM(4);
#define MOE_BLOCK(mb, layer) \
    PHASE(mb, pg8::Gemm g{(const bf16*)(ws + WS_XB1), (const bf16*)(ws + WS_RW) + (size_t)(layer) * 256 * 2048, 1024, 2048, 2048, nullptr}; RouterOrder S; S.G = G; S.c = vcu; \
        pg8::EpiLogits E{(float*)(ws + WS_LOG), 72, 72, (size_t)(WS_LOG1 - WS_LOG) / 4}; pg8::gemm_phase(X.lds, g, S, E);); SEAM(mb); \
    PHASE(mb + 1, phase_route(X, k, layer);); SEAM(mb + 1); \
    PHASE(mb + 2, phase_slots(X, k);); SEAM(mb + 2); \
    PHASE(mb + 3, pg8::Gemm g{(const bf16*)(ws + WS_XQ), (const bf16*)(ws + WS_GUT) + (size_t)(layer) * 64 * 1024 * 1024, 1024, 1024, 1024, (const int*)(ws + WS_MISC + MS_STOK)}; \
        MoeOrder S; S.init((const int*)(ws + WS_MISC + MS_TILE), 4, G, vcu, (size_t)1024 * 2048); \
        pg8::EpiSwiGLU8 E{(unsigned char*)(ws + WS_H), 512, (const float*)(ws + WS_MISC + MS_RSSLOT), 1.0f / (QS_A * QS_WGU), QS_H}; pg8::gemm_phase<pg8::EpiSwiGLU8, MoeOrder, true, true>(X.lds, g, S, E);); SEAM(mb + 3); \
    PHASE(mb + 4, pg8::Gemm g{(const bf16*)(ws + WS_H), (const bf16*)(ws + WS_DT) + (size_t)(layer) * 64 * 2048 * 256, 256, 256, 256, nullptr}; \
        MoeOrder S; S.init((const int*)(ws + WS_MISC + MS_TILE), 8, G, vcu, (size_t)2048 * 512); \
        pg8::EpiY8 E{(unsigned char*)(ws + WS_Y), 2048, QS_Y / (QS_H * QS_WD)}; pg8::gemm_phase<pg8::EpiY8, MoeOrder, false, true>(X.lds, g, S, E);); SEAM(mb + 4);
    MOE_BLOCK(5, 0)
    PHASE(10, phase_combine<false>(X, k, (const bf16*)(ws + WS_XB1), (bf16*)(ws + WS_XB0), (float*)(ws + WS_MISC + MS_RSTD2), nullptr);); SEAM(10);
    PHASE(11, pg8::Gemm g{(const bf16*)(ws + WS_XB0), (const bf16*)(ws + WS_WPT), 2048, 2048, 2048, nullptr}; pg8::StaticOrder S; S.init(T, 2048, G, bx);
        typedef pg8::EpiBf16<pg8::f32x4, false, true> EU; EU E{(bf16*)(ws + WS_UU), 2048, 256, 128, nullptr, (const float*)(ws + WS_MISC + MS_RSTD2), nullptr, 0, 0, nullptr, 1.f, nullptr, 0, 0.f, -1}; pg8::gemm_phase(X.lds, g, S, E);); SEAM(11);
    PHASE(12, phase_pool(X, k);); SEAM(12);
    PHASE(13, pg8::Gemm g{(const bf16*)(ws + WS_Y2), (const bf16*)(ws + WS_PWO), 2048, 2048, 2048, nullptr}; pg8::StaticOrder S; S.init(T, 2048, G, bx);
        pg8::EpiResBf16<> E{(const bf16*)(ws + WS_XB0), (bf16*)(ws + WS_XB1), 2048, (float*)(ws + WS_SSQP), k->in[15] + 2048, (unsigned char*)(ws + WS_XQ), QS_A, 0.f}; pg8::gemm_phase(X.lds, g, S, E);); SEAM(13);
    MOE_BLOCK(14, 1)
    PHASE(19, phase_combine<true>(X, k, (const bf16*)(ws + WS_XB1), nullptr, nullptr, k->out););
#undef MOE_BLOCK
#undef IN
#undef SEAM
#undef PH_BEGIN
#undef PHASE
}

extern "C" void kernel_launch(void* const* d_in, const int* in_sizes, int n_in, void* d_out, int out_size, void* d_ws, size_t ws_size, hipStream_t stream) {
    static int grid = 0;
    if (grid == 0) {
        if (n_in != 23 || out_size != T * DM || ws_size < WS_END) { fprintf(stderr, "kernel_launch: unexpected shapes (n_in %d out %d ws %zu); nothing launched\n", n_in, out_size, ws_size); grid = -1; return; }
        int dev = 0, cus = 0, per_cu = 0;
        if (hipGetDevice(&dev) != hipSuccess || hipDeviceGetAttribute(&cus, hipDeviceAttributeMultiprocessorCount, dev) != hipSuccess) { grid = -1; return; }
        if (hipFuncSetAttribute((const void*)mk_fwd, hipFuncAttributeMaxDynamicSharedMemorySize, LDS_BYTES) != hipSuccess) { fprintf(stderr, "kernel_launch: hipFuncSetAttribute failed\n"); grid = -1; return; }
        if (hipOccupancyMaxActiveBlocksPerMultiprocessor(&per_cu, (const void*)mk_fwd, NWAVES * 64, LDS_BYTES) != hipSuccess || per_cu < 1) { fprintf(stderr, "kernel_launch: occupancy query reports %d blocks per CU\n", per_cu); }
        (void)hipGetLastError();
        grid = cus;
    }
    if (grid < 0) return;
    if (hipMemsetAsync((char*)d_ws + WS_CTL, 0, CTL_ZERO_BYTES, stream) != hipSuccess) return;
    Params p{};
    for (int i = 0; i < 23; ++i) p.in[i] = (const float*)d_in[i];
    p.out = (float*)d_out; p.ws = (unsigned char*)d_ws;
#if MK_MULTI
    for (int k = 0; k < NPHASE; ++k) { p.ph_lo = k; p.ph_hi = k + 1; hipLaunchKernelGGL(mk_fwd, dim3(grid), dim3(NWAVES * 64), LDS_BYTES, stream, p); }
#else
    p.ph_lo = 0; p.ph_hi = NPHASE;
    hipLaunchKernelGGL(mk_fwd, dim3(grid), dim3(NWAVES * 64), LDS_BYTES, stream, p);
#endif
}
```

```cpp
#include <hip/hip_runtime.h>
#include <cstdio>
#include <cstdint>

namespace pg8 {
#define PG8_LAS __attribute__((address_space(3)))
typedef unsigned short bf16_t;
typedef short bf16x8 __attribute__((ext_vector_type(8)));
typedef float f32x4 __attribute__((ext_vector_type(4)));
typedef unsigned u32x4 __attribute__((ext_vector_type(4)));
typedef int i32x4 __attribute__((ext_vector_type(4)));
template <bool I8> struct AccT { typedef f32x4 type; };
template <> struct AccT<true> { typedef i32x4 type; };
constexpr int BM = 256, BK = 64, HALF = 128, HTB = HALF * BK * 2  , STAGE_BYTES = 8 * HTB, NXCD = 8, WGM = 8;

__host__ __device__ __forceinline__ int lds_byte(int r, int c) { const int st = (r >> 4) * 2 + (c >> 5), rr = r & 15, cc = c & 31, ob = rr * 64 + cc * 2; return st * 1024 + (ob ^ (((ob >> 9) & 1) << 5)); }
__host__ __device__ __forceinline__ void stage_rc(int b, int& R, int& C) { const int st = b / 1024, sb = b % 1024, swz = sb ^ (((sb >> 9) & 1) << 5); R = (st >> 1) * 16 + swz / 64; C = (st & 1) * 32 + (swz % 64) / 2; }
__host__ __device__ __forceinline__ int perm32(int rho) { const int n = rho >> 4, i = rho & 15; return 8 * (i >> 2) + 4 * n + (i & 3); }

struct Unit { int pm, pn, aux; };
struct Gemm { const bf16_t* A; const bf16_t* Bt; int K; int lda; int ldb; const int* rowtab; };

struct StaticOrder {
    int nM, nN, nwg, G, c;
    __device__ void init(int M, int N, int G_, int c_) { nM = M / BM; nN = N / BM; nwg = nM * nN; G = G_; c = c_; }
    __device__ bool next(int i, Unit& u) const {
        const long L = (long)i * G + c; if (L >= nwg) return false;
        int wgid = (int)L; { const int q = nwg / NXCD, r = nwg % NXCD, xcd = wgid % NXCD, off = wgid / NXCD; wgid = (xcd < r ? xcd * (q + 1) : r * (q + 1) + (xcd - r) * q) + off; }
        const int nig = WGM * nN, gid = wgid / nig, fm = gid * WGM, gsz = (nM - fm) < WGM ? (nM - fm) : WGM;
        u.pm = fm + ((wgid % nig) % gsz); u.pn = (wgid % nig) / gsz; u.aux = 0; return true;
    }
    __device__ __forceinline__ const char* abase(const Gemm& g, const Unit& u) const { return (const char*)g.A + (size_t)u.pm * BM * g.lda * 2; }
    __device__ __forceinline__ const char* bbase(const Gemm& g, const Unit& u) const { return (const char*)g.Bt + (size_t)u.pn * BM * g.ldb * 2; }
};

__device__ __forceinline__ unsigned cvt_pk_bf16(float lo, float hi) { unsigned r; asm volatile("v_cvt_pk_bf16_f32 %0, %1, %2" : "=v"(r) : "v"(lo), "v"(hi)); return r; }

__device__ __forceinline__ float lo16(unsigned w) { return __uint_as_float(w << 16); }
__device__ __forceinline__ float hi16(unsigned w) { return __uint_as_float(w & 0xffff0000u); }
__device__ __forceinline__ unsigned q8x4(float a, float b, float c, float d) {
    unsigned w = __builtin_amdgcn_cvt_pk_u8_f32((a + 128.f), 0, 0u); w = __builtin_amdgcn_cvt_pk_u8_f32((b + 128.f), 1, w);
    w = __builtin_amdgcn_cvt_pk_u8_f32((c + 128.f), 2, w); w = __builtin_amdgcn_cvt_pk_u8_f32((d + 128.f), 3, w); return w ^ 0x80808080u; }
template <class A> __device__ __forceinline__ A pin(const A& v) { A t = v; asm volatile("" : "+v"(t) :: "memory"); return t; }
typedef unsigned u32x2v __attribute__((ext_vector_type(2)));
__device__ __forceinline__ void store16_pair(unsigned char* pa, unsigned char* pb, u32x2v xa, u32x2v xb, int fq) {
    auto r0 = __builtin_amdgcn_permlane16_swap(xa.x, xb.x, false, false);
    auto r1 = __builtin_amdgcn_permlane16_swap(xa.y, xb.y, false, false);
    u32x4 w; w.x = r0[0]; w.y = r1[0]; w.z = r0[1]; w.w = r1[1];
    *(u32x4*)((fq & 1) ? pb - 8 : pa) = w;
}
template <class F> __device__ __forceinline__ void rows8(int fq, F f, float (&out)[8]) {
    const unsigned v0 = __float_as_uint(f(2 * fq)), v1 = __float_as_uint(f(2 * fq + 1));
    auto p0 = __builtin_amdgcn_permlane16_swap(v0, v0, false, false); auto p1 = __builtin_amdgcn_permlane16_swap(v1, v1, false, false);
    const unsigned w[4] = {p0[0], p1[0], p0[1], p1[1]};
#pragma unroll
    for (int k = 0; k < 4; ++k) { auto q = __builtin_amdgcn_permlane32_swap(w[k], w[k], false, false); out[k] = __uint_as_float(q[0]); out[4 + k] = __uint_as_float(q[1]); }
}
__device__ __forceinline__ f32x4 tof(const f32x4& v) { return v; }
__device__ __forceinline__ f32x4 tof(const i32x4& v) { return (f32x4){(float)v[0], (float)v[1], (float)v[2], (float)v[3]}; }
template <class ACC = f32x4, bool CS = false, bool RS = false, bool SSQI = false, bool SSQO = false, bool Q8 = false, bool BF = true, int BFPN = -1, bool NH = false>
struct EpiBf16 {   static constexpr bool NHALF = NH;       static constexpr int NSTORE = (Q8 ? 8 : 0) + ((BF && BFPN < 0) ? (NH ? 8 : 16) : 0) + (SSQO ? 2 : 0);
    static constexpr bool PERM = true;
    bf16_t* O; int ldc; int tile_cs; int bj_s; const float* cscale; const float* rscale; const float* ssq_in; int ssq_off; int ssq_ld; float* ssq_out; float dq; unsigned char* q8out; int q8ld; float q8scale; int bf_only_pn;
    __device__ __forceinline__ void operator()(const ACC (&acc)[2][2][4][2], const Unit& u, int wr, int wc, int fr, int fq) const {
        asm volatile("" : "+v"(fr), "+v"(fq));
        const int row0 = u.pm * BM + wr * 64 + fr;
        const int col0 = u.pn * tile_cs + wc * 32 + 8 * fq, lcol0 = u.pn * BM + wc * 32 + 8 * fq;
        f32x4 sv[2][2]; float ssv[8] = {0.f, 0.f, 0.f, 0.f, 0.f, 0.f, 0.f, 0.f}; float rs8[8] = {0.f, 0.f, 0.f, 0.f, 0.f, 0.f, 0.f, 0.f};
        if (RS || SSQI) rows8(fq, [&](int i) -> float { const size_t row = (size_t)(row0 + (i >> 2) * HALF + (i & 3) * 16); float r = RS ? rscale[row] : 1.f;
            if (SSQI) { const f32x4 a = *(const f32x4*)(ssq_in + row * ssq_ld + ssq_off), b = *(const f32x4*)(ssq_in + row * ssq_ld + ssq_off + 4);
                r = __builtin_amdgcn_rsqf(((a[0] + a[1]) + (a[2] + a[3]) + (b[0] + b[1]) + (b[2] + b[3])) * (1.0f / 512.f) + 1e-6f); }
            return r * dq; }, rs8);
#pragma unroll
        for (int bj = 0; bj < (NH ? 1 : 2); ++bj)
#pragma unroll
            for (int n = 0; n < 2; ++n) sv[bj][n] = CS ? *(const f32x4*)(cscale + lcol0 + bj * HALF + 4 * n) : (f32x4){1.f, 1.f, 1.f, 1.f};
#pragma unroll
        for (int ai = 0; ai < 2; ++ai)
#pragma unroll
            for (int m = 0; m < 4; ++m) { const int row = row0 + ai * HALF + m * 16; bf16_t* rowp = O + (size_t)row * ldc + col0;
                const float rs = (RS || SSQI) ? rs8[ai * 4 + m] : dq;
                float ss = 0.f; u32x2v xq8[2];
#pragma unroll
                for (int bj = 0; bj < (NH ? 1 : 2); ++bj) { const f32x4 v0 = tof(pin(acc[ai][bj][m][0])) * sv[bj][0] * rs, v1 = tof(pin(acc[ai][bj][m][1])) * sv[bj][1] * rs;
                    ss += (v0[0] * v0[0] + v0[1] * v0[1]) + (v0[2] * v0[2] + v0[3] * v0[3]) + (v1[0] * v1[0] + v1[1] * v1[1]) + (v1[2] * v1[2] + v1[3] * v1[3]);
                    if (BF && (BFPN < 0 || u.pn == BFPN)) { u32x4 w; w.x = cvt_pk_bf16(v0[0], v0[1]); w.y = cvt_pk_bf16(v0[2], v0[3]); w.z = cvt_pk_bf16(v1[0], v1[1]); w.w = cvt_pk_bf16(v1[2], v1[3]);
                        *(u32x4*)(rowp + bj * bj_s) = w; }
                    if (Q8) { xq8[bj].x = q8x4(v0[0] * q8scale, v0[1] * q8scale, v0[2] * q8scale, v0[3] * q8scale); xq8[bj].y = q8x4(v1[0] * q8scale, v1[1] * q8scale, v1[2] * q8scale, v1[3] * q8scale); } }
                if (Q8) { unsigned char* qp = q8out + (size_t)row * q8ld + col0; store16_pair(qp, qp + bj_s, xq8[0], xq8[1], fq); }
                if (SSQO) {
                    ss += __int_as_float(__builtin_amdgcn_ds_swizzle(__float_as_int(ss), (16 << 10) | 0x1F));
                    { auto rr = __builtin_amdgcn_permlane32_swap(__float_as_uint(ss), __float_as_uint(ss), false, false); ss = __uint_as_float(rr[0]) + __uint_as_float(rr[1]); }
                    ssv[ai * 4 + m] = ss; } }
        if (SSQO) {
#pragma unroll
            for (int j = 0; j < 2; ++j) { const float sv = (fq & 2) ? ((fq & 1) ? ssv[6 + j] : ssv[4 + j]) : ((fq & 1) ? ssv[2 + j] : ssv[j]);
                const int i = 2 * fq + j; ssq_out[(size_t)(row0 + (i >> 2) * HALF + (i & 3) * 16) * ssq_ld + u.pn * 4 + wc] = sv; } }
    }
};
template <class ACC = f32x4>
struct EpiKV {
    static constexpr bool PERM = true; static constexpr int NSTORE = 14;
    bf16_t* KV; const float* ssqc; const bf16_t* C; const float* CS; const float* gk; PG8_LAS unsigned char* xl; mutable int par; float dq;
    __device__ __forceinline__ void operator()(const ACC (&acc)[2][2][4][2], const Unit& u, int wr, int wc, int fr, int fq) const {
        asm volatile("" : "+v"(fr), "+v"(fq));
        PG8_LAS float* P = (PG8_LAS float*)xl;
        PG8_LAS float* RS = P + 1024;
        const int rl0 = wr * 64 + fr, col0 = wc * 32 + 8 * fq;
        const int tid = (wr * 4 + wc) * 64 + fq * 16 + fr;
        f32x4 sa = {0.f, 0.f, 0.f, 0.f}, sb = sa, sr = sa;
        if (wr == 0) { const float* sp = ssqc + ((size_t)u.pm * BM + tid) * 20; sa = *(const f32x4*)(sp + 8); sb = *(const f32x4*)(sp + 12); sr = *(const f32x4*)(sp + 16); }
        PG8_LAS const float* gl = (PG8_LAS const float*)(xl + 6144);
        const f32x4 g0 = *(PG8_LAS const f32x4*)(gl + col0), g1 = *(PG8_LAS const f32x4*)(gl + col0 + 4);
#pragma unroll
        for (int ai = 0; ai < 2; ++ai)
#pragma unroll
            for (int m = 0; m < 4; ++m) {
                const f32x4 k0 = tof(pin(acc[ai][0][m][0])), k1 = tof(pin(acc[ai][0][m][1]));
                float ss = (k0[0] * k0[0] + k0[1] * k0[1]) + (k0[2] * k0[2] + k0[3] * k0[3]) + (k1[0] * k1[0] + k1[1] * k1[1]) + (k1[2] * k1[2] + k1[3] * k1[3]);
                ss += __int_as_float(__builtin_amdgcn_ds_swizzle(__float_as_int(ss), (16 << 10) | 0x1F));
                { auto rr = __builtin_amdgcn_permlane32_swap(__float_as_uint(ss), __float_as_uint(ss), false, false); ss = __uint_as_float(rr[0]) + __uint_as_float(rr[1]); }
                if (fq == 0) P[(rl0 + ai * HALF + m * 16) * 4 + wc] = ss; }
        asm volatile("s_waitcnt lgkmcnt(0)" ::: "memory"); __builtin_amdgcn_s_barrier(); asm volatile("" ::: "memory");
        if (wr == 0) { const f32x4 pp = *(const PG8_LAS f32x4*)(P + tid * 4);
            const float rs = dq * __builtin_amdgcn_rsqf(((sa[0] + sa[1]) + (sa[2] + sa[3]) + (sb[0] + sb[1]) + (sb[2] + sb[3])) * (1.0f / 512.f) + 1e-6f);
            const float rkn = __builtin_amdgcn_rsqf((((pp[0] + pp[1]) + (pp[2] + pp[3])) * (rs * rs) + (sr[0] + sr[1]) + (sr[2] + sr[3])) * (1.0f / 192.f) + 1e-6f);
            typedef float f32x2v __attribute__((ext_vector_type(2))); *(PG8_LAS f32x2v*)(RS + 2 * tid) = (f32x2v){rs, rkn}; }
        asm volatile("s_waitcnt lgkmcnt(0)" ::: "memory"); __builtin_amdgcn_s_barrier(); asm volatile("" ::: "memory");
        unsigned char* tb = (unsigned char*)KV + (size_t)u.pm * BM * 8192 + u.pn * 512;
#pragma unroll
        for (int ai = 0; ai < 2; ++ai)
#pragma unroll
            for (int mp = 0; mp < 2; ++mp) { u32x2v wk[2];
#pragma unroll
                for (int mm = 0; mm < 2; ++mm) { const int m = 2 * mp + mm; const int rl = rl0 + ai * HALF + m * 16;
                    typedef float f32x2v __attribute__((ext_vector_type(2))); const f32x2v st = *(const PG8_LAS f32x2v*)(RS + 2 * rl);
                    const float rs = st[0], rk = st[0] * st[1];
                    bf16_t* rowp = (bf16_t*)(tb + (unsigned)rl * 8192u + 256) + col0;
                    const f32x4 k0 = tof(pin(acc[ai][0][m][0])) * rk * g0, k1 = tof(pin(acc[ai][0][m][1])) * rk * g1, v0 = tof(pin(acc[ai][1][m][0])) * rs, v1 = tof(pin(acc[ai][1][m][1])) * rs;
                    wk[mm].x = q8x4(k0[0] * 16.f, k0[1] * 16.f, k0[2] * 16.f, k0[3] * 16.f); wk[mm].y = q8x4(k1[0] * 16.f, k1[1] * 16.f, k1[2] * 16.f, k1[3] * 16.f);
                    u32x4 x; x.x = cvt_pk_bf16(v0[0], v0[1]); x.y = cvt_pk_bf16(v0[2], v0[3]); x.z = cvt_pk_bf16(v1[0], v1[1]); x.w = cvt_pk_bf16(v1[2], v1[3]); *(u32x4*)rowp = x; }
                unsigned char* ka = tb + (unsigned)(rl0 + ai * HALF + 2 * mp * 16) * 8192u + col0;
                store16_pair(ka, ka + 16 * 8192, wk[0], wk[1], fq);
                asm volatile("" ::: "memory"); }
        { const int rl = tid >> 1, j0 = 16 * (tid & 1); const size_t row = (size_t)u.pm * BM + rl;
          const float rk = RS[2 * rl + 1];
          const bf16_t* cr = C + row * 1280 + 1024 + j0; const float* cs = CS + row * 64 + j0; unsigned char* kp = tb + (unsigned)rl * 8192u + 128 + j0;
          u32x2v w1[2], w2[2];
#pragma unroll
          for (int q = 0; q < 2; ++q) { const u32x4 a = *(const u32x4*)(cr + 8 * q), b = *(const u32x4*)(cr + 32 + 8 * q);
              const f32x4 c0 = *(const f32x4*)(cs + 8 * q), c1 = *(const f32x4*)(cs + 8 * q + 4), s0 = *(const f32x4*)(cs + 32 + 8 * q), s1 = *(const f32x4*)(cs + 32 + 8 * q + 4);
              const f32x4 ga0 = *(PG8_LAS const f32x4*)(gl + 128 + j0 + 8 * q), ga1 = *(PG8_LAS const f32x4*)(gl + 128 + j0 + 8 * q + 4), gb0 = *(PG8_LAS const f32x4*)(gl + 160 + j0 + 8 * q), gb1 = *(PG8_LAS const f32x4*)(gl + 160 + j0 + 8 * q + 4);
              const f32x4 x10 = (f32x4){lo16(a.x), hi16(a.x), lo16(a.y), hi16(a.y)} * rk * ga0, x11 = (f32x4){lo16(a.z), hi16(a.z), lo16(a.w), hi16(a.w)} * rk * ga1;
              const f32x4 x20 = (f32x4){lo16(b.x), hi16(b.x), lo16(b.y), hi16(b.y)} * rk * gb0, x21 = (f32x4){lo16(b.z), hi16(b.z), lo16(b.w), hi16(b.w)} * rk * gb1;
              const f32x4 o10 = x10 * c0 - x20 * s0, o11 = x11 * c1 - x21 * s1, o20 = x20 * c0 + x10 * s0, o21 = x21 * c1 + x11 * s1;
              w1[q].x = q8x4(o10[0] * 16.f, o10[1] * 16.f, o10[2] * 16.f, o10[3] * 16.f); w1[q].y = q8x4(o11[0] * 16.f, o11[1] * 16.f, o11[2] * 16.f, o11[3] * 16.f);
              w2[q].x = q8x4(o20[0] * 16.f, o20[1] * 16.f, o20[2] * 16.f, o20[3] * 16.f); w2[q].y = q8x4(o21[0] * 16.f, o21[1] * 16.f, o21[2] * 16.f, o21[3] * 16.f); }
          { u32x4 w; w.x = w1[0].x; w.y = w1[0].y; w.z = w1[1].x; w.w = w1[1].y; *(u32x4*)kp = w; }
          { u32x4 w; w.x = w2[0].x; w.y = w2[0].y; w.z = w2[1].x; w.w = w2[1].y; *(u32x4*)(kp + 32) = w; } }
    }
};
struct EpiSwiGLU8 {   static constexpr int NSTORE = 4;
    static constexpr bool PERM = true;
    unsigned char* O; int ldc; const float* rscale; float dq; float hscale;
    __device__ __forceinline__ static float sg(float g, float u) { return g * u * __builtin_amdgcn_rcpf(1.f + __builtin_amdgcn_exp2f(-1.4426950408889634f * g)); }
    __device__ __forceinline__ void operator()(const i32x4 (&acc)[2][2][4][2], const Unit& u, int wr, int wc, int fr, int fq) const {
        asm volatile("" : "+v"(fr), "+v"(fq));
        const int row0 = u.pm * BM + wr * 64 + fr, col0 = u.pn * HALF + wc * 32 + 8 * fq;
        float rs8[8]; rows8(fq, [&](int i) -> float { return rscale[row0 + (i >> 2) * HALF + (i & 3) * 16] * dq; }, rs8);
#pragma unroll
        for (int ai = 0; ai < 2; ++ai)
#pragma unroll
            for (int mp = 0; mp < 2; ++mp) { u32x2v w[2];
#pragma unroll
                for (int mm = 0; mm < 2; ++mm) { const int m = 2 * mp + mm; const float rs = rs8[ai * 4 + m]; float h[8];
#pragma unroll
                    for (int n = 0; n < 2; ++n)
#pragma unroll
                        for (int e = 0; e < 4; ++e) h[4 * n + e] = sg((float)acc[ai][0][m][n][e] * rs, (float)acc[ai][1][m][n][e] * rs) * hscale;
                    w[mm].x = q8x4(h[0], h[1], h[2], h[3]); w[mm].y = q8x4(h[4], h[5], h[6], h[7]); }
                unsigned char* pa = O + (size_t)(row0 + ai * HALF + 2 * mp * 16) * ldc + col0;
                store16_pair(pa, pa + (size_t)16 * ldc, w[0], w[1], fq); }
    }
};
struct EpiY8 {   static constexpr int NSTORE = 8;
    static constexpr bool PERM = true;
    unsigned char* O; int ldc; float dq;
    __device__ __forceinline__ void operator()(const i32x4 (&acc)[2][2][4][2], const Unit& u, int wr, int wc, int fr, int fq) const {
        asm volatile("" : "+v"(fr), "+v"(fq));
        const int row0 = u.pm * BM + wr * 64 + fr, col0 = u.pn * BM + wc * 32 + 8 * fq;
#pragma unroll
        for (int ai = 0; ai < 2; ++ai)
#pragma unroll
            for (int m = 0; m < 4; ++m) { unsigned char* rowp = O + (size_t)(row0 + ai * HALF + m * 16) * ldc + col0;
                u32x2v w[2];
#pragma unroll
                for (int bj = 0; bj < 2; ++bj) { const i32x4 a0 = acc[ai][bj][m][0], a1 = acc[ai][bj][m][1];
                    w[bj].x = q8x4((float)a0[0] * dq, (float)a0[1] * dq, (float)a0[2] * dq, (float)a0[3] * dq); w[bj].y = q8x4((float)a1[0] * dq, (float)a1[1] * dq, (float)a1[2] * dq, (float)a1[3] * dq); }
                store16_pair(rowp, rowp + HALF, w[0], w[1], fq); }
    }
};
struct EpiSwiGLU {
    static constexpr bool PERM = true;
    bf16_t* O; int ldc; const float* rscale;
    __device__ __forceinline__ static float sg(float g, float u) { return g * u * __builtin_amdgcn_rcpf(1.f + __builtin_amdgcn_exp2f(-1.4426950408889634f * g)); }
    __device__ __forceinline__ void operator()(const f32x4 (&acc)[2][2][4][2], const Unit& u, int wr, int wc, int fr, int fq) const {
        asm volatile("" : "+v"(fr), "+v"(fq));
        const int row0 = u.pm * BM + wr * 64 + fr, col0 = u.pn * HALF + wc * 32 + 8 * fq;
#pragma unroll
        for (int ai = 0; ai < 2; ++ai)
#pragma unroll
            for (int m = 0; m < 4; ++m) { const int row = row0 + ai * HALF + m * 16; bf16_t* rowp = O + (size_t)row * ldc + col0; const float rs = rscale[row];
                const f32x4 g0 = acc[ai][0][m][0] * rs, g1 = acc[ai][0][m][1] * rs, u0 = acc[ai][1][m][0] * rs, u1 = acc[ai][1][m][1] * rs;
                u32x4 w; w.x = cvt_pk_bf16(sg(g0[0], u0[0]), sg(g0[1], u0[1])); w.y = cvt_pk_bf16(sg(g0[2], u0[2]), sg(g0[3], u0[3]));
                w.z = cvt_pk_bf16(sg(g1[0], u1[0]), sg(g1[1], u1[1])); w.w = cvt_pk_bf16(sg(g1[2], u1[2]), sg(g1[3], u1[3]));
                *(u32x4*)rowp = w; }
    }
};
constexpr float QS_O = 96.f;
__device__ __forceinline__ float o_row_scale(int row) { return QS_O * sqrtf((float)(((row & 4095) >> 6) + 1)); }
template <class ACC = f32x4>
struct EpiResBf16 {
    static constexpr bool PERM = true; static constexpr int NSTORE = 26;
    const bf16_t* base; bf16_t* out; int ldc; float* ssqp; const float* qgain; unsigned char* xq; float qscale; float dq;
    __device__ __forceinline__ void operator()(const ACC (&acc)[2][2][4][2], const Unit& u, int wr, int wc, int fr, int fq) const {
        asm volatile("" : "+v"(fr), "+v"(fq));
        const int row0 = u.pm * BM + wr * 64 + fr, col0 = u.pn * BM + wc * 32 + 8 * fq;
        f32x4 gv[2][2]; float ssv[8];
#pragma unroll
        for (int bj = 0; bj < 2; ++bj)
#pragma unroll
            for (int n = 0; n < 2; ++n) gv[bj][n] = *(const f32x4*)(qgain + col0 + bj * HALF + 4 * n) * qscale;
#pragma unroll
        for (int ai = 0; ai < 2; ++ai)
#pragma unroll
            for (int m = 0; m < 4; ++m) { const int row = row0 + ai * HALF + m * 16; const size_t off = (size_t)row * ldc + col0; float ss = 0.f; u32x2v xq8[2];
                const float as = dq > 0.f ? dq * (1.0f / QS_O) * __builtin_amdgcn_rsqf((float)(((row & 4095) >> 6) + 1)) : 1.f;
#pragma unroll
                for (int bj = 0; bj < 2; ++bj) { const u32x4 b = *(const u32x4*)(base + off + bj * HALF);
                    const f32x4 v0 = tof(acc[ai][bj][m][0]) * as + (f32x4){lo16(b.x), hi16(b.x), lo16(b.y), hi16(b.y)}, v1 = tof(acc[ai][bj][m][1]) * as + (f32x4){lo16(b.z), hi16(b.z), lo16(b.w), hi16(b.w)};
                    ss += (v0[0] * v0[0] + v0[1] * v0[1]) + (v0[2] * v0[2] + v0[3] * v0[3]) + (v1[0] * v1[0] + v1[1] * v1[1]) + (v1[2] * v1[2] + v1[3] * v1[3]);
                    u32x4 w; w.x = cvt_pk_bf16(v0[0], v0[1]); w.y = cvt_pk_bf16(v0[2], v0[3]); w.z = cvt_pk_bf16(v1[0], v1[1]); w.w = cvt_pk_bf16(v1[2], v1[3]);
                    *(u32x4*)(out + off + bj * HALF) = w;
                    const f32x4 q0 = v0 * gv[bj][0], q1 = v1 * gv[bj][1];
                    xq8[bj].x = q8x4(q0[0], q0[1], q0[2], q0[3]); xq8[bj].y = q8x4(q1[0], q1[1], q1[2], q1[3]); }
                store16_pair(xq + off, xq + off + HALF, xq8[0], xq8[1], fq);
                ss += __int_as_float(__builtin_amdgcn_ds_swizzle(__float_as_int(ss), (16 << 10) | 0x1F));
                { auto rr = __builtin_amdgcn_permlane32_swap(__float_as_uint(ss), __float_as_uint(ss), false, false); ss = __uint_as_float(rr[0]) + __uint_as_float(rr[1]); }
                ssv[ai * 4 + m] = ss;
                if (m == 3) asm volatile("" ::: "memory"); }
#pragma unroll
        for (int j = 0; j < 2; ++j) { const float sv = (fq & 2) ? ((fq & 1) ? ssv[6 + j] : ssv[4 + j]) : ((fq & 1) ? ssv[2 + j] : ssv[j]);
            const int i = 2 * fq + j; ssqp[(size_t)(row0 + (i >> 2) * HALF + (i & 3) * 16) * 32 + u.pn * 4 + wc] = sv; }
    }
};
struct EpiResF32 {
    static constexpr bool PERM = false;
    const float* base; float* out; int ldc;
    __device__ __forceinline__ void operator()(const f32x4 (&acc)[2][2][4][2], const Unit& u, int wr, int wc, int fr, int fq) const {
        asm volatile("" : "+v"(fr), "+v"(fq));
        const int col0 = u.pn * BM + wc * 32 + 4 * fq;
#pragma unroll
        for (int ai = 0; ai < 2; ++ai)
#pragma unroll
            for (int m = 0; m < 4; ++m) { const size_t off = (size_t)(u.pm * BM + ai * HALF + wr * 64 + m * 16 + fr) * ldc + col0;
#pragma unroll
                for (int bj = 0; bj < 2; ++bj)
#pragma unroll
                    for (int n = 0; n < 2; ++n) { const f32x4 bs = *(const f32x4*)(base + off + bj * HALF + n * 16); *(f32x4*)(out + off + bj * HALF + n * 16) = bs + acc[ai][bj][m][n]; } }
    }
};
struct EpiLogits {   static constexpr bool NHALF = true;
    static constexpr bool PERM = false;
    float* out; int ldc; int ncol; size_t bstride;
    __device__ __forceinline__ void operator()(const f32x4 (&acc)[2][2][4][2], const Unit& u, int wr, int wc, int fr, int fq) const {
        asm volatile("" : "+v"(fr), "+v"(fq));
        const int col0 = wc * 32 + 4 * fq;
        if (wc * 32 >= ncol) return;
#pragma unroll
        for (int ai = 0; ai < 2; ++ai)
#pragma unroll
            for (int m = 0; m < 4; ++m) { const size_t off = (size_t)u.aux * bstride + (size_t)(u.pm * BM + ai * HALF + wr * 64 + m * 16 + fr) * ldc;
#pragma unroll
                for (int n = 0; n < 2; ++n) { const int c = col0 + n * 16; if (c < ncol) *(f32x4*)(out + off + c) = acc[ai][0][m][n]; } }
    }
};

template <class E, class = void> struct EpiHalfN { static constexpr bool v = false; };
template <class E> struct EpiHalfN<E, decltype((void)E::NHALF)> { static constexpr bool v = E::NHALF; };
template <class E, class = void> struct EpiStores { static constexpr int v = 0; };
template <class E> struct EpiStores<E, decltype((void)E::NSTORE)> { static constexpr int v = E::NSTORE; };
template <class Epi, class Sched, bool GATHER = false, bool I8 = false>
__device__ __forceinline__ void gemm_phase(PG8_LAS unsigned char* lds, const Gemm g, const Sched& S, const Epi& E) {
    int tid = threadIdx.x; asm volatile("" : "+v"(tid));
    const int wid = __builtin_amdgcn_readfirstlane(tid >> 6), lane = tid & 63, wr = wid >> 2, wc = wid & 3, fr = lane & 15, fq = lane >> 4;
    const int K = g.K, nt = K / BK, lda = g.lda, ldb = g.ldb;
    unsigned voffA[2], voffB[2]; int gR[2], gC[2];
#pragma unroll
    for (int i = 0; i < 2; ++i) { int R, C; stage_rc(tid * 16 + i * 8192, R, C); const int Rb = Epi::PERM ? ((R & ~31) + perm32(R & 31)) : R; gR[i] = R; gC[i] = C;
        voffA[i] = (unsigned)(R * lda + C) * 2u; voffB[i] = (unsigned)(Rb * ldb + C) * 2u; }
    unsigned cao[2][2], xao[2][2];
    PG8_LAS unsigned* stash = (PG8_LAS unsigned*)(lds + STAGE_BYTES + 4096) + tid;
#define PG8_GOFF(u, ao) do { _Pragma("unroll") for (int h_ = 0; h_ < 2; ++h_) _Pragma("unroll") for (int i_ = 0; i_ < 2; ++i_) { \
        const unsigned row_ = __hip_atomic_load((const unsigned*)g.rowtab + (u).pm * BM + h_ * HALF + gR[i_], __ATOMIC_RELAXED, __HIP_MEMORY_SCOPE_AGENT); \
        ao[h_][i_] = row_ * (unsigned)(lda * 2) + (unsigned)(gC[i_] * 2); } } while (0)
#define PG8_STAGE_A(bufoff, ptr, h, nx, kt) do { if constexpr (GATHER) { _Pragma("unroll") for (int _i = 0; _i < 2; ++_i) { const unsigned o_ = (nx) ? xao[h][_i] : cao[h][_i]; \
        __builtin_amdgcn_global_load_lds((const unsigned*)((const char*)g.A + o_ + (size_t)(kt) * (BK * 2)), (PG8_LAS unsigned*)(lds + (bufoff) + ldsw + _i * 8192), 16, 0, 0); } } \
        else PG8_STAGE(bufoff, ptr, voffA); } while (0)
    const size_t kstep = (size_t)(BK * 2);
    const size_t hstepA = (size_t)HALF * lda * 2, hstepB = (size_t)HALF * ldb * 2;
    const unsigned ldsw = (unsigned)wid * 1024u;
    const int aoff = lds_byte(wr * 64 + fr, fq * 8), boff = lds_byte(wc * 32 + fr, fq * 8);
#define PG8_SA(b, h) (((b) * 2 + (h)) * HTB)
#define PG8_SB(b, h) ((4 + (b) * 2 + (h)) * HTB)
#define PG8_STAGE(bufoff, gbase, voff) do { _Pragma("unroll") for (int _i = 0; _i < 2; ++_i) \
        __builtin_amdgcn_global_load_lds((const unsigned*)((const char*)(gbase) + (voff)[_i]), (PG8_LAS unsigned*)(lds + (bufoff) + ldsw + _i * 8192), 16, 0, 0); } while (0)
#define PG8_LDA(dst, b, h) do { _Pragma("unroll") for (int m = 0; m < 4; ++m) _Pragma("unroll") for (int k = 0; k < 2; ++k) dst[m][k] = *(const PG8_LAS bf16x8*)(lds + PG8_SA(b, h) + aoff + m * 2048 + k * 1024); } while (0)
#define PG8_LDB(dst, b, h) do { _Pragma("unroll") for (int n = 0; n < 2; ++n) _Pragma("unroll") for (int k = 0; k < 2; ++k) dst[n][k] = *(const PG8_LAS bf16x8*)(lds + PG8_SB(b, h) + boff + n * 2048 + k * 1024); } while (0)
#define PG8_MMA(ai, bj, At, Bt) do { __builtin_amdgcn_s_setprio(1); _Pragma("unroll") for (int m = 0; m < 4; ++m) _Pragma("unroll") for (int n = 0; n < 2; ++n) _Pragma("unroll") for (int k = 0; k < 2; ++k) \
        { if constexpr (I8) acc[ai][bj][m][n] = __builtin_bit_cast(acc_t, __builtin_amdgcn_mfma_i32_16x16x64_i8(__builtin_bit_cast(i32x4, Bt[n][k]), __builtin_bit_cast(i32x4, At[m][k]), __builtin_bit_cast(i32x4, acc[ai][bj][m][n]), 0, 0, 0)); \
          else acc[ai][bj][m][n] = __builtin_bit_cast(acc_t, __builtin_amdgcn_mfma_f32_16x16x32_bf16(Bt[n][k], At[m][k], __builtin_bit_cast(f32x4, acc[ai][bj][m][n]), 0, 0, 0)); } __builtin_amdgcn_s_setprio(0); } while (0)
#define PG8_WAIT_V(n) asm volatile("s_waitcnt vmcnt(" #n ")" ::: "memory")
#define PG8_WAIT_L(n) asm volatile("s_waitcnt lgkmcnt(" #n ")" ::: "memory")
#define PG8_WAIT_VE asm volatile("s_waitcnt vmcnt(%0)" :: "n"(8 + EpiStores<Epi>::v) : "memory")
#define PG8_BAR __builtin_amdgcn_s_barrier()
#define PG8_SCHED __builtin_amdgcn_sched_barrier(0)
    Unit cur, nxt; int ui = 0;
    if (!S.next(0, cur)) return;
    typedef typename AccT<I8>::type acc_t;
    acc_t acc[2][2][4][2];
#pragma unroll
    for (int a = 0; a < 2; ++a)
#pragma unroll
        for (int b = 0; b < 2; ++b)
#pragma unroll
            for (int m = 0; m < 4; ++m)
#pragma unroll
                for (int n = 0; n < 2; ++n) acc[a][b][m][n] = __builtin_bit_cast(acc_t, (f32x4){0.f, 0.f, 0.f, 0.f});
    bf16x8 At[4][2], B0[2][2], B1[2][2];
    const char* cA = S.abase(g, cur); const char* cB = S.bbase(g, cur);
    if constexpr (GATHER) { PG8_GOFF(cur, cao); }
    PG8_STAGE(PG8_SB(0, 0), cB, voffB); PG8_STAGE(PG8_SB(0, 1), cB + hstepB, voffB); PG8_STAGE_A(PG8_SA(0, 0), cA, 0, false, 0); PG8_STAGE_A(PG8_SA(0, 1), cA + hstepA, 1, false, 0);
    if (wr == 1) PG8_BAR;
    PG8_WAIT_V(2); PG8_BAR;
    PG8_STAGE(PG8_SB(1, 0), cB + kstep, voffB); PG8_STAGE_A(PG8_SA(1, 0), cA + kstep, 0, false, 1); PG8_STAGE(PG8_SB(1, 1), cB + hstepB + kstep, voffB);
    if constexpr (GATHER || EpiStores<Epi>::v == 0) { PG8_WAIT_V(6); } else { PG8_WAIT_V(0); }
    PG8_BAR;
    for (;;) {
        const bool has_next = S.next(ui + 1, nxt);
        const char* nA = has_next ? S.abase(g, nxt) : cA; const char* nB = has_next ? S.bbase(g, nxt) : cB;
        if constexpr (GATHER) { if (has_next) { unsigned nao[2][2]; PG8_GOFF(nxt, nao); stash[0] = nao[0][0]; stash[512] = nao[0][1]; stash[1024] = nao[1][0]; stash[1536] = nao[1][1]; } }
#define PG8_KPAIR(t, last, WAITA) do { \
            const char* a1 = cA + (size_t)((t) + 1) * kstep;                                             \
            const char* a2 = (last) ? nA : cA + (size_t)((t) + 2) * kstep; const char* b2 = (last) ? nB : cB + (size_t)((t) + 2) * kstep;     \
            const char* a3 = a2 + kstep; const char* b3 = b2 + kstep;                                \
            const int k2 = (last) ? 0 : (t) + 2; \
            if constexpr (GATHER) { if (last) { if (has_next) { xao[0][0] = stash[0]; xao[0][1] = stash[512]; xao[1][0] = stash[1024]; xao[1][1] = stash[1536]; } \
                else { xao[0][0] = cao[0][0]; xao[0][1] = cao[0][1]; xao[1][0] = cao[1][0]; xao[1][1] = cao[1][1]; } } } \
              \
            PG8_LDB(B0, 0, 0); if constexpr (!EpiHalfN<Epi>::v) PG8_LDB(B1, 0, 1); PG8_SCHED; PG8_LDA(At, 0, 0); PG8_STAGE_A(PG8_SA(1, 1), a1 + hstepA, 1, false, (t) + 1); \
            WAITA; PG8_WAIT_L(0); PG8_BAR; PG8_MMA(0, 0, At, B0); if constexpr (!EpiHalfN<Epi>::v) PG8_MMA(0, 1, At, B1); PG8_BAR; PG8_SCHED; \
            PG8_LDA(At, 0, 1); PG8_STAGE(PG8_SB(0, 0), b2, voffB); PG8_STAGE(PG8_SB(0, 1), b2 + hstepB, voffB); PG8_STAGE_A(PG8_SA(0, 0), a2, 0, last, k2); \
            WAITA; PG8_WAIT_L(0); PG8_BAR; PG8_MMA(1, 0, At, B0); if constexpr (!EpiHalfN<Epi>::v) PG8_MMA(1, 1, At, B1); PG8_BAR; PG8_SCHED; \
              \
            PG8_LDB(B0, 1, 0); if constexpr (!EpiHalfN<Epi>::v) PG8_LDB(B1, 1, 1); PG8_SCHED; PG8_LDA(At, 1, 0); PG8_STAGE_A(PG8_SA(0, 1), a2 + hstepA, 1, last, k2); \
            PG8_WAIT_V(8); PG8_WAIT_L(0); PG8_BAR; PG8_MMA(0, 0, At, B0); if constexpr (!EpiHalfN<Epi>::v) PG8_MMA(0, 1, At, B1); PG8_BAR; PG8_SCHED; \
            PG8_LDA(At, 1, 1); PG8_STAGE(PG8_SB(1, 0), b3, voffB); PG8_STAGE(PG8_SB(1, 1), b3 + hstepB, voffB); PG8_STAGE_A(PG8_SA(1, 0), a3, 0, last, k2 + 1); \
            PG8_WAIT_V(8); PG8_WAIT_L(0); PG8_BAR; PG8_MMA(1, 0, At, B0); if constexpr (!EpiHalfN<Epi>::v) PG8_MMA(1, 1, At, B1); PG8_BAR; PG8_SCHED; } while (0)
        if constexpr (GATHER || EpiStores<Epi>::v == 0) { for (int t = 0; t < nt; t += 2) { const bool last = (t == nt - 2); PG8_KPAIR(t, last, PG8_WAIT_V(8)); } }
        else { PG8_KPAIR(0, false, PG8_WAIT_VE);
               for (int t = 2; t < nt; t += 2) { const bool last = (t == nt - 2); PG8_KPAIR(t, last, PG8_WAIT_V(8)); } }
        if (wr == 0) PG8_BAR;
        { int l2 = threadIdx.x; asm volatile("" : "+v"(l2)); E(acc, cur, wr, wc, l2 & 15, (l2 >> 4) & 3); }
        if (!has_next) break;
#pragma unroll
        for (int a = 0; a < 2; ++a)
#pragma unroll
            for (int b = 0; b < 2; ++b)
#pragma unroll
                for (int m = 0; m < 4; ++m)
#pragma unroll
                    for (int n = 0; n < 2; ++n) acc[a][b][m][n] = __builtin_bit_cast(acc_t, (f32x4){0.f, 0.f, 0.f, 0.f});
        cur = nxt; cA = nA; cB = nB; ++ui;
        if constexpr (GATHER) { cao[0][0] = xao[0][0]; cao[0][1] = xao[0][1]; cao[1][0] = xao[1][0]; cao[1][1] = xao[1][1]; }
        if (wr == 1) PG8_BAR;
    }
    PG8_WAIT_V(0);
    PG8_BAR;
#undef PG8_SA
#undef PG8_SB
#undef PG8_STAGE
#undef PG8_STAGE_A
#undef PG8_GOFF
#undef PG8_LDA
#undef PG8_LDB
#undef PG8_MMA
#undef PG8_WAIT_V
#undef PG8_WAIT_L
#undef PG8_WAIT_VE
#undef PG8_KPAIR
#undef PG8_BAR
#undef PG8_SCHED
}
}
namespace att {
#define ATT_LAS __attribute__((address_space(3)))
typedef unsigned short bf16_t;
typedef short bf16x8 __attribute__((ext_vector_type(8)));
typedef short s16x4 __attribute__((ext_vector_type(4)));
typedef float f32x16 __attribute__((ext_vector_type(16)));
typedef unsigned u32x4 __attribute__((ext_vector_type(4)));
typedef unsigned u32x2 __attribute__((ext_vector_type(2)));
constexpr int SEQ = 4096, NHEAD = 16, QPITCH = 3072, KVPITCH = 4096, OPITCH = 2048, HQK = 192, HKV = 256, VOFF = 128, HV = 128;
constexpr int KT_BYTES = 64 * 256, VT_BYTES = 64 * 128 * 2;
constexpr float QK8 = 16.f;
typedef int i32x4 __attribute__((ext_vector_type(4)));
typedef int i32x16 __attribute__((ext_vector_type(16)));
constexpr int SLOT_BYTES = KT_BYTES + VT_BYTES, NSLOT = 4, LDS_BYTES = NSLOT * SLOT_BYTES;
constexpr float THR = 8.f;

typedef __bf16 bf16x2_t __attribute__((ext_vector_type(2)));
typedef float f32x2_t __attribute__((ext_vector_type(2)));
__device__ __forceinline__ unsigned cvtpk(float lo, float hi) { f32x2_t v = {lo, hi}; bf16x2_t r = __builtin_convertvector(v, bf16x2_t); return __builtin_bit_cast(unsigned, r); }
__device__ __forceinline__ bf16x8 pack8(const f32x16& p, int b) {
    u32x4 w = {cvtpk(p[b + 0], p[b + 1]), cvtpk(p[b + 2], p[b + 3]), cvtpk(p[b + 4], p[b + 5]), cvtpk(p[b + 6], p[b + 7])};
    return __builtin_bit_cast(bf16x8, w);
}
typedef float f32x4v __attribute__((ext_vector_type(4)));
__device__ __forceinline__ float bf2f(short s) { return __uint_as_float(((unsigned)(unsigned short)s) << 16); }
__device__ __forceinline__ bf16x8 pack8f(const float (&v)[8]) { u32x4 w = {cvtpk(v[0], v[1]), cvtpk(v[2], v[3]), cvtpk(v[4], v[5]), cvtpk(v[6], v[7])}; return __builtin_bit_cast(bf16x8, w); }
__device__ __forceinline__ i32x4 pack16q(const float (&v)[16]) { i32x4 w;
    w[0] = (int)pg8::q8x4(v[0], v[1], v[2], v[3]); w[1] = (int)pg8::q8x4(v[4], v[5], v[6], v[7]); w[2] = (int)pg8::q8x4(v[8], v[9], v[10], v[11]); w[3] = (int)pg8::q8x4(v[12], v[13], v[14], v[15]); return w; }
__device__ __forceinline__ int xhalf_imax(int v) { auto rr = __builtin_amdgcn_permlane32_swap((unsigned)v, (unsigned)v, false, false); const int a = (int)rr[0], b = (int)rr[1]; return a > b ? a : b; }
__device__ __forceinline__ s16x4 vtr(ATT_LAS const unsigned char* p) {
    typedef short v4i16_t __attribute__((ext_vector_type(4)));
    return __builtin_bit_cast(s16x4, __builtin_amdgcn_ds_read_tr16_b64_v4i16((ATT_LAS v4i16_t*)p));
}
__device__ __forceinline__ float xhalf_max(float v) { auto rr = __builtin_amdgcn_permlane32_swap(__float_as_uint(v), __float_as_uint(v), false, false); return fmaxf(__uint_as_float(rr[0]), __uint_as_float(rr[1])); }
__device__ __forceinline__ float xhalf_sum(float v) { auto rr = __builtin_amdgcn_permlane32_swap(__float_as_uint(v), __float_as_uint(v), false, false); return __uint_as_float(rr[0]) + __uint_as_float(rr[1]); }

__device__ __forceinline__ void attn_unit(ATT_LAS unsigned char* lds, const bf16_t* __restrict__ Q, const bf16_t* __restrict__ KV, bf16_t* __restrict__ O, const float* __restrict__ qn, const float* __restrict__ CS, int b, int h, int qb) {
    int tid = threadIdx.x; asm volatile("" : "+v"(tid));
    const int lane = tid & 63, c = lane & 31, hi = lane >> 5;
    const int wid = __builtin_amdgcn_readfirstlane(tid >> 6);
    const size_t row0 = (size_t)b * SEQ;
    const int q0 = qb * 256;
    const int NT = 4 * qb + 4;
    const int my_nt = 4 * qb + (wid >> 1) + 1;
    const char* kvh = (const char*)(KV + row0 * KVPITCH + h * HKV);
    unsigned koff[2], voff[2];
#pragma unroll
    for (int i = 0; i < 2; ++i) { const int qi = 64 * (wid + 8 * i) + lane, krow = qi >> 4, pos = qi & 15, kc = pos ^ (krow & 15);
        koff[i] = (unsigned)(krow * KVPITCH * 2 + kc * 16); }
#pragma unroll
    for (int j = 0; j < 2; ++j) { const int sg = 2 * (wid + 8 * j) + (lane >> 5), kb = sg >> 2, cg = sg & 3, vrow = kb * 8 + ((lane & 31) >> 2), vcol = cg * 32 + (lane & 3) * 8;
        voff[j] = (unsigned)(vrow * KVPITCH * 2 + (VOFF + vcol) * 2); }
#define ATT_DMA_K(t, kbuf) do { const char* tb_ = kvh + (size_t)(t) * 64 * KVPITCH * 2; \
        _Pragma("unroll") for (int i_ = 0; i_ < 2; ++i_) __builtin_amdgcn_global_load_lds((const unsigned*)(tb_ + koff[i_]), (ATT_LAS unsigned*)(lds + (kbuf) + 1024 * (wid + 8 * i_)), 16, 0, 0); } while (0)
#define ATT_DMA_V(t, vbuf) do { const char* tb_ = kvh + (size_t)(t) * 64 * KVPITCH * 2; \
        _Pragma("unroll") for (int j_ = 0; j_ < 2; ++j_) __builtin_amdgcn_global_load_lds((const unsigned*)(tb_ + voff[j_]), (ATT_LAS unsigned*)(lds + (vbuf) + 1024 * (wid + 8 * j_)), 16, 0, 0); } while (0)
    asm volatile("s_waitcnt lgkmcnt(0)\n\ts_barrier" ::: "memory");
    ATT_DMA_K(0, 0); ATT_DMA_K(1, KT_BYTES); ATT_DMA_V(0, 4 * KT_BYTES);
    i32x4 qf[6];
    { const size_t trow = row0 + q0 + 32 * wid + c;
      const unsigned char* qp = (const unsigned char*)Q + trow * QPITCH + h * HQK + 16 * hi;
      float qr[6][16];
#pragma unroll
      for (int s = 0; s < 6; ++s) { const i32x4 w = *(const i32x4*)(qp + 32 * s);
#pragma unroll
          for (int e = 0; e < 16; ++e) qr[s][e] = (float)((w[e >> 2] << (24 - 8 * (e & 3))) >> 24); }
      float ss = 0.f;
#pragma unroll
      for (int s = 0; s < 6; ++s)
#pragma unroll
          for (int e = 0; e < 16; ++e) { const float v = qr[s][e]; ss += v * v; }
      ss = xhalf_sum(ss);
      const float rs = (1.0f / sqrtf(ss * (1.0f / 192.f) + 1e-6f * 256.f)) * QK8;
#pragma unroll
      for (int s = 0; s < 4; ++s) { float v[16];
#pragma unroll
          for (int q4 = 0; q4 < 4; ++q4) { const f32x4v g = *(const f32x4v*)(qn + 32 * s + 16 * hi + 4 * q4);
#pragma unroll
              for (int e = 0; e < 4; ++e) v[4 * q4 + e] = qr[s][4 * q4 + e] * rs * g[e]; }
          qf[s] = pack16q(v); }
      const float* csr = CS + trow * 64 + 16 * hi;
      { float o1[16], o2[16];
#pragma unroll
        for (int q4 = 0; q4 < 4; ++q4) { const f32x4v ga = *(const f32x4v*)(qn + 128 + 16 * hi + 4 * q4), gb = *(const f32x4v*)(qn + 160 + 16 * hi + 4 * q4);
            const f32x4v cc = *(const f32x4v*)(csr + 4 * q4), sn = *(const f32x4v*)(csr + 32 + 4 * q4);
#pragma unroll
            for (int e = 0; e < 4; ++e) { const int idx = 4 * q4 + e; const float n1 = qr[4][idx] * rs * ga[e], n2 = qr[5][idx] * rs * gb[e];
                o1[idx] = n1 * cc[e] - n2 * sn[e]; o2[idx] = n2 * cc[e] + n1 * sn[e]; } }
        qf[4] = pack16q(o1); qf[5] = pack16q(o2); } }
    unsigned ko[6];
#pragma unroll
    for (int s = 0; s < 6; ++s) ko[s] = (unsigned)(c * 256 + 16 * ((2 * s + hi) ^ (c & 15)));
    const unsigned vbase = (unsigned)(hi * 256 + ((lane >> 2) & 3) * 64 + ((lane >> 4) & 1) * 32 + (lane & 3) * 8);
    f32x16 o[4];
#pragma unroll
    for (int d = 0; d < 4; ++d)
#pragma unroll
        for (int r = 0; r < 16; ++r) o[d][r] = 0.f;
    float l_run = 0.f;
    constexpr float CSC = 0.07216878364870322f * 1.4426950408889634f / (QK8 * QK8);
#define ATT_QKH(A, koff_) do { ATT_LAS const unsigned char* kp = lds + (koff_); \
            { const i32x16 z = {0, 0, 0, 0, 0, 0, 0, 0, 0, 0, 0, 0, 0, 0, 0, 0}; const i32x4 k0 = *(ATT_LAS const i32x4*)(kp + ko[0]); A = __builtin_amdgcn_mfma_i32_32x32x32_i8(k0, qf[0], z, 0, 0, 0); } \
            _Pragma("unroll") for (int s = 1; s < 6; ++s) { const i32x4 k0 = *(ATT_LAS const i32x4*)(kp + ko[s]); A = __builtin_amdgcn_mfma_i32_32x32x32_i8(k0, qf[s], A, 0, 0, 0); } } while (0)
#define ATT_EXPH(A, P0, P1) do { float pe[16]; \
            _Pragma("unroll") for (int r = 0; r < 16; ++r) pe[r] = __builtin_amdgcn_exp2f((float)A[r] * CSC); \
            { u32x4 w = {cvtpk(pe[0], pe[1]), cvtpk(pe[2], pe[3]), cvtpk(pe[4], pe[5]), cvtpk(pe[6], pe[7])}; P0 = __builtin_bit_cast(bf16x8, w); } \
            { u32x4 w = {cvtpk(pe[8], pe[9]), cvtpk(pe[10], pe[11]), cvtpk(pe[12], pe[13]), cvtpk(pe[14], pe[15])}; P1 = __builtin_bit_cast(bf16x8, w); } \
            float ps = 0.f; \
            _Pragma("unroll") for (int r = 0; r < 16; ++r) ps += pe[r]; \
            l_run += ps; } while (0)
#define ATT_PVH(P0, P1, voff_) do { ATT_LAS const unsigned char* vp = lds + (voff_) + vbase; \
            _Pragma("unroll") for (int d = 0; d < 4; ++d) { \
                    const s16x4 lo = vtr(vp + d * 512), hh = vtr(vp + 2048 + d * 512); \
                    const bf16x8 a = {lo[0], lo[1], lo[2], lo[3], hh[0], hh[1], hh[2], hh[3]}; \
                    o[d] = __builtin_amdgcn_mfma_f32_32x32x16_bf16(a, P0, o[d], 0, 0, 0); } \
            _Pragma("unroll") for (int d = 0; d < 4; ++d) { \
                    const s16x4 lo = vtr(vp + 4096 + d * 512), hh = vtr(vp + 4096 + 2048 + d * 512); \
                    const bf16x8 a = {lo[0], lo[1], lo[2], lo[3], hh[0], hh[1], hh[2], hh[3]}; \
                    o[d] = __builtin_amdgcn_mfma_f32_32x32x16_bf16(a, P1, o[d], 0, 0, 0); } } while (0)
#define ATT_VF(j_) ({ const int d_ = (j_) & 3, h_ = (j_) >> 2; const s16x4 lo_ = vtr(vp_s + h_ * 4096 + d_ * 512), hh_ = vtr(vp_s + h_ * 4096 + 2048 + d_ * 512); \
        bf16x8 a_ = {lo_[0], lo_[1], lo_[2], lo_[3], hh_[0], hh_[1], hh_[2], hh_[3]}; a_; })
#define ATT_PV1(j_, vf_, P0, P1) o[(j_) & 3] = __builtin_amdgcn_mfma_f32_32x32x16_bf16(vf_, ((j_) < 4 ? P0 : P1), o[(j_) & 3], 0, 0, 0)
#define ATT_E(r_) pe[r_] = __builtin_amdgcn_exp2f((float)Ain_[r_] * CSC)
#define ATT_HALF(A, koff_, P0, P1, voff_, AinV, Pout0, Pout1) do { \
        ATT_LAS const unsigned char* kp_s = lds + (koff_); ATT_LAS const unsigned char* vp_s = lds + (voff_) + vbase; const i32x16 Ain_ = AinV; float pe[16]; \
        i32x4 kf = *(ATT_LAS const i32x4*)(kp_s + ko[0]); bf16x8 va_ = ATT_VF(0), vb_ = ATT_VF(1); \
        __builtin_amdgcn_sched_barrier(0); \
        { const i32x16 z = {0, 0, 0, 0, 0, 0, 0, 0, 0, 0, 0, 0, 0, 0, 0, 0}; A = __builtin_amdgcn_mfma_i32_32x32x32_i8(kf, qf[0], z, 0, 0, 0); } asm volatile("" : "+v"(A)); ATT_PV1(0, va_, P0, P1); ATT_PV1(1, vb_, P0, P1); \
        kf = *(ATT_LAS const i32x4*)(kp_s + ko[1]); va_ = ATT_VF(2); ATT_E(0); ATT_E(1); ATT_E(2); \
        __builtin_amdgcn_sched_barrier(0); \
        A = __builtin_amdgcn_mfma_i32_32x32x32_i8(kf, qf[1], A, 0, 0, 0); asm volatile("" : "+v"(A)); ATT_PV1(2, va_, P0, P1); \
        kf = *(ATT_LAS const i32x4*)(kp_s + ko[2]); va_ = ATT_VF(3); ATT_E(3); ATT_E(4); ATT_E(5); \
        __builtin_amdgcn_sched_barrier(0); \
        A = __builtin_amdgcn_mfma_i32_32x32x32_i8(kf, qf[2], A, 0, 0, 0); asm volatile("" : "+v"(A)); ATT_PV1(3, va_, P0, P1); \
        kf = *(ATT_LAS const i32x4*)(kp_s + ko[3]); va_ = ATT_VF(4); vb_ = ATT_VF(5); ATT_E(6); ATT_E(7); \
        { u32x4 w = {cvtpk(pe[0], pe[1]), cvtpk(pe[2], pe[3]), cvtpk(pe[4], pe[5]), cvtpk(pe[6], pe[7])}; Pout0 = __builtin_bit_cast(bf16x8, w); } \
        __builtin_amdgcn_sched_barrier(0); \
        A = __builtin_amdgcn_mfma_i32_32x32x32_i8(kf, qf[3], A, 0, 0, 0); asm volatile("" : "+v"(A)); ATT_PV1(4, va_, P0, P1); ATT_PV1(5, vb_, P0, P1); \
        kf = *(ATT_LAS const i32x4*)(kp_s + ko[4]); va_ = ATT_VF(6); ATT_E(8); ATT_E(9); ATT_E(10); \
        __builtin_amdgcn_sched_barrier(0); \
        A = __builtin_amdgcn_mfma_i32_32x32x32_i8(kf, qf[4], A, 0, 0, 0); asm volatile("" : "+v"(A)); ATT_PV1(6, va_, P0, P1); \
        kf = *(ATT_LAS const i32x4*)(kp_s + ko[5]); va_ = ATT_VF(7); ATT_E(11); ATT_E(12); ATT_E(13); \
        __builtin_amdgcn_sched_barrier(0); \
        A = __builtin_amdgcn_mfma_i32_32x32x32_i8(kf, qf[5], A, 0, 0, 0); asm volatile("" : "+v"(A)); ATT_PV1(7, va_, P0, P1); \
        ATT_E(14); ATT_E(15); \
        { u32x4 w = {cvtpk(pe[8], pe[9]), cvtpk(pe[10], pe[11]), cvtpk(pe[12], pe[13]), cvtpk(pe[14], pe[15])}; Pout1 = __builtin_bit_cast(bf16x8, w); } \
        { float ps = 0.f; _Pragma("unroll") for (int r = 0; r < 16; ++r) ps += pe[r]; l_run += ps; } \
        __builtin_amdgcn_sched_barrier(0); } while (0)
    { i32x16 aX, aY; bf16x8 pX0, pX1, pY0, pY1;
      for (int t = -1; t <= NT; ++t) {
          if (t + 2 < NT) asm volatile("s_waitcnt vmcnt(4) lgkmcnt(0)\n\ts_barrier" ::: "memory");
          else if (t + 1 < NT) asm volatile("s_waitcnt vmcnt(2) lgkmcnt(0)\n\ts_barrier" ::: "memory");
          else asm volatile("s_waitcnt vmcnt(0) lgkmcnt(0)\n\ts_barrier" ::: "memory");
          if (t + 3 < NT) ATT_DMA_K(t + 3, ((t + 3) & 3) * KT_BYTES);
          if (t + 2 < NT) ATT_DMA_V(t + 2, 4 * KT_BYTES + ((t + 2) & 3) * VT_BYTES);
          const int kc = (t & 3) * KT_BYTES + 32 * 256, kn = ((t + 1) & 3) * KT_BYTES;
          const int vp_ = 4 * KT_BYTES + ((t - 1) & 3) * VT_BYTES + 2 * 4096, vc = 4 * KT_BYTES + (t & 3) * VT_BYTES;
          const bool act = (t >= 0 && t < my_nt), v0 = (t >= 1 && t <= my_nt), q1 = (t + 1 < my_nt);
          if (act && v0 && q1) {
              ATT_HALF(aY, kc, pY0, pY1, vp_, aX, pX0, pX1);
              ATT_HALF(aX, kn, pX0, pX1, vc, aY, pY0, pY1);
          } else {
              if (act) ATT_QKH(aY, kc);
              if (v0) ATT_PVH(pY0, pY1, vp_);
              if (act) ATT_EXPH(aX, pX0, pX1);
              __builtin_amdgcn_sched_barrier(0);
              if (q1) ATT_QKH(aX, kn);
              if (act) { ATT_PVH(pX0, pX1, vc); ATT_EXPH(aY, pY0, pY1); }
              __builtin_amdgcn_sched_barrier(0);
          }
      } }
#undef ATT_HALF
#undef ATT_E
#undef ATT_PV1
#undef ATT_VF
#undef ATT_PVH
#undef ATT_EXPH
#undef ATT_QKH
    l_run = xhalf_sum(l_run);
#undef ATT_STEP
#undef ATT_STAGES
#undef ATT_CHUNK
#undef ATT_QK1
    { const int spos = q0 + 32 * wid + c; const float sc = pg8::o_row_scale(spos) / l_run;
      unsigned char* op = (unsigned char*)O + (row0 + spos) * 2048 + h * HV;
#pragma unroll
      for (int d = 0; d < 4; ++d)
          { u32x4 w;
#pragma unroll
            for (int j = 0; j < 2; ++j) { const int g0 = j, g1 = j + 2;
              const unsigned w0 = pg8::q8x4(o[d][4 * g0] * sc, o[d][4 * g0 + 1] * sc, o[d][4 * g0 + 2] * sc, o[d][4 * g0 + 3] * sc);
              const unsigned w1 = pg8::q8x4(o[d][4 * g1] * sc, o[d][4 * g1 + 1] * sc, o[d][4 * g1 + 2] * sc, o[d][4 * g1 + 3] * sc);
              auto rr = __builtin_amdgcn_permlane32_swap(w0, w1, false, false);
              if (j == 0) { w.x = rr[0]; w.y = rr[1]; } else { w.z = rr[0]; w.w = rr[1]; } }
            *(u32x4*)(op + 32 * d + (hi ? 16 : 0)) = w; } }
#undef ATT_DMA_K
#undef ATT_DMA_V
}
__device__ __forceinline__ void attn_phase(ATT_LAS unsigned char* lds, const bf16_t* Q, const bf16_t* KV, bf16_t* O, const float* qn, const float* CS, unsigned* queues, int xcc) {
    ATT_LAS unsigned* tk = (ATT_LAS unsigned*)(lds + LDS_BYTES);
    for (int s = 0; s < 8; ++s) {
        const int qx = (xcc + s) & 7;
        for (;;) {
            if (threadIdx.x == 0) *tk = __hip_atomic_fetch_add(queues + 64 * qx, 1u, __ATOMIC_RELAXED, __HIP_MEMORY_SCOPE_AGENT);
            asm volatile("s_waitcnt vmcnt(0) lgkmcnt(0)\n\ts_barrier" ::: "memory");
            const unsigned pr = (unsigned)__builtin_amdgcn_readfirstlane((int)*tk);
            asm volatile("s_waitcnt lgkmcnt(0)\n\ts_barrier" ::: "memory");
            if (pr >= 128u) break;
            const int pair = qx * 128 + (int)pr, bh = pair >> 3, x = pair & 7, b = bh >> 4, h = bh & 15;
#pragma nounroll
            for (int u = 0; u < 2; ++u) attn_unit(lds, Q, KV, O, qn, CS, b, h, u ? x : 15 - x);
        }
    }
    asm volatile("s_waitcnt vmcnt(0) lgkmcnt(0)\n\ts_barrier" ::: "memory");
}
}
#ifndef MK_MULTI
#define MK_MULTI 0
#endif
constexpr int NWAVES = 8;
constexpr int T = 32768, DM = 2048, SEQ = 4096, NB = 8, NH = 16;
constexpr int NPHASE = 20;
constexpr float EPS = 1e-6f;
constexpr int PSLOTS = 81920;
constexpr size_t MiB = 1u << 20;
constexpr size_t WS_CTL = 0, CTL_ZERO_BYTES = 1 * MiB;
constexpr size_t WS_WIN = 1 * MiB;
constexpr size_t WS_WQ = 6 * MiB;
constexpr size_t WS_WKV = 9 * MiB;
constexpr size_t WS_WO = 13 * MiB;
constexpr size_t WS_PWIN = 21 * MiB;
constexpr size_t WS_WG = 29 * MiB;
constexpr size_t WS_PWO = 31 * MiB;
constexpr size_t WS_RW = 39 * MiB;
constexpr size_t WS_CS = 41 * MiB;
constexpr size_t WS_GUT = 50 * MiB;
constexpr size_t WS_DT = 562 * MiB;
constexpr size_t WS_XB0 = 818 * MiB;
constexpr size_t WS_LOG = 946 * MiB;
constexpr size_t WS_MISC = 956 * MiB;
constexpr size_t WS_U = 960 * MiB;
constexpr size_t WS_C = WS_U, WS_CQ = WS_U + 80 * MiB, WS_CKV = WS_U + 112 * MiB, WS_Q = WS_U + 144 * MiB, WS_KV = WS_U + 336 * MiB, WS_O = WS_U + 656 * MiB;
constexpr size_t WS_CQ8 = WS_U + 80 * MiB;
constexpr size_t WS_XQ = WS_U;
constexpr size_t WS_XS = WS_U, WS_H = WS_U + 320 * MiB, WS_Y = WS_U + 400 * MiB;
constexpr size_t WS_LOG1 = WS_U + 736 * MiB;
constexpr size_t WS_SSQC = WS_U + 746 * MiB;
constexpr size_t WS_UU = WS_U, WS_PM = WS_U + 128 * MiB, WS_Y2 = WS_U + 256 * MiB;
constexpr size_t WS_XB1 = WS_U + 784 * MiB;
constexpr size_t WS_SSQP = WS_XB1 + 128 * MiB;
constexpr size_t WS_WPT = WS_SSQP + 4 * MiB;
constexpr size_t WS_END = WS_WPT + 8 * MiB;
constexpr size_t MS_TOKE = 0;
constexpr size_t MS_TOKW = 256 * 1024;
constexpr size_t MS_SLOT = 512 * 1024;
constexpr size_t MS_BC = 768 * 1024;
constexpr size_t MS_TILE = 896 * 1024;
constexpr size_t MS_RSTD0 = 1024 * 1024;
constexpr size_t MS_RSTD2 = 1152 * 1024;
constexpr size_t MS_RSTOK = 1280 * 1024;
constexpr size_t MS_RSSLOT = 1408 * 1024;
constexpr size_t MS_STOK = 1792 * 1024;
constexpr int CW_BAR = 4096;
constexpr int LDS_TILE_OFF = 143360;
constexpr int CW_ATTQ = 8192;
constexpr int CW_CONVQ = 8192 + 1024;
constexpr int NCONV = 6;

#define GAS __attribute__((address_space(1)))
#define LAS __attribute__((address_space(3)))
typedef unsigned short bf16;
typedef unsigned v4u __attribute__((ext_vector_type(4)));
typedef unsigned v2u __attribute__((ext_vector_type(2)));
typedef float f32x4 __attribute__((ext_vector_type(4)));
#define RLX_AGENT __ATOMIC_RELAXED, __HIP_MEMORY_SCOPE_AGENT
__device__ __forceinline__ unsigned pk2(float lo, float hi) { return pg8::cvt_pk_bf16(lo, hi); }
__device__ __forceinline__ float bf_lo(unsigned w) { return __uint_as_float(w << 16); }
__device__ __forceinline__ float bf_hi(unsigned w) { return __uint_as_float(w & 0xffff0000u); }

#define XB_TMO      128
#define XB_XCNT(j)  (256  + 64 * (j))
#define XB_XSUB(j)  (1280 + 64 * (j))
#define XB_XGEN(j)  (2304 + 64 * (j))
#define XB_TOP      3328
#define XB_TOPGEN   3392
#define XCD_BAR_WORDS 3456
#define XB_SPIN_CAP (1u << 18)
__device__ __forceinline__ unsigned xb_ld(unsigned* p)              { return __hip_atomic_load(p, __ATOMIC_RELAXED, __HIP_MEMORY_SCOPE_AGENT); }
__device__ __forceinline__ unsigned xb_add(unsigned* p, unsigned v) { return __hip_atomic_fetch_add(p, v, __ATOMIC_RELAXED, __HIP_MEMORY_SCOPE_AGENT); }
__device__ __forceinline__ unsigned xb_xcc_id() { return (unsigned)__builtin_amdgcn_s_getreg((3 << 11) | 20) & 0xFu; }
#define XB_SPIN(cond, bar) do { unsigned _sp = 0; while (cond) { __builtin_amdgcn_s_sleep(1); \
    if ((++_sp & 255u) == 0u) { if (xb_ld(&(bar)[XB_TMO])) break; if (_sp > XB_SPIN_CAP) { atomicAdd(&(bar)[XB_TMO], 1u); break; } } } } while (0)
struct XcdBarrier { unsigned* bar; unsigned x; volatile LAS unsigned* st; };
__device__ __forceinline__ XcdBarrier xcd_barrier_post(unsigned* bar, volatile LAS unsigned* st) {
    XcdBarrier b; b.bar = bar; b.x = xb_xcc_id(); b.st = st;
    if (threadIdx.x == 0) (void)xb_add(&bar[XB_XCNT(b.x)], 1u);
    return b;
}
__device__ __forceinline__ void xcd_barrier_complete(unsigned* bar, unsigned x, unsigned& nloc, unsigned& nx) {
    const unsigned G = gridDim.x * gridDim.y * gridDim.z;
    unsigned sum, cnt, mine, sp = 0u;
    for (;;) {
        sum = 0u; cnt = 0u; mine = 0u;
#pragma unroll
        for (unsigned j = 0; j < 16; ++j) { const unsigned c = xb_ld(&bar[XB_XCNT(j)]); sum += c; cnt += (c > 0u) ? 1u : 0u; mine = (j == x) ? c : mine; }
        if (sum == G) break;
        __builtin_amdgcn_s_sleep(1);
        if ((++sp & 255u) == 0u) { if (xb_ld(&bar[XB_TMO])) break; if (sp > XB_SPIN_CAP) { atomicAdd(&bar[XB_TMO], 1u); break; } }
    }
    nloc = mine > 0u ? mine : 1u; nx = cnt > 0u ? cnt : 1u;
}
__device__ __forceinline__ void xcd_barrier(const XcdBarrier& b) {
    asm volatile("s_waitcnt vmcnt(0)" ::: "memory");
    __syncthreads();
    if (threadIdx.x == 0) {
        unsigned* bar = b.bar;
        __builtin_amdgcn_s_waitcnt(0);
        unsigned nloc = b.st[0], nx = b.st[1];
        if (nloc == 0u) { xcd_barrier_complete(bar, b.x, nloc, nx); b.st[0] = nloc; b.st[1] = nx; }
        const unsigned old = xb_add(&bar[XB_XSUB(b.x)], 1u);
        const unsigned gen = old / nloc;
        if (old + 1u == (gen + 1u) * nloc) {
            __builtin_amdgcn_fence(__ATOMIC_RELEASE, "agent");
            asm volatile("s_waitcnt vmcnt(0)" ::: "memory");
            const unsigned og = xb_add(&bar[XB_TOP], 1u);
            const unsigned tg = og / nx;
            if (og + 1u == (tg + 1u) * nx) xb_add(&bar[XB_TOPGEN], 1u);
            else XB_SPIN(xb_ld(&bar[XB_TOPGEN]) == tg, bar);
            __builtin_amdgcn_fence(__ATOMIC_ACQUIRE, "agent");
            xb_add(&bar[XB_XGEN(b.x)], 1u);
            asm volatile("s_waitcnt vmcnt(0)" ::: "memory");
        } else {
            XB_SPIN(xb_ld(&bar[XB_XGEN(b.x)]) == gen, bar);
            __builtin_amdgcn_fence(__ATOMIC_ACQUIRE, "agent");
            asm volatile("s_waitcnt vmcnt(0)" ::: "memory");
        }
    }
    __syncthreads();
}

__device__ __forceinline__ void ld8(const bf16* p, float (&v)[8]) { const v4u a = *(const v4u*)p;
    v[0] = bf_lo(a.x); v[1] = bf_hi(a.x); v[2] = bf_lo(a.y); v[3] = bf_hi(a.y); v[4] = bf_lo(a.z); v[5] = bf_hi(a.z); v[6] = bf_lo(a.w); v[7] = bf_hi(a.w); }
#define SWZ_XOR(k) (((k) << 10) | 0x1F)
__device__ __forceinline__ float wave_sum(float v) {
    v += __int_as_float(__builtin_amdgcn_ds_swizzle(__float_as_int(v), SWZ_XOR(1)));
    v += __int_as_float(__builtin_amdgcn_ds_swizzle(__float_as_int(v), SWZ_XOR(2)));
    v += __int_as_float(__builtin_amdgcn_ds_swizzle(__float_as_int(v), SWZ_XOR(4)));
    v += __int_as_float(__builtin_amdgcn_ds_swizzle(__float_as_int(v), SWZ_XOR(8)));
    v += __int_as_float(__builtin_amdgcn_ds_swizzle(__float_as_int(v), SWZ_XOR(16)));
    auto rr = __builtin_amdgcn_permlane32_swap(__float_as_uint(v), __float_as_uint(v), false, false);
    return __uint_as_float(rr[0]) + __uint_as_float(rr[1]);
}
struct Ctx { LAS unsigned char* lds; int tid, lane, wave, vcu, G, gw, NGW, bx; };
__device__ __forceinline__ Ctx make_ctx(LAS unsigned char* lds) {
    Ctx X; X.lds = lds;
    int tid = threadIdx.x, G = gridDim.x, bx = blockIdx.x; asm volatile("" : "+v"(tid)); asm volatile("" : "+s"(G), "+s"(bx));
    X.tid = tid; X.lane = tid & 63; X.wave = __builtin_amdgcn_readfirstlane(tid >> 6); X.G = G; X.bx = bx;
    X.vcu = (G % 8 == 0) ? (bx % 8) * (G / 8) + bx / 8 : bx;
    X.gw = X.vcu * NWAVES + X.wave; X.NGW = G * NWAVES;
    return X;
}

__device__ __forceinline__ void tr_item(const float* __restrict__ W, int N, bf16* __restrict__ WT, int ldk, int k0, int n0, int orow0, const float* __restrict__ kscale, int lane) {
    const int c = lane & 15, g = lane >> 4;
    const float* src = W + (size_t)(k0 + 8 * g) * N + n0 + 4 * c;
    f32x4 v[2][8];
#pragma unroll
    for (int hh = 0; hh < 2; ++hh)
#pragma unroll
        for (int j = 0; j < 8; ++j) v[hh][j] = *(const f32x4*)(src + (size_t)(32 * hh + j) * N);
    if (kscale) {
#pragma unroll
        for (int hh = 0; hh < 2; ++hh) { const f32x4 s0 = *(const f32x4*)(kscale + k0 + 32 * hh + 8 * g), s1 = *(const f32x4*)(kscale + k0 + 32 * hh + 8 * g + 4);
#pragma unroll
            for (int j = 0; j < 8; ++j) v[hh][j] = v[hh][j] * (j < 4 ? s0[j & 3] : s1[j & 3]); }
    }
#pragma unroll
    for (int hh = 0; hh < 2; ++hh)
#pragma unroll
        for (int jj = 0; jj < 4; ++jj) {
            v4u o; o.x = pk2(v[hh][0][jj], v[hh][1][jj]); o.y = pk2(v[hh][2][jj], v[hh][3][jj]); o.z = pk2(v[hh][4][jj], v[hh][5][jj]); o.w = pk2(v[hh][6][jj], v[hh][7][jj]);
            *(v4u*)(WT + (size_t)(orow0 + 4 * c + jj) * ldk + k0 + 32 * hh + 8 * g) = o;
        }
}
__device__ __forceinline__ float store_row_rstd(const f32x4 (&v)[8], bf16* __restrict__ orow, int lane) {
    float s = 0.f;
#pragma unroll
    for (int j = 0; j < 8; ++j) s += (v[j][0] * v[j][0] + v[j][1] * v[j][1]) + (v[j][2] * v[j][2] + v[j][3] * v[j][3]);
#pragma unroll
    for (int j = 0; j < 8; ++j) { v2u w; w.x = pk2(v[j][0], v[j][1]); w.y = pk2(v[j][2], v[j][3]); *(v2u*)(orow + 4 * lane + 256 * j) = w; }
    return 1.0f / sqrtf(wave_sum(s) * (1.0f / DM) + EPS);
}

struct Params {
    const float* in[23]; float* out; unsigned char* ws; int ph_lo, ph_hi;
};
typedef const __attribute__((address_space(4))) Params* KP;
__device__ __forceinline__ KP kargs() { KP k = (KP)__builtin_amdgcn_kernarg_segment_ptr(); asm volatile("" : "+s"(k)); return k; }

constexpr int MOE_ITEMS = 128 * 768, CONV_CHUNK = 8, CONV_TICKETS = MOE_ITEMS / CONV_CHUNK;
struct TrJob { const float* W; unsigned char* WT; int N, ldk, k0, n0, orow0; float scale; const float* ks; };
constexpr float QS_Q = 16.f;
constexpr float QS_Y = 32.f;
constexpr float QS_A = 16.f, QS_WGU = 1024.f, QS_H = 16.f, QS_WD = 512.f, QS_X = 16.f, QS_WIN = 1024.f, QS_C = 16.f, QS_WQK = 512.f;
__device__ __forceinline__ TrJob moe_job(KP p, int r) {
    unsigned char* GUT = (unsigned char*)(p->ws + WS_GUT); unsigned char* DT = (unsigned char*)(p->ws + WS_DT);
    const int le = r / 768, rr = r % 768, which = rr / 256, id = rr % 256; TrJob j;
    if (which < 2) { const int kb = id / 16, nb = id % 16, n0 = 32 * nb;
        j.W = p->in[20 + which] + (size_t)le * 2048 * 512; j.N = 512; j.WT = GUT + (size_t)le * 1024 * 2048; j.ldk = 2048; j.k0 = 128 * kb; j.n0 = n0; j.orow0 = 256 * (n0 >> 7) + (n0 & 127) + 128 * which; j.scale = QS_WGU; j.ks = nullptr;
    } else { const int kb = id / 64, nb = id % 64;
        j.W = p->in[22] + (size_t)le * 512 * 2048; j.N = 2048; j.WT = DT + (size_t)le * 2048 * 512; j.ldk = 512; j.k0 = 128 * kb; j.n0 = 32 * nb; j.orow0 = 32 * nb; j.scale = QS_WD; j.ks = nullptr; }
    return j;
}
__device__ __forceinline__ void tr_load(const TrJob& j, f32x4 (&v)[16], int lane) {
    const int c = lane & 7, g = lane >> 3; const float* src = j.W + (size_t)(j.k0 + 16 * g) * j.N + j.n0 + 4 * c;
#pragma unroll
    for (int q = 0; q < 16; ++q) v[q] = __builtin_nontemporal_load((const f32x4*)(src + (size_t)q * j.N));
}
__device__ __forceinline__ void tr_store(const TrJob& j, f32x4 (&v)[16], int lane) {
    const int c = lane & 7, g = lane >> 3;
    if (j.ks) {
#pragma unroll
        for (int q4 = 0; q4 < 4; ++q4) { const f32x4 s = *(const f32x4*)(j.ks + j.k0 + 16 * g + 4 * q4);
#pragma unroll
            for (int e = 0; e < 4; ++e) v[4 * q4 + e] = v[4 * q4 + e] * s[e]; } }
#pragma unroll
    for (int jj = 0; jj < 4; ++jj) {
        v4u o; o.x = pg8::q8x4(v[0][jj] * j.scale, v[1][jj] * j.scale, v[2][jj] * j.scale, v[3][jj] * j.scale); o.y = pg8::q8x4(v[4][jj] * j.scale, v[5][jj] * j.scale, v[6][jj] * j.scale, v[7][jj] * j.scale);
        o.z = pg8::q8x4(v[8][jj] * j.scale, v[9][jj] * j.scale, v[10][jj] * j.scale, v[11][jj] * j.scale); o.w = pg8::q8x4(v[12][jj] * j.scale, v[13][jj] * j.scale, v[14][jj] * j.scale, v[15][jj] * j.scale);
        *(v4u*)(j.WT + (size_t)(j.orow0 + 4 * c + jj) * j.ldk + j.k0 + 16 * g) = o;
    }
}
__device__ __forceinline__ void moe_convert_drain(KP p, unsigned* q, int lane) {
    for (;;) {
        unsigned t = 0u; if (lane == 0) t = __hip_atomic_fetch_add(q, 1u, RLX_AGENT);
        t = (unsigned)__builtin_amdgcn_readfirstlane((int)t);
        if (t >= (unsigned)CONV_TICKETS) break;
        for (int i = 0; i < CONV_CHUNK; i += 2) {
            const TrJob ja = moe_job(p, (int)t * CONV_CHUNK + i), jb = moe_job(p, (int)t * CONV_CHUNK + i + 1);
            f32x4 va[16], vb[16]; tr_load(ja, va, lane); tr_load(jb, vb, lane); tr_store(ja, va, lane); tr_store(jb, vb, lane); }
    }
}

__device__ __forceinline__ void phase_prologue(const Ctx& X, KP p) {
    unsigned char* ws = p->ws;
    bf16* WinT = (bf16*)(ws + WS_WIN); bf16* WqT = (bf16*)(ws + WS_WQ); bf16* WkvT = (bf16*)(ws + WS_WKV); bf16* WoT = (bf16*)(ws + WS_WO);
    bf16* PwinT = (bf16*)(ws + WS_PWIN); bf16* WgT = (bf16*)(ws + WS_WG); bf16* PwoT = (bf16*)(ws + WS_PWO); bf16* RW = (bf16*)(ws + WS_RW);
    float* CS = (float*)(ws + WS_CS); bf16* XB0 = (bf16*)(ws + WS_XB0); float* RSTD0 = (float*)(ws + WS_MISC + MS_RSTD0);
    constexpr int I_WIN = 16 * 34, I_WQ = 4 * 96, I_WKV = 4 * 128, I_SQ = 32 * 32, I_WG = 4 * 64;
    constexpr int NITEMS = I_WIN + I_WQ + I_WKV + 2 * I_SQ + I_WG;
    const int lane = X.lane;
#pragma clang loop unroll(disable)
    for (int it = X.gw; it < NITEMS; it += X.NGW) {
        int r = it;
        if (r < I_WIN) { const int kb = r / 34, nb = r % 34; TrJob j{p->in[3], (unsigned char*)WinT, 1088, 2048, 128 * kb, 32 * nb, 32 * nb, QS_WIN, p->in[2]}; f32x4 v[16]; tr_load(j, v, lane); tr_store(j, v, lane); continue; } r -= I_WIN;
        if (r < I_WQ) { const int kb = r / 96, nb = r % 96; TrJob j{p->in[6], (unsigned char*)WqT, 3072, 512, 128 * kb, 32 * nb, 32 * nb, QS_WQK, p->in[4]}; f32x4 v[16]; tr_load(j, v, lane); tr_store(j, v, lane); continue; } r -= I_WQ;
        if (r < I_WKV) { const int kb = r / 128, nb = r % 128; TrJob j{p->in[7], (unsigned char*)WkvT, 4096, 512, 128 * kb, 32 * nb, 32 * nb, QS_WQK, p->in[5]}; f32x4 v[16]; tr_load(j, v, lane); tr_store(j, v, lane); continue; } r -= I_WKV;
        if (r < I_SQ) { const int kb = r / 64, nb = r % 64; TrJob j{p->in[10], (unsigned char*)WoT, 2048, 2048, 128 * kb, 32 * nb, 32 * nb, QS_WIN, nullptr}; f32x4 v[16]; tr_load(j, v, lane); tr_store(j, v, lane); continue; } r -= I_SQ;
        if (r < I_SQ) { const int kb = r / 32, nb = r % 32; tr_item(p->in[14], 2048, PwoT, 2048, 64 * kb, 64 * nb, 64 * nb, nullptr, lane); continue; } r -= I_SQ;
        if (r < I_WG) { const int g = r / 64, q = r % 64, kb = q / 8, nb = q % 8; tr_item(p->in[12] + (size_t)g * 512 * 512, 512, WgT, 512, 64 * kb, 64 * nb, g * 512 + 64 * nb, nullptr, lane); }
    }
    const int gt = X.vcu * (NWAVES * 64) + X.tid, NGT = X.G * NWAVES * 64;
    for (int i = gt; i < 2048 * 2048 / 8; i += NGT) { const f32x4 a = *(const f32x4*)(p->in[11] + (size_t)i * 8), b = *(const f32x4*)(p->in[11] + (size_t)i * 8 + 4);
        v4u o; o.x = pk2(a[0], a[1]); o.y = pk2(a[2], a[3]); o.z = pk2(b[0], b[1]); o.w = pk2(b[2], b[3]); *(v4u*)(PwinT + (size_t)i * 8) = o; }
    for (int i = gt; i < 192 * 128; i += NGT) *(v4u*)((unsigned char*)WinT + (size_t)1088 * 2048 + (size_t)i * 16) = (v4u){0u, 0u, 0u, 0u};
    for (int i = gt; i < 2 * 256 * 256; i += NGT) {
        const int l = i >> 16, n = (i >> 8) & 255, k0 = (i & 255) * 8; float v[8];
#pragma unroll
        for (int j = 0; j < 8; ++j) v[j] = (n < 8 ? p->in[16][((size_t)l * 2048 + k0 + j) * 8 + n] : (n < 72 ? p->in[18][((size_t)l * 2048 + k0 + j) * 64 + (n - 8)] : 0.f)) * p->in[15][l * 2048 + k0 + j];
        v4u o; o.x = pk2(v[0], v[1]); o.y = pk2(v[2], v[3]); o.z = pk2(v[4], v[5]); o.w = pk2(v[6], v[7]);
        *(v4u*)(RW + ((size_t)l * 256 + n) * 2048 + k0) = o;
    }
    { const int* pos = (const int*)p->in[1];
      for (int i = gt; i < T * 32; i += NGT) { const int t = i >> 5, j = i & 31;
          const float inv_freq = __builtin_amdgcn_exp2f(-(float)j * 0.41524101186092029f);
          const float ang = (float)pos[t] * inv_freq;
          double rev = (double)ang * 0.15915494309189535; rev -= rint(rev);
          const float xr = (float)rev;
          CS[(size_t)t * 64 + j] = __builtin_amdgcn_cosf(xr); CS[(size_t)t * 64 + 32 + j] = __builtin_amdgcn_sinf(xr); } }
#pragma clang loop unroll(disable)
    for (int m = X.gw; m < T; m += X.NGW) { const float* xr = p->in[0] + (size_t)m * DM; f32x4 v[8];
#pragma unroll
        for (int j = 0; j < 8; ++j) v[j] = *(const f32x4*)(xr + 4 * lane + 256 * j);
        const float rs = store_row_rstd(v, XB0 + (size_t)m * DM, lane);
        if (lane == 0) RSTD0[m] = rs;
        unsigned char* xq0 = (unsigned char*)(p->ws + WS_XB1) + (size_t)m * DM;
#pragma unroll
        for (int j = 0; j < 8; ++j) *(unsigned*)(xq0 + 4 * lane + 256 * j) = pg8::q8x4(v[j][0] * QS_X, v[j][1] * QS_X, v[j][2] * QS_X, v[j][3] * QS_X); }
}

__device__ __forceinline__ void phase_latent(const Ctx& X, KP p) {
    const bf16* C = (const bf16*)(p->ws + WS_C); bf16* CQ = (bf16*)(p->ws + WS_CQ); bf16* CKV = (bf16*)(p->ws + WS_CKV);
    const int lane = X.lane;
#pragma clang loop unroll(disable)
    for (int t = X.gw; t < T; t += X.NGW) {
        const v4u a = *(const v4u*)(C + (size_t)t * 1280 + 8 * lane), b = *(const v4u*)(C + (size_t)t * 1280 + 512 + 8 * lane);
        float xa[8] = {bf_lo(a.x), bf_hi(a.x), bf_lo(a.y), bf_hi(a.y), bf_lo(a.z), bf_hi(a.z), bf_lo(a.w), bf_hi(a.w)};
        float xb[8] = {bf_lo(b.x), bf_hi(b.x), bf_lo(b.y), bf_hi(b.y), bf_lo(b.z), bf_hi(b.z), bf_lo(b.w), bf_hi(b.w)};
        float sa = 0.f, sb = 0.f;
#pragma unroll
        for (int j = 0; j < 8; ++j) { sa += xa[j] * xa[j]; sb += xb[j] * xb[j]; }
        const float ra = 1.0f / sqrtf(wave_sum(sa) * (1.0f / 512.f) + EPS), rb = 1.0f / sqrtf(wave_sum(sb) * (1.0f / 512.f) + EPS);
        const f32x4 ga0 = *(const f32x4*)(p->in[4] + 8 * lane), ga1 = *(const f32x4*)(p->in[4] + 8 * lane + 4);
        const f32x4 gb0 = *(const f32x4*)(p->in[5] + 8 * lane), gb1 = *(const f32x4*)(p->in[5] + 8 * lane + 4);
        v4u oa, ob;
        oa.x = pk2(xa[0] * ra * ga0[0], xa[1] * ra * ga0[1]); oa.y = pk2(xa[2] * ra * ga0[2], xa[3] * ra * ga0[3]); oa.z = pk2(xa[4] * ra * ga1[0], xa[5] * ra * ga1[1]); oa.w = pk2(xa[6] * ra * ga1[2], xa[7] * ra * ga1[3]);
        ob.x = pk2(xb[0] * rb * gb0[0], xb[1] * rb * gb0[1]); ob.y = pk2(xb[2] * rb * gb0[2], xb[3] * rb * gb0[3]); ob.z = pk2(xb[4] * rb * gb1[0], xb[5] * rb * gb1[1]); ob.w = pk2(xb[6] * rb * gb1[2], xb[7] * rb * gb1[3]);
        *(v4u*)(CQ + (size_t)t * 512 + 8 * lane) = oa; *(v4u*)(CKV + (size_t)t * 512 + 8 * lane) = ob;
    }
}

__device__ __forceinline__ void phase_knorm(const Ctx& X, KP p) {
    bf16* KV = (bf16*)(p->ws + WS_KV); const bf16* C = (const bf16*)(p->ws + WS_C); const float* CS = (const float*)(p->ws + WS_CS); const float* gain = p->in[9];
    const int lane = X.lane, hd = lane >> 2, q = lane & 3;
    float gk[32], g1[8], g2[8];
#pragma unroll
    for (int i = 0; i < 32; ++i) gk[i] = gain[32 * q + i];
#pragma unroll
    for (int i = 0; i < 8; ++i) { g1[i] = gain[128 + 8 * q + i]; g2[i] = gain[160 + 8 * q + i]; }
#pragma clang loop unroll(disable)
    for (int t = X.gw; t < T; t += X.NGW) {
        bf16* kp = KV + (size_t)t * 5120 + hd * 320 + 32 * q;
        float kx[32], r1[8], r2[8];
#pragma unroll
        for (int i = 0; i < 4; ++i) { float v[8]; ld8(kp + 8 * i, v);
#pragma unroll
            for (int e = 0; e < 8; ++e) kx[8 * i + e] = v[e]; }
        ld8(C + (size_t)t * 1280 + 1024 + 8 * q, r1); ld8(C + (size_t)t * 1280 + 1056 + 8 * q, r2);
        float ss = 0.f;
#pragma unroll
        for (int i = 0; i < 32; ++i) ss += kx[i] * kx[i];
#pragma unroll
        for (int i = 0; i < 8; ++i) ss += r1[i] * r1[i] + r2[i] * r2[i];
        ss += __int_as_float(__builtin_amdgcn_ds_swizzle(__float_as_int(ss), SWZ_XOR(1))); ss += __int_as_float(__builtin_amdgcn_ds_swizzle(__float_as_int(ss), SWZ_XOR(2)));
        const float rstd = 1.0f / sqrtf(ss * (1.0f / 192.f) + EPS);
#pragma unroll
        for (int i = 0; i < 4; ++i) { v4u w;
            w.x = pk2(kx[8 * i] * rstd * gk[8 * i], kx[8 * i + 1] * rstd * gk[8 * i + 1]); w.y = pk2(kx[8 * i + 2] * rstd * gk[8 * i + 2], kx[8 * i + 3] * rstd * gk[8 * i + 3]);
            w.z = pk2(kx[8 * i + 4] * rstd * gk[8 * i + 4], kx[8 * i + 5] * rstd * gk[8 * i + 5]); w.w = pk2(kx[8 * i + 6] * rstd * gk[8 * i + 6], kx[8 * i + 7] * rstd * gk[8 * i + 7]);
            *(v4u*)(kp + 8 * i) = w; }
        const float* cs = CS + (size_t)t * 64 + 8 * q;
        const f32x4 c0 = *(const f32x4*)cs, c1 = *(const f32x4*)(cs + 4), s0 = *(const f32x4*)(cs + 32), s1 = *(const f32x4*)(cs + 36);
        float o1[8], o2[8];
#pragma unroll
        for (int e = 0; e < 8; ++e) { const float n1 = r1[e] * rstd * g1[e], n2 = r2[e] * rstd * g2[e], cc = e < 4 ? c0[e & 3] : c1[e & 3], sn = e < 4 ? s0[e & 3] : s1[e & 3];
            o1[e] = n1 * cc - n2 * sn; o2[e] = n2 * cc + n1 * sn; }
        v4u w1, w2; w1.x = pk2(o1[0], o1[1]); w1.y = pk2(o1[2], o1[3]); w1.z = pk2(o1[4], o1[5]); w1.w = pk2(o1[6], o1[7]);
        w2.x = pk2(o2[0], o2[1]); w2.y = pk2(o2[2], o2[3]); w2.z = pk2(o2[4], o2[5]); w2.w = pk2(o2[6], o2[7]);
        bf16* rp = KV + (size_t)t * 5120 + hd * 320 + 128 + 8 * q;
        *(v4u*)rp = w1; *(v4u*)(rp + 32) = w2;
    }
}

__device__ __forceinline__ unsigned dpp_x1(unsigned v) { return (unsigned)__builtin_amdgcn_mov_dpp((int)v, 0xB1, 0xF, 0xF, true); }
__device__ __forceinline__ unsigned dpp_x2(unsigned v) { return (unsigned)__builtin_amdgcn_mov_dpp((int)v, 0x4E, 0xF, 0xF, true); }
__device__ __forceinline__ void quad_tr(unsigned (&a)[4], int lane) {
    const bool o1 = lane & 1, o2 = lane & 2;
    unsigned b[4];
#pragma unroll
    for (int m = 0; m < 2; ++m) { const unsigned r = dpp_x1(o1 ? a[2 * m] : a[2 * m + 1]); b[2 * m] = o1 ? r : a[2 * m]; b[2 * m + 1] = o1 ? a[2 * m + 1] : r; }
#pragma unroll
    for (int j = 0; j < 2; ++j) { const unsigned r = dpp_x2(o2 ? b[j] : b[2 + j]); a[j] = o2 ? r : b[j]; a[2 + j] = o2 ? b[2 + j] : r; }
}
__device__ __forceinline__ void pair_tr(v2u& a0, v2u& a1, int lane) {
    const bool o1 = lane & 1; v2u s = o1 ? a0 : a1, r; r.x = dpp_x1(s.x); r.y = dpp_x1(s.y);
    if (o1) a0 = r; else a1 = r;
}
template <bool FINAL>
__device__ __forceinline__ void phase_combine(const Ctx& X, KP p, const bf16* __restrict__ xin, bf16* __restrict__ xout, float* __restrict__ rstd, float* __restrict__ outf) {
    const unsigned char* Y = (const unsigned char*)(p->ws + WS_Y); const int* SLOT = (const int*)(p->ws + WS_MISC + MS_SLOT); const float* TOKW = (const float*)(p->ws + WS_MISC + MS_TOKW);
    const int lane = X.lane;
    const int xo = 256 * (lane & 1) + 8 * (lane >> 1), yo = 256 * (lane & 3) + 16 * (lane >> 2);
#pragma clang loop unroll(disable)
    for (int m = X.gw; m < T; m += X.NGW) {
        const int s0 = (int)__hip_atomic_load((const unsigned*)SLOT + 2 * m, RLX_AGENT), s1 = (int)__hip_atomic_load((const unsigned*)SLOT + 2 * m + 1, RLX_AGENT);
        const float w0 = __uint_as_float(__hip_atomic_load((const unsigned*)TOKW + 2 * m, RLX_AGENT)), w1 = __uint_as_float(__hip_atomic_load((const unsigned*)TOKW + 2 * m + 1, RLX_AGENT));
        const bf16* xr = xin + (size_t)m * DM; const unsigned char* y0 = Y + (size_t)s0 * DM, * y1 = Y + (size_t)s1 * DM; f32x4 v[8];
        const float u0 = w0 * (1.0f / QS_Y), u1 = w1 * (1.0f / QS_Y);
        v4u xw[4], ya[2], yb[2];
#pragma unroll
        for (int g = 0; g < 4; ++g) xw[g] = *(const v4u*)(xr + 512 * g + xo);
#pragma unroll
        for (int g = 0; g < 2; ++g) { ya[g] = *(const v4u*)(y0 + 1024 * g + yo); yb[g] = *(const v4u*)(y1 + 1024 * g + yo); }
#pragma unroll
        for (int g = 0; g < 2; ++g) { unsigned a[4] = {ya[g].x, ya[g].y, ya[g].z, ya[g].w}, b[4] = {yb[g].x, yb[g].y, yb[g].z, yb[g].w}; quad_tr(a, lane); quad_tr(b, lane);
#pragma unroll
            for (int k = 0; k < 4; ++k) { const int j = 4 * g + k; v2u lo, hi; lo.x = xw[j >> 1].x; lo.y = xw[j >> 1].y; hi.x = xw[j >> 1].z; hi.y = xw[j >> 1].w;
                if ((k & 1) == 0) { pair_tr(lo, hi, lane); xw[j >> 1].x = lo.x; xw[j >> 1].y = lo.y; xw[j >> 1].z = hi.x; xw[j >> 1].w = hi.y; }
                v2u xv; xv.x = (k & 1) ? xw[j >> 1].z : xw[j >> 1].x; xv.y = (k & 1) ? xw[j >> 1].w : xw[j >> 1].y;
                const int aa = (int)a[k], bb = (int)b[k];
                f32x4 q;
                q[0] = bf_lo(xv.x) + (u0 * (float)((aa << 24) >> 24) + u1 * (float)((bb << 24) >> 24)); q[1] = bf_hi(xv.x) + (u0 * (float)((aa << 16) >> 24) + u1 * (float)((bb << 16) >> 24));
                q[2] = bf_lo(xv.y) + (u0 * (float)((aa << 8) >> 24) + u1 * (float)((bb << 8) >> 24)); q[3] = bf_hi(xv.y) + (u0 * (float)(aa >> 24) + u1 * (float)(bb >> 24));
                v[j] = q; if (FINAL) *(f32x4*)(outf + (size_t)m * DM + 4 * lane + 256 * j) = q; } }
        if (!FINAL) { const float rs = store_row_rstd(v, xout + (size_t)m * DM, lane); if (lane == 0) rstd[m] = rs; }
    }
}

__device__ __forceinline__ void phase_pool(const Ctx& X, KP p) {
    const bf16* U = (const bf16*)(p->ws + WS_UU); bf16* PM = (bf16*)(p->ws + WS_Y2); const float* scl = p->in[13];
    const int gt = X.vcu * (NWAVES * 64) + X.tid, NGT = X.G * NWAVES * 64;
#pragma clang loop unroll(disable)
    for (int task = gt; task < (T / 32) * 256; task += NGT) {
        const int run = task >> 8, cc = task & 255, col = cc * 8, w = 2 << (col >> 9);
        const int t0 = run * 32, s0 = t0 & (SEQ - 1);
        const f32x4 sc0 = *(const f32x4*)(scl + col), sc1 = *(const f32x4*)(scl + col + 4);
        float sum[8];
#pragma unroll
        for (int e = 0; e < 8; ++e) sum[e] = 0.f;
        { v4u wu[16];
#pragma unroll
          for (int j = 0; j < 16; ++j) { const int i = s0 - 1 - j; const bool ok = (j < w) && (i >= 0); wu[j] = *(const v4u*)(U + (size_t)(ok ? t0 - s0 + i : t0) * DM + col); }
#pragma unroll
          for (int j = 0; j < 16; ++j) { const int i = s0 - 1 - j; const bool ok = (j < w) && (i >= 0);
              if (ok) { sum[0] += bf_lo(wu[j].x); sum[1] += bf_hi(wu[j].x); sum[2] += bf_lo(wu[j].y); sum[3] += bf_hi(wu[j].y); sum[4] += bf_lo(wu[j].z); sum[5] += bf_hi(wu[j].z); sum[6] += bf_lo(wu[j].w); sum[7] += bf_hi(wu[j].w); } } }
#pragma clang loop unroll(disable)
        for (int kb = 0; kb < 32; kb += 8) {
            v4u cur[8], old_[8];
#pragma unroll
            for (int j = 0; j < 8; ++j) { const int t = t0 + kb + j, s = s0 + kb + j; cur[j] = *(const v4u*)(U + (size_t)t * DM + col);
                old_[j] = *(const v4u*)(U + (size_t)(s >= w ? t - w : t) * DM + col); }
#pragma unroll
            for (int j = 0; j < 8; ++j) { const int t = t0 + kb + j, s = s0 + kb + j; float v[8], o[8];
                v[0] = bf_lo(cur[j].x); v[1] = bf_hi(cur[j].x); v[2] = bf_lo(cur[j].y); v[3] = bf_hi(cur[j].y); v[4] = bf_lo(cur[j].z); v[5] = bf_hi(cur[j].z); v[6] = bf_lo(cur[j].w); v[7] = bf_hi(cur[j].w);
                o[0] = bf_lo(old_[j].x); o[1] = bf_hi(old_[j].x); o[2] = bf_lo(old_[j].y); o[3] = bf_hi(old_[j].y); o[4] = bf_lo(old_[j].z); o[5] = bf_hi(old_[j].z); o[6] = bf_lo(old_[j].w); o[7] = bf_hi(old_[j].w);
#pragma unroll
                for (int e = 0; e < 8; ++e) sum[e] += v[e];
                if (s >= w) {
#pragma unroll
                    for (int e = 0; e < 8; ++e) sum[e] -= o[e]; }
                const float ic = 1.0f / (float)(s + 1 < w ? s + 1 : w);
                v4u r; r.x = pk2((sum[0] * ic - v[0]) * sc0[0], (sum[1] * ic - v[1]) * sc0[1]); r.y = pk2((sum[2] * ic - v[2]) * sc0[2], (sum[3] * ic - v[3]) * sc0[3]);
                r.z = pk2((sum[4] * ic - v[4]) * sc1[0], (sum[5] * ic - v[5]) * sc1[1]); r.w = pk2((sum[6] * ic - v[6]) * sc1[2], (sum[7] * ic - v[7]) * sc1[3]);
                *(v4u*)(PM + (size_t)t * DM + col) = r; } }
    }
}

__device__ __forceinline__ void phase_route(const Ctx& X, KP p, int layer) {
    const float* LOG = (const float*)(p->ws + WS_LOG); const float* LOG1 = (const float*)(p->ws + WS_LOG1); unsigned* TOKE = (unsigned*)(p->ws + WS_MISC + MS_TOKE); float* TOKW = (float*)(p->ws + WS_MISC + MS_TOKW);
    unsigned* BC = (unsigned*)(p->ws + WS_MISC + MS_BC);
    const float* brg = p->in[17] + layer * 8; const float* bre = p->in[19] + layer * 64;
    const float* SSQP = (const float*)(p->ws + WS_SSQP); float* RSTOK = (float*)(p->ws + WS_MISC + MS_RSTOK);
    LAS unsigned* hist = (LAS unsigned*)X.lds;
    { int* STOK = (int*)(p->ws + WS_MISC + MS_STOK); for (int i = X.vcu * (NWAVES * 64) + X.tid; i < PSLOTS; i += X.G * NWAVES * 64) STOK[i] = 0; }
#pragma clang loop unroll(disable)
    for (int ch = X.vcu; ch < 256; ch += X.G) {
        if (X.tid < 64) hist[X.tid] = 0u;
        __syncthreads();
        if (X.tid < 128) {
            const int t = ch * 128 + X.tid; const float* lg = LOG + (size_t)t * 72; const float* lh = LOG1 + (size_t)t * 72;
            float ssq = 0.f;
#pragma unroll
            for (int j = 0; j < 8; ++j) { const f32x4 q = *(const f32x4*)(SSQP + (size_t)t * 32 + 4 * j); ssq += (q[0] + q[1]) + (q[2] + q[3]); }
            const float rstd = 1.0f / sqrtf(ssq * (1.0f / DM) + EPS);
            RSTOK[t] = rstd;
            float g[8]; int gs = 0; float gm;
#pragma unroll
            for (int j = 0; j < 8; ++j) g[j] = (lg[j] + lh[j]) * rstd + brg[j];
            gm = g[0];
#pragma unroll
            for (int j = 1; j < 8; ++j) if (g[j] > gm) { gm = g[j]; gs = j; }
            float den = 0.f;
#pragma unroll
            for (int j = 0; j < 8; ++j) den += expf(g[j] - gm);
            const float psel = 1.0f / den;
            float e[8];
#pragma unroll
            for (int j = 0; j < 8; ++j) e[j] = (lg[8 + gs * 8 + j] + lh[8 + gs * 8 + j]) * rstd + bre[gs * 8 + j];
            int i1 = 0; float m1 = e[0];
#pragma unroll
            for (int j = 1; j < 8; ++j) if (e[j] > m1) { m1 = e[j]; i1 = j; }
            int i2 = -1; float m2 = -3.0e38f;
#pragma unroll
            for (int j = 0; j < 8; ++j) if (j != i1 && e[j] > m2) { m2 = e[j]; i2 = j; }
            const float a2 = expf(m2 - m1), q1 = 1.0f / (1.0f + a2), q2 = a2 / (1.0f + a2);
            const unsigned e1 = (unsigned)(gs * 8 + i1), e2 = (unsigned)(gs * 8 + i2);
            const unsigned r1 = __hip_atomic_fetch_add(&hist[e1], 1u, __ATOMIC_RELAXED, __HIP_MEMORY_SCOPE_WORKGROUP), r2 = __hip_atomic_fetch_add(&hist[e2], 1u, __ATOMIC_RELAXED, __HIP_MEMORY_SCOPE_WORKGROUP);
            TOKE[t] = e1 | (e2 << 8) | (r1 << 16) | (r2 << 24);
            TOKW[2 * t] = psel * q1; TOKW[2 * t + 1] = psel * q2;
        }
        __syncthreads();
        if (X.tid < 64) BC[ch * 64 + X.tid] = hist[X.tid];
        __syncthreads();
    }
}
__device__ __forceinline__ void phase_slots(const Ctx& X, KP p) {
    const unsigned* TOKE = (const unsigned*)(p->ws + WS_MISC + MS_TOKE); int* SLOT = (int*)(p->ws + WS_MISC + MS_SLOT);
    const unsigned* BC = (const unsigned*)(p->ws + WS_MISC + MS_BC); int* TILE = (int*)(p->ws + WS_MISC + MS_TILE);
    const bf16* HN = (const bf16*)(p->ws + WS_XB1); bf16* XS = (bf16*)(p->ws + WS_XS);
    const float* RSTOK = (const float*)(p->ws + WS_MISC + MS_RSTOK); float* RSSLOT = (float*)(p->ws + WS_MISC + MS_RSSLOT); int* STOK = (int*)(p->ws + WS_MISC + MS_STOK);
    LAS unsigned* part = (LAS unsigned*)X.lds;
    LAS unsigned* pstart = part + 512;
    LAS unsigned* cbase = pstart + 64;
    LAS int* slots = (LAS int*)(cbase + 64);
    { const int e = X.tid & 63, g = X.tid >> 6; unsigned s = 0u;
#pragma unroll
      for (int i = 0; i < 32; ++i) s += BC[(32 * g + i) * 64 + e];
      part[g * 64 + e] = s; }
    __syncthreads();
    if (X.tid < 64) { const int e = X.tid; unsigned tot = 0u;
#pragma unroll
        for (int g = 0; g < 8; ++g) tot += part[g * 64 + e];
        const unsigned ntile = (tot + 255u) >> 8;
        cbase[e] = ntile;
        __builtin_amdgcn_fence(__ATOMIC_RELEASE, "workgroup"); __builtin_amdgcn_wave_barrier(); __builtin_amdgcn_fence(__ATOMIC_ACQUIRE, "workgroup");
        unsigned excl = 0u;
#pragma unroll
        for (int j = 0; j < 64; ++j) { const unsigned v = cbase[j]; excl += (j < e) ? v : 0u; }
        pstart[e] = excl << 8;
        { LAS int* LT = (LAS int*)(X.lds + LDS_TILE_OFF); for (unsigned k = 0; k < ntile; ++k) if (excl + k < 320u) LT[64 + excl + k] = e; if (e == 63) LT[0] = (int)(excl + ntile); }
        if (blockIdx.x == 0) { for (unsigned k = 0; k < ntile; ++k) TILE[64 + excl + k] = e; if (e == 63) TILE[0] = (int)(excl + ntile); } }
    __syncthreads();
#pragma clang loop unroll(disable)
    for (int ch = X.vcu; ch < 256; ch += X.G) {
        if (X.tid < 64) { const int e = X.tid, g = ch >> 5; unsigned s = 0u;
            for (int gg = 0; gg < g; ++gg) s += part[gg * 64 + e];
#pragma unroll
            for (int i = 0; i < 31; ++i) { const int c = 32 * g + i; const unsigned v = BC[(c < ch ? c : 32 * g) * 64 + e]; s += (c < ch) ? v : 0u; }
            cbase[e] = s; }
        __syncthreads();
        if (X.tid < 128) { const int t = ch * 128 + X.tid; const unsigned te = TOKE[t];
            const unsigned e1 = te & 255u, e2 = (te >> 8) & 255u, r1 = (te >> 16) & 255u, r2 = te >> 24;
            const int s1 = (int)(pstart[e1] + cbase[e1] + r1), s2 = (int)(pstart[e2] + cbase[e2] + r2);
            SLOT[2 * t] = s1; SLOT[2 * t + 1] = s2; slots[2 * X.tid] = s1; slots[2 * X.tid + 1] = s2;
            const float rs = RSTOK[t]; RSSLOT[s1] = rs; RSSLOT[s2] = rs; STOK[s1] = t; STOK[s2] = t; }
        __syncthreads();
        __syncthreads();
    }
}

struct MoeOrder {
    LAS const int* tile; int ntile, nN, G, c; size_t bstride;
    __device__ void init(LAS const int* tile_, int nN_, int G_, int c_, size_t bstride_) { tile = tile_; nN = nN_; G = G_; c = c_; bstride = bstride_;
        ntile = tile_[0]; ntile = ntile < 320 ? ntile : 320; }
    __device__ bool next(int i, pg8::Unit& u) const {
        const long L = (long)i * G + c; if (L >= (long)ntile * nN) return false;
        u.pm = (int)(L / nN); u.pn = (int)(L % nN); u.aux = tile[64 + u.pm] & 63; return true;
    }
    __device__ __forceinline__ const char* abase(const pg8::Gemm& g, const pg8::Unit& u) const { return (const char*)g.A + (size_t)u.pm * 256 * g.lda * 2; }
    __device__ __forceinline__ const char* bbase(const pg8::Gemm& g, const pg8::Unit& u) const { return (const char*)g.Bt + (size_t)u.aux * bstride + (size_t)u.pn * 256 * g.K * 2; }
};
struct RouterOrder {
    int G, c;
    __device__ bool next(int i, pg8::Unit& u) const { const int L = i * G + c; if (L >= 256) return false; u.pm = L >> 1; u.pn = 0; u.aux = L & 1; return true; }
    __device__ __forceinline__ const char* abase(const pg8::Gemm& g, const pg8::Unit& u) const { return (const char*)g.A + (size_t)u.pm * 256 * g.lda * 2 + (size_t)u.aux * g.K * 2; }
    __device__ __forceinline__ const char* bbase(const pg8::Gemm& g, const pg8::Unit& u) const { return (const char*)g.Bt + (size_t)u.aux * g.K * 2; }
};
struct ProdOrder {
    int bx, G;
    __device__ bool next(int i, pg8::Unit& u) const { const int c = (bx + G - (128 % G)) % G, L = i * G + c; if (L >= 64) return false; u.pm = L >> 3; u.pn = L & 7; u.aux = 0; return true; }
    __device__ __forceinline__ const char* abase(const pg8::Gemm& g, const pg8::Unit& u) const { return (const char*)g.A + (size_t)u.pm * 256 * g.lda * 2; }
    __device__ __forceinline__ const char* bbase(const pg8::Gemm& g, const pg8::Unit& u) const { return (const char*)g.Bt + (size_t)u.pn * 256 * g.ldb * 2 + (size_t)(u.pm >> 1) * 512 * 2; }
};
struct Col4Order {
    int bx, G;
    __device__ bool next(int i, pg8::Unit& u) const { const int L = i * G + bx; if (L >= 128) return false; u.pm = L; u.pn = 4; u.aux = 0; return true; }
    __device__ __forceinline__ const char* abase(const pg8::Gemm& g, const pg8::Unit& u) const { return (const char*)g.A + (size_t)u.pm * 256 * g.lda * 2; }
    __device__ __forceinline__ const char* bbase(const pg8::Gemm& g, const pg8::Unit& u) const { return (const char*)g.Bt + (size_t)u.pn * 256 * g.ldb * 2; }
};
struct GroupOrder {
    pg8::StaticOrder so;
    __device__ bool next(int i, pg8::Unit& u) const { return so.next(i, u); }
    __device__ __forceinline__ const char* abase(const pg8::Gemm& g, const pg8::Unit& u) const { return (const char*)g.A + (size_t)u.pm * 256 * g.lda * 2 + (size_t)(u.pn >> 1) * 512 * 2; }
    __device__ __forceinline__ const char* bbase(const pg8::Gemm& g, const pg8::Unit& u) const { return (const char*)g.Bt + (size_t)u.pn * 256 * g.K * 2; }
};

constexpr int RING_BYTES = 131072, MISC_OFF = RING_BYTES, LDS_BYTES = 147456;
__global__ void __launch_bounds__(NWAVES * 64, 2) mk_fwd(Params p_unused) {
    extern __shared__ __attribute__((aligned(16))) unsigned char lds_raw[];
    LAS unsigned char* const lds0 = (LAS unsigned char*)lds_raw;
    volatile LAS unsigned* MISC = (volatile LAS unsigned*)(lds0 + MISC_OFF);
    for (int u = threadIdx.x; u < (LDS_BYTES - MISC_OFF) / 4; u += NWAVES * 64) ((LAS unsigned*)(lds0 + MISC_OFF))[u] = 0u;
    __syncthreads();
    XcdBarrier bar; int lo, hi;
    { KP k = kargs(); lo = k->ph_lo; hi = k->ph_hi; unsigned* bw = (unsigned*)(k->ws + WS_CTL) + CW_BAR;
      bar.bar = bw; bar.x = 0; bar.st = nullptr;
      if (!MK_MULTI) bar = xcd_barrier_post(bw, MISC + 8); }
#define IN(k_) (lo <= (k_) && (k_) < hi)
#define SEAM(k_) do { if (IN(k_) && IN((k_) + 1)) xcd_barrier(bar); } while (0)
#define PH_BEGIN KP k = kargs(); const Ctx X = make_ctx(lds0); unsigned char* ws = k->ws; const int G = X.G, bx = X.bx, vcu = X.vcu; (void)ws; (void)G; (void)bx; (void)vcu;
#ifdef PROBE_ATT
#define PROBE_ATT_BODY xcd_barrier(bar); if (bx == 0 && threadIdx.x < 8) __hip_atomic_store(ctl + CW_ATTQ + 64 * threadIdx.x, 0u, __ATOMIC_RELAXED, __HIP_MEMORY_SCOPE_AGENT); xcd_barrier(bar); \
    att::attn_phase(X.lds, (const bf16*)(ws + WS_Q), (const bf16*)(ws + WS_KV), (bf16*)(ws + WS_O), k->in[8], (const float*)(ws + WS_CS), ctl + CW_ATTQ, (int)(xb_xcc_id() & 7u));
#else
#define PROBE_ATT_BODY
#endif
#ifndef PROBE_REP
#define PROBE_REP 0u
#endif
#define PHASE(k_, ...) do { if (IN(k_)) { { PH_BEGIN __VA_ARGS__ } if ((PROBE_REP >> (k_)) & 1u) { xcd_barrier(bar); { PH_BEGIN __VA_ARGS__ } } } } while (0)

    PHASE(0, phase_prologue(X, k);); SEAM(0);
    PHASE(1, pg8::Gemm g{(const bf16*)(ws + WS_XB1), (const bf16*)(ws + WS_WIN), 1024, 1024, 1024, nullptr}; pg8::StaticOrder S; S.init(T, 1024, G, bx);
        typedef pg8::EpiBf16<pg8::i32x4, false, true, false, true, true, true, 4> EC; EC E{(bf16*)(ws + WS_C), 1280, 256, 128, nullptr, (const float*)(ws + WS_MISC + MS_RSTD0), nullptr, 0, 20, (float*)(ws + WS_SSQC), 1.0f / (QS_X * QS_WIN), (unsigned char*)(ws + WS_CQ8), 1280, QS_C, 4}; pg8::gemm_phase<EC, pg8::StaticOrder, false, true>(X.lds, g, S, E);
        { Col4Order S4; S4.bx = bx; S4.G = G;
          typedef pg8::EpiBf16<pg8::i32x4, false, true, false, true, false, true, -1, true> EC4; EC4 E4{(bf16*)(ws + WS_C), 1280, 256, 128, nullptr, (const float*)(ws + WS_MISC + MS_RSTD0), nullptr, 0, 20, (float*)(ws + WS_SSQC), 1.0f / (QS_X * QS_WIN), nullptr, 0, 0.f, -1};
          pg8::gemm_phase<EC4, Col4Order, false, true>(X.lds, g, S4, E4); }
        { pg8::Gemm g2{(const bf16*)(ws + WS_WG), (const bf16*)(ws + WS_PWIN), 512, 512, 2048, nullptr}; ProdOrder S2; S2.bx = bx; S2.G = G;
          typedef pg8::EpiBf16<pg8::f32x4, true> EP; EP E2{(bf16*)(ws + WS_WPT), 2048, 256, 128, k->in[2] + 2048, nullptr, nullptr, 0, 0, nullptr, 1.f, nullptr, 0, 0.f, -1}; pg8::gemm_phase(X.lds, g2, S2, E2); }); SEAM(1);
    PHASE(2,
        { pg8::Gemm g{(const bf16*)(ws + WS_CQ8), (const bf16*)(ws + WS_WQ), 256, 640, 256, nullptr}; pg8::StaticOrder S; S.init(T, 3072, G, bx);
          typedef pg8::EpiBf16<pg8::i32x4, false, false, true, false, true, false> EQ; EQ E{(bf16*)(ws + WS_Q), 3072, 256, 128, nullptr, nullptr, (const float*)(ws + WS_SSQC), 0, 20, nullptr, 1.0f / (QS_C * QS_WQK), (unsigned char*)(ws + WS_Q), 3072, QS_Q, 9999}; pg8::gemm_phase<EQ, pg8::StaticOrder, false, true>(X.lds, g, S, E); }
        { if (threadIdx.x < 48) ((LAS f32x4*)(X.lds + pg8::STAGE_BYTES + 4096 + 6144))[threadIdx.x] = *(const f32x4*)(k->in[9] + 4 * threadIdx.x);
          __syncthreads();
          pg8::Gemm g{(const bf16*)(ws + WS_CQ8) + 256, (const bf16*)(ws + WS_WKV), 256, 640, 256, nullptr}; pg8::StaticOrder S; S.init(T, 4096, G, bx);
          pg8::EpiKV<pg8::i32x4> E{(bf16*)(ws + WS_KV), (const float*)(ws + WS_SSQC), (const bf16*)(ws + WS_C), (const float*)(ws + WS_CS), k->in[9], X.lds + pg8::STAGE_BYTES + 4096, 0, 1.0f / (QS_C * QS_WQK)}; pg8::gemm_phase<pg8::EpiKV<pg8::i32x4>, pg8::StaticOrder, false, true>(X.lds, g, S, E); }); SEAM(2);
    PHASE(3, unsigned* ctl = (unsigned*)(ws + WS_CTL);
        if ((vcu & 31) >= 32 - NCONV) moe_convert_drain(k, ctl + CW_CONVQ, X.lane);
        att::attn_phase(X.lds, (const bf16*)(ws + WS_Q), (const bf16*)(ws + WS_KV), (bf16*)(ws + WS_O), k->in[8], (const float*)(ws + WS_CS), ctl + CW_ATTQ, (int)(xb_xcc_id() & 7u));
        { int ln = threadIdx.x; asm volatile("" : "+v"(ln)); moe_convert_drain(k, ctl + CW_CONVQ, ln & 63); }
        PROBE_ATT_BODY); SEAM(3);
    PHASE(4, pg8::Gemm g{(const bf16*)(ws + WS_O), (const bf16*)(ws + WS_WO), 1024, 1024, 1024, nullptr}; pg8::StaticOrder S; S.init(T, 2048, G, bx);
        pg8::EpiResBf16<pg8::i32x4> E{(const bf16*)(ws + WS_XB0), (bf16*)(ws + WS_XB1), 2048, (float*)(ws + WS_SSQP), k->in[15], (unsigned char*)(ws + WS_XQ), QS_A, 1.0f / QS_WIN}; pg8::gemm_phase<pg8::EpiResBf16<pg8::i32x4>, pg8::StaticOrder, false, true>(X.lds, g, S, E);); SEAM(4);
#define MOE_BLOCK(mb, layer) \
    PHASE(mb, pg8::Gemm g{(const bf16*)(ws + WS_XB1), (const bf16*)(ws + WS_RW) + (size_t)(layer) * 256 * 2048, 1024, 2048, 2048, nullptr}; RouterOrder S; S.G = G; S.c = vcu; \
        pg8::EpiLogits E{(float*)(ws + WS_LOG), 72, 72, (size_t)(WS_LOG1 - WS_LOG) / 4}; pg8::gemm_phase(X.lds, g, S, E);); SEAM(mb); \
    PHASE(mb + 1, phase_route(X, k, layer);); SEAM(mb + 1); \
    PHASE(mb + 2, phase_slots(X, k);); SEAM(mb + 2); \
    PHASE(mb + 3, pg8::Gemm g{(const bf16*)(ws + WS_XQ), (const bf16*)(ws + WS_GUT) + (size_t)(layer) * 64 * 1024 * 1024, 1024, 1024, 1024, (const int*)(ws + WS_MISC + MS_STOK)}; \
        MoeOrder S; S.init((LAS const int*)(X.lds + LDS_TILE_OFF), 4, G, vcu, (size_t)1024 * 2048); \
        pg8::EpiSwiGLU8 E{(unsigned char*)(ws + WS_H), 512, (const float*)(ws + WS_MISC + MS_RSSLOT), 1.0f / (QS_A * QS_WGU), QS_H}; pg8::gemm_phase<pg8::EpiSwiGLU8, MoeOrder, true, true>(X.lds, g, S, E);); SEAM(mb + 3); \
    PHASE(mb + 4, pg8::Gemm g{(const bf16*)(ws + WS_H), (const bf16*)(ws + WS_DT) + (size_t)(layer) * 64 * 2048 * 256, 256, 256, 256, nullptr}; \
        MoeOrder S; S.init((LAS const int*)(X.lds + LDS_TILE_OFF), 8, G, vcu, (size_t)2048 * 512); \
        pg8::EpiY8 E{(unsigned char*)(ws + WS_Y), 2048, QS_Y / (QS_H * QS_WD)}; pg8::gemm_phase<pg8::EpiY8, MoeOrder, false, true>(X.lds, g, S, E);); SEAM(mb + 4);
    MOE_BLOCK(5, 0)
    PHASE(10, phase_combine<false>(X, k, (const bf16*)(ws + WS_XB1), (bf16*)(ws + WS_XB0), (float*)(ws + WS_MISC + MS_RSTD2), nullptr);); SEAM(10);
    PHASE(11, pg8::Gemm g{(const bf16*)(ws + WS_XB0), (const bf16*)(ws + WS_WPT), 2048, 2048, 2048, nullptr}; pg8::StaticOrder S; S.init(T, 2048, G, bx);
        typedef pg8::EpiBf16<pg8::f32x4, false, true> EU; EU E{(bf16*)(ws + WS_UU), 2048, 256, 128, nullptr, (const float*)(ws + WS_MISC + MS_RSTD2), nullptr, 0, 0, nullptr, 1.f, nullptr, 0, 0.f, -1}; pg8::gemm_phase(X.lds, g, S, E);); SEAM(11);
    PHASE(12, phase_pool(X, k);); SEAM(12);
    PHASE(13, pg8::Gemm g{(const bf16*)(ws + WS_Y2), (const bf16*)(ws + WS_PWO), 2048, 2048, 2048, nullptr}; pg8::StaticOrder S; S.init(T, 2048, G, bx);
        pg8::EpiResBf16<> E{(const bf16*)(ws + WS_XB0), (bf16*)(ws + WS_XB1), 2048, (float*)(ws + WS_SSQP), k->in[15] + 2048, (unsigned char*)(ws + WS_XQ), QS_A, 0.f}; pg8::gemm_phase(X.lds, g, S, E);); SEAM(13);
    MOE_BLOCK(14, 1)
    PHASE(19, phase_combine<true>(X, k, (const bf16*)(ws + WS_XB1), nullptr, nullptr, k->out););
#undef MOE_BLOCK
#undef IN
#undef SEAM
#undef PH_BEGIN
#undef PHASE
}

extern "C" void kernel_launch(void* const* d_in, const int* in_sizes, int n_in, void* d_out, int out_size, void* d_ws, size_t ws_size, hipStream_t stream) {
    static int grid = 0;
    if (grid == 0) {
        if (n_in != 23 || out_size != T * DM || ws_size < WS_END) { fprintf(stderr, "kernel_launch: unexpected shapes (n_in %d out %d ws %zu); nothing launched\n", n_in, out_size, ws_size); grid = -1; return; }
        int dev = 0, cus = 0, per_cu = 0;
        if (hipGetDevice(&dev) != hipSuccess || hipDeviceGetAttribute(&cus, hipDeviceAttributeMultiprocessorCount, dev) != hipSuccess) { grid = -1; return; }
        if (hipFuncSetAttribute((const void*)mk_fwd, hipFuncAttributeMaxDynamicSharedMemorySize, LDS_BYTES) != hipSuccess) { fprintf(stderr, "kernel_launch: hipFuncSetAttribute failed\n"); grid = -1; return; }
        if (hipOccupancyMaxActiveBlocksPerMultiprocessor(&per_cu, (const void*)mk_fwd, NWAVES * 64, LDS_BYTES) != hipSuccess || per_cu < 1) { fprintf(stderr, "kernel_launch: occupancy query reports %d blocks per CU\n", per_cu); }
        (void)hipGetLastError();
        grid = cus;
    }
    if (grid < 0) return;
    if (hipMemsetAsync((char*)d_ws + WS_CTL, 0, CTL_ZERO_BYTES, stream) != hipSuccess) return;
    Params p{};
    for (int i = 0; i < 23; ++i) p.in[i] = (const float*)d_in[i];
    p.out = (float*)d_out; p.ws = (unsigned char*)d_ws;
#if MK_MULTI
    for (int k = 0; k < NPHASE; ++k) { p.ph_lo = k; p.ph_hi = k + 1; hipLaunchKernelGGL(mk_fwd, dim3(grid), dim3(NWAVES * 64), LDS_BYTES, stream, p); }
#else
    p.ph_lo = 0; p.ph_hi = NPHASE;
    hipLaunchKernelGGL(mk_fwd, dim3(grid), dim3(NWAVES * 64), LDS_BYTES, stream, p);
#endif
}
```

```cpp
#include <hip/hip_runtime.h>
#include <cstdio>
#include <cstdint>

namespace pg8 {
#define PG8_LAS __attribute__((address_space(3)))
typedef unsigned short bf16_t;
typedef short bf16x8 __attribute__((ext_vector_type(8)));
typedef float f32x4 __attribute__((ext_vector_type(4)));
typedef unsigned u32x4 __attribute__((ext_vector_type(4)));
typedef int i32x4 __attribute__((ext_vector_type(4)));
template <bool I8> struct AccT { typedef f32x4 type; };
template <> struct AccT<true> { typedef i32x4 type; };
constexpr int BM = 256, BK = 64, HALF = 128, HTB = HALF * BK * 2  , STAGE_BYTES = 8 * HTB, NXCD = 8, WGM = 8;

__host__ __device__ __forceinline__ int lds_byte(int r, int c) { const int st = (r >> 4) * 2 + (c >> 5), rr = r & 15, cc = c & 31, ob = rr * 64 + cc * 2; return st * 1024 + (ob ^ (((ob >> 9) & 1) << 5)); }
__host__ __device__ __forceinline__ void stage_rc(int b, int& R, int& C) { const int st = b / 1024, sb = b % 1024, swz = sb ^ (((sb >> 9) & 1) << 5); R = (st >> 1) * 16 + swz / 64; C = (st & 1) * 32 + (swz % 64) / 2; }
__host__ __device__ __forceinline__ int perm32(int rho) { const int n = rho >> 4, i = rho & 15; return 8 * (i >> 2) + 4 * n + (i & 3); }

struct Unit { int pm, pn, aux; };
struct Gemm { const bf16_t* A; const bf16_t* Bt; int K; int lda; int ldb; const int* rowtab; };

struct StaticOrder {
    int nM, nN, nwg, G, c;
    __device__ void init(int M, int N, int G_, int c_) { nM = M / BM; nN = N / BM; nwg = nM * nN; G = G_; c = c_; }
    __device__ bool next(int i, Unit& u) const {
        const long L = (long)i * G + c; if (L >= nwg) return false;
        int wgid = (int)L; { const int q = nwg / NXCD, r = nwg % NXCD, xcd = wgid % NXCD, off = wgid / NXCD; wgid = (xcd < r ? xcd * (q + 1) : r * (q + 1) + (xcd - r) * q) + off; }
        const int nig = WGM * nN, gid = wgid / nig, fm = gid * WGM, gsz = (nM - fm) < WGM ? (nM - fm) : WGM;
        u.pm = fm + ((wgid % nig) % gsz); u.pn = (wgid % nig) / gsz; u.aux = 0; return true;
    }
    __device__ __forceinline__ const char* abase(const Gemm& g, const Unit& u) const { return (const char*)g.A + (size_t)u.pm * BM * g.lda * 2; }
    __device__ __forceinline__ const char* bbase(const Gemm& g, const Unit& u) const { return (const char*)g.Bt + (size_t)u.pn * BM * g.ldb * 2; }
};

__device__ __forceinline__ unsigned cvt_pk_bf16(float lo, float hi) { unsigned r; asm volatile("v_cvt_pk_bf16_f32 %0, %1, %2" : "=v"(r) : "v"(lo), "v"(hi)); return r; }

__device__ __forceinline__ float lo16(unsigned w) { return __uint_as_float(w << 16); }
__device__ __forceinline__ float hi16(unsigned w) { return __uint_as_float(w & 0xffff0000u); }
__device__ __forceinline__ unsigned q8x4(float a, float b, float c, float d) {
    unsigned w = __builtin_amdgcn_cvt_pk_u8_f32((a + 128.f), 0, 0u); w = __builtin_amdgcn_cvt_pk_u8_f32((b + 128.f), 1, w);
    w = __builtin_amdgcn_cvt_pk_u8_f32((c + 128.f), 2, w); w = __builtin_amdgcn_cvt_pk_u8_f32((d + 128.f), 3, w); return w ^ 0x80808080u; }
template <class A> __device__ __forceinline__ A pin(const A& v) { A t = v; asm volatile("" : "+v"(t) :: "memory"); return t; }
typedef unsigned u32x2v __attribute__((ext_vector_type(2)));
__device__ __forceinline__ void store16_pair(unsigned char* pa, unsigned char* pb, u32x2v xa, u32x2v xb, int fq) {
    auto r0 = __builtin_amdgcn_permlane16_swap(xa.x, xb.x, false, false);
    auto r1 = __builtin_amdgcn_permlane16_swap(xa.y, xb.y, false, false);
    u32x4 w; w.x = r0[0]; w.y = r1[0]; w.z = r0[1]; w.w = r1[1];
    *(u32x4*)((fq & 1) ? pb - 8 : pa) = w;
}
template <class F> __device__ __forceinline__ void rows8(int fq, F f, float (&out)[8]) {
    const unsigned v0 = __float_as_uint(f(2 * fq)), v1 = __float_as_uint(f(2 * fq + 1));
    auto p0 = __builtin_amdgcn_permlane16_swap(v0, v0, false, false); auto p1 = __builtin_amdgcn_permlane16_swap(v1, v1, false, false);
    const unsigned w[4] = {p0[0], p1[0], p0[1], p1[1]};
#pragma unroll
    for (int k = 0; k < 4; ++k) { auto q = __builtin_amdgcn_permlane32_swap(w[k], w[k], false, false); out[k] = __uint_as_float(q[0]); out[4 + k] = __uint_as_float(q[1]); }
}
__device__ __forceinline__ f32x4 tof(const f32x4& v) { return v; }
__device__ __forceinline__ f32x4 tof(const i32x4& v) { return (f32x4){(float)v[0], (float)v[1], (float)v[2], (float)v[3]}; }
template <class ACC = f32x4, bool CS = false, bool RS = false, bool SSQI = false, bool SSQO = false, bool Q8 = false, bool BF = true, int BFPN = -1, bool NH = false>
struct EpiBf16 {   static constexpr bool NHALF = NH;       static constexpr int NSTORE = (Q8 ? 8 : 0) + ((BF && BFPN < 0) ? (NH ? 8 : 16) : 0) + (SSQO ? 2 : 0);
    static constexpr bool PERM = true;
    bf16_t* O; int ldc; int tile_cs; int bj_s; const float* cscale; const float* rscale; const float* ssq_in; int ssq_off; int ssq_ld; float* ssq_out; float dq; unsigned char* q8out; int q8ld; float q8scale; int bf_only_pn;
    __device__ __forceinline__ void operator()(const ACC (&acc)[2][2][4][2], const Unit& u, int wr, int wc, int fr, int fq) const {
        asm volatile("" : "+v"(fr), "+v"(fq));
        const int row0 = u.pm * BM + wr * 64 + fr;
        const int col0 = u.pn * tile_cs + wc * 32 + 8 * fq, lcol0 = u.pn * BM + wc * 32 + 8 * fq;
        f32x4 sv[2][2]; float ssv[8] = {0.f, 0.f, 0.f, 0.f, 0.f, 0.f, 0.f, 0.f}; float rs8[8] = {0.f, 0.f, 0.f, 0.f, 0.f, 0.f, 0.f, 0.f};
        if (RS || SSQI) rows8(fq, [&](int i) -> float { const size_t row = (size_t)(row0 + (i >> 2) * HALF + (i & 3) * 16); float r = RS ? rscale[row] : 1.f;
            if (SSQI) { const f32x4 a = *(const f32x4*)(ssq_in + row * ssq_ld + ssq_off), b = *(const f32x4*)(ssq_in + row * ssq_ld + ssq_off + 4);
                r = __builtin_amdgcn_rsqf(((a[0] + a[1]) + (a[2] + a[3]) + (b[0] + b[1]) + (b[2] + b[3])) * (1.0f / 512.f) + 1e-6f); }
            return r * dq; }, rs8);
#pragma unroll
        for (int bj = 0; bj < (NH ? 1 : 2); ++bj)
#pragma unroll
            for (int n = 0; n < 2; ++n) sv[bj][n] = CS ? *(const f32x4*)(cscale + lcol0 + bj * HALF + 4 * n) : (f32x4){1.f, 1.f, 1.f, 1.f};
#pragma unroll
        for (int ai = 0; ai < 2; ++ai)
#pragma unroll
            for (int m = 0; m < 4; ++m) { const int row = row0 + ai * HALF + m * 16; bf16_t* rowp = O + (size_t)row * ldc + col0;
                const float rs = (RS || SSQI) ? rs8[ai * 4 + m] : dq;
                float ss = 0.f; u32x2v xq8[2];
#pragma unroll
                for (int bj = 0; bj < (NH ? 1 : 2); ++bj) { const f32x4 v0 = tof(pin(acc[ai][bj][m][0])) * sv[bj][0] * rs, v1 = tof(pin(acc[ai][bj][m][1])) * sv[bj][1] * rs;
                    ss += (v0[0] * v0[0] + v0[1] * v0[1]) + (v0[2] * v0[2] + v0[3] * v0[3]) + (v1[0] * v1[0] + v1[1] * v1[1]) + (v1[2] * v1[2] + v1[3] * v1[3]);
                    if (BF && (BFPN < 0 || u.pn == BFPN)) { u32x4 w; w.x = cvt_pk_bf16(v0[0], v0[1]); w.y = cvt_pk_bf16(v0[2], v0[3]); w.z = cvt_pk_bf16(v1[0], v1[1]); w.w = cvt_pk_bf16(v1[2], v1[3]);
                        *(u32x4*)(rowp + bj * bj_s) = w; }
                    if (Q8) { xq8[bj].x = q8x4(v0[0] * q8scale, v0[1] * q8scale, v0[2] * q8scale, v0[3] * q8scale); xq8[bj].y = q8x4(v1[0] * q8scale, v1[1] * q8scale, v1[2] * q8scale, v1[3] * q8scale); } }
                if (Q8) { unsigned char* qp = q8out + (size_t)row * q8ld + col0; store16_pair(qp, qp + bj_s, xq8[0], xq8[1], fq); }
                if (SSQO) {
                    ss += __int_as_float(__builtin_amdgcn_ds_swizzle(__float_as_int(ss), (16 << 10) | 0x1F));
                    { auto rr = __builtin_amdgcn_permlane32_swap(__float_as_uint(ss), __float_as_uint(ss), false, false); ss = __uint_as_float(rr[0]) + __uint_as_float(rr[1]); }
                    ssv[ai * 4 + m] = ss; } }
        if (SSQO) {
#pragma unroll
            for (int j = 0; j < 2; ++j) { const float sv = (fq & 2) ? ((fq & 1) ? ssv[6 + j] : ssv[4 + j]) : ((fq & 1) ? ssv[2 + j] : ssv[j]);
                const int i = 2 * fq + j; ssq_out[(size_t)(row0 + (i >> 2) * HALF + (i & 3) * 16) * ssq_ld + u.pn * 4 + wc] = sv; } }
    }
};
template <class ACC = f32x4>
struct EpiKV {
    static constexpr bool PERM = true; static constexpr int NSTORE = 14;
    bf16_t* KV; const float* ssqc; const bf16_t* C; const float* CS; const float* gk; PG8_LAS unsigned char* xl; mutable int par; float dq;
    __device__ __forceinline__ void operator()(const ACC (&acc)[2][2][4][2], const Unit& u, int wr, int wc, int fr, int fq) const {
        asm volatile("" : "+v"(fr), "+v"(fq));
        PG8_LAS float* P = (PG8_LAS float*)xl;
        PG8_LAS float* RS = P + 1024;
        const int rl0 = wr * 64 + fr, col0 = wc * 32 + 8 * fq;
        const int tid = (wr * 4 + wc) * 64 + fq * 16 + fr;
        f32x4 sa = {0.f, 0.f, 0.f, 0.f}, sb = sa, sr = sa;
        if (wr == 0) { const float* sp = ssqc + ((size_t)u.pm * BM + tid) * 20; sa = *(const f32x4*)(sp + 8); sb = *(const f32x4*)(sp + 12); sr = *(const f32x4*)(sp + 16); }
        PG8_LAS const float* gl = (PG8_LAS const float*)(xl + 6144);
        const f32x4 g0 = *(PG8_LAS const f32x4*)(gl + col0), g1 = *(PG8_LAS const f32x4*)(gl + col0 + 4);
#pragma unroll
        for (int ai = 0; ai < 2; ++ai)
#pragma unroll
            for (int m = 0; m < 4; ++m) {
                const f32x4 k0 = tof(pin(acc[ai][0][m][0])), k1 = tof(pin(acc[ai][0][m][1]));
                float ss = (k0[0] * k0[0] + k0[1] * k0[1]) + (k0[2] * k0[2] + k0[3] * k0[3]) + (k1[0] * k1[0] + k1[1] * k1[1]) + (k1[2] * k1[2] + k1[3] * k1[3]);
                ss += __int_as_float(__builtin_amdgcn_ds_swizzle(__float_as_int(ss), (16 << 10) | 0x1F));
                { auto rr = __builtin_amdgcn_permlane32_swap(__float_as_uint(ss), __float_as_uint(ss), false, false); ss = __uint_as_float(rr[0]) + __uint_as_float(rr[1]); }
                if (fq == 0) P[(rl0 + ai * HALF + m * 16) * 4 + wc] = ss; }
        asm volatile("s_waitcnt lgkmcnt(0)" ::: "memory"); __builtin_amdgcn_s_barrier(); asm volatile("" ::: "memory");
        if (wr == 0) { const f32x4 pp = *(const PG8_LAS f32x4*)(P + tid * 4);
            const float rs = dq * __builtin_amdgcn_rsqf(((sa[0] + sa[1]) + (sa[2] + sa[3]) + (sb[0] + sb[1]) + (sb[2] + sb[3])) * (1.0f / 512.f) + 1e-6f);
            const float rkn = __builtin_amdgcn_rsqf((((pp[0] + pp[1]) + (pp[2] + pp[3])) * (rs * rs) + (sr[0] + sr[1]) + (sr[2] + sr[3])) * (1.0f / 192.f) + 1e-6f);
            typedef float f32x2v __attribute__((ext_vector_type(2))); *(PG8_LAS f32x2v*)(RS + 2 * tid) = (f32x2v){rs, rkn}; }
        asm volatile("s_waitcnt lgkmcnt(0)" ::: "memory"); __builtin_amdgcn_s_barrier(); asm volatile("" ::: "memory");
        unsigned char* tb = (unsigned char*)KV + (size_t)u.pm * BM * 8192 + u.pn * 512;
#pragma unroll
        for (int ai = 0; ai < 2; ++ai)
#pragma unroll
            for (int mp = 0; mp < 2; ++mp) { u32x2v wk[2];
#pragma unroll
                for (int mm = 0; mm < 2; ++mm) { const int m = 2 * mp + mm; const int rl = rl0 + ai * HALF + m * 16;
                    typedef float f32x2v __attribute__((ext_vector_type(2))); const f32x2v st = *(const PG8_LAS f32x2v*)(RS + 2 * rl);
                    const float rs = st[0], rk = st[0] * st[1];
                    bf16_t* rowp = (bf16_t*)(tb + (unsigned)rl * 8192u + 256) + col0;
                    const f32x4 k0 = tof(pin(acc[ai][0][m][0])) * rk * g0, k1 = tof(pin(acc[ai][0][m][1])) * rk * g1, v0 = tof(pin(acc[ai][1][m][0])) * rs, v1 = tof(pin(acc[ai][1][m][1])) * rs;
                    wk[mm].x = q8x4(k0[0] * 16.f, k0[1] * 16.f, k0[2] * 16.f, k0[3] * 16.f); wk[mm].y = q8x4(k1[0] * 16.f, k1[1] * 16.f, k1[2] * 16.f, k1[3] * 16.f);
                    u32x4 x; x.x = cvt_pk_bf16(v0[0], v0[1]); x.y = cvt_pk_bf16(v0[2], v0[3]); x.z = cvt_pk_bf16(v1[0], v1[1]); x.w = cvt_pk_bf16(v1[2], v1[3]); *(u32x4*)rowp = x; }
                unsigned char* ka = tb + (unsigned)(rl0 + ai * HALF + 2 * mp * 16) * 8192u + col0;
                store16_pair(ka, ka + 16 * 8192, wk[0], wk[1], fq);
                asm volatile("" ::: "memory"); }
        { const int rl = tid >> 1, j0 = 16 * (tid & 1); const size_t row = (size_t)u.pm * BM + rl;
          const float rk = RS[2 * rl + 1];
          const bf16_t* cr = C + row * 1280 + 1024 + j0; const float* cs = CS + row * 64 + j0; unsigned char* kp = tb + (unsigned)rl * 8192u + 128 + j0;
          u32x2v w1[2], w2[2];
#pragma unroll
          for (int q = 0; q < 2; ++q) { const u32x4 a = *(const u32x4*)(cr + 8 * q), b = *(const u32x4*)(cr + 32 + 8 * q);
              const f32x4 c0 = *(const f32x4*)(cs + 8 * q), c1 = *(const f32x4*)(cs + 8 * q + 4), s0 = *(const f32x4*)(cs + 32 + 8 * q), s1 = *(const f32x4*)(cs + 32 + 8 * q + 4);
              const f32x4 ga0 = *(PG8_LAS const f32x4*)(gl + 128 + j0 + 8 * q), ga1 = *(PG8_LAS const f32x4*)(gl + 128 + j0 + 8 * q + 4), gb0 = *(PG8_LAS const f32x4*)(gl + 160 + j0 + 8 * q), gb1 = *(PG8_LAS const f32x4*)(gl + 160 + j0 + 8 * q + 4);
              const f32x4 x10 = (f32x4){lo16(a.x), hi16(a.x), lo16(a.y), hi16(a.y)} * rk * ga0, x11 = (f32x4){lo16(a.z), hi16(a.z), lo16(a.w), hi16(a.w)} * rk * ga1;
              const f32x4 x20 = (f32x4){lo16(b.x), hi16(b.x), lo16(b.y), hi16(b.y)} * rk * gb0, x21 = (f32x4){lo16(b.z), hi16(b.z), lo16(b.w), hi16(b.w)} * rk * gb1;
              const f32x4 o10 = x10 * c0 - x20 * s0, o11 = x11 * c1 - x21 * s1, o20 = x20 * c0 + x10 * s0, o21 = x21 * c1 + x11 * s1;
              w1[q].x = q8x4(o10[0] * 16.f, o10[1] * 16.f, o10[2] * 16.f, o10[3] * 16.f); w1[q].y = q8x4(o11[0] * 16.f, o11[1] * 16.f, o11[2] * 16.f, o11[3] * 16.f);
              w2[q].x = q8x4(o20[0] * 16.f, o20[1] * 16.f, o20[2] * 16.f, o20[3] * 16.f); w2[q].y = q8x4(o21[0] * 16.f, o21[1] * 16.f, o21[2] * 16.f, o21[3] * 16.f); }
          { u32x4 w; w.x = w1[0].x; w.y = w1[0].y; w.z = w1[1].x; w.w = w1[1].y; *(u32x4*)kp = w; }
          { u32x4 w; w.x = w2[0].x; w.y = w2[0].y; w.z = w2[1].x; w.w = w2[1].y; *(u32x4*)(kp + 32) = w; } }
    }
};
struct EpiSwiGLU8 {   static constexpr int NSTORE = 4;
    static constexpr bool PERM = true;
    unsigned char* O; int ldc; const float* rscale; float dq; float hscale;
    __device__ __forceinline__ static float sg(float g, float u) { return g * u * __builtin_amdgcn_rcpf(1.f + __builtin_amdgcn_exp2f(-1.4426950408889634f * g)); }
    __device__ __forceinline__ void operator()(const i32x4 (&acc)[2][2][4][2], const Unit& u, int wr, int wc, int fr, int fq) const {
        asm volatile("" : "+v"(fr), "+v"(fq));
        const int row0 = u.pm * BM + wr * 64 + fr, col0 = u.pn * HALF + wc * 32 + 8 * fq;
        float rs8[8]; rows8(fq, [&](int i) -> float { return rscale[row0 + (i >> 2) * HALF + (i & 3) * 16] * dq; }, rs8);
#pragma unroll
        for (int ai = 0; ai < 2; ++ai)
#pragma unroll
            for (int mp = 0; mp < 2; ++mp) { u32x2v w[2];
#pragma unroll
                for (int mm = 0; mm < 2; ++mm) { const int m = 2 * mp + mm; const float rs = rs8[ai * 4 + m]; float h[8];
#pragma unroll
                    for (int n = 0; n < 2; ++n)
#pragma unroll
                        for (int e = 0; e < 4; ++e) h[4 * n + e] = sg((float)acc[ai][0][m][n][e] * rs, (float)acc[ai][1][m][n][e] * rs) * hscale;
                    w[mm].x = q8x4(h[0], h[1], h[2], h[3]); w[mm].y = q8x4(h[4], h[5], h[6], h[7]); }
                unsigned char* pa = O + (size_t)(row0 + ai * HALF + 2 * mp * 16) * ldc + col0;
                store16_pair(pa, pa + (size_t)16 * ldc, w[0], w[1], fq); }
    }
};
struct EpiY8 {   static constexpr int NSTORE = 8;
    static constexpr bool PERM = true;
    unsigned char* O; int ldc; float dq;
    __device__ __forceinline__ void operator()(const i32x4 (&acc)[2][2][4][2], const Unit& u, int wr, int wc, int fr, int fq) const {
        asm volatile("" : "+v"(fr), "+v"(fq));
        const int row0 = u.pm * BM + wr * 64 + fr, col0 = u.pn * BM + wc * 32 + 8 * fq;
#pragma unroll
        for (int ai = 0; ai < 2; ++ai)
#pragma unroll
            for (int m = 0; m < 4; ++m) { unsigned char* rowp = O + (size_t)(row0 + ai * HALF + m * 16) * ldc + col0;
                u32x2v w[2];
#pragma unroll
                for (int bj = 0; bj < 2; ++bj) { const i32x4 a0 = acc[ai][bj][m][0], a1 = acc[ai][bj][m][1];
                    w[bj].x = q8x4((float)a0[0] * dq, (float)a0[1] * dq, (float)a0[2] * dq, (float)a0[3] * dq); w[bj].y = q8x4((float)a1[0] * dq, (float)a1[1] * dq, (float)a1[2] * dq, (float)a1[3] * dq); }
                store16_pair(rowp, rowp + HALF, w[0], w[1], fq); }
    }
};
struct EpiSwiGLU {
    static constexpr bool PERM = true;
    bf16_t* O; int ldc; const float* rscale;
    __device__ __forceinline__ static float sg(float g, float u) { return g * u * __builtin_amdgcn_rcpf(1.f + __builtin_amdgcn_exp2f(-1.4426950408889634f * g)); }
    __device__ __forceinline__ void operator()(const f32x4 (&acc)[2][2][4][2], const Unit& u, int wr, int wc, int fr, int fq) const {
        asm volatile("" : "+v"(fr), "+v"(fq));
        const int row0 = u.pm * BM + wr * 64 + fr, col0 = u.pn * HALF + wc * 32 + 8 * fq;
#pragma unroll
        for (int ai = 0; ai < 2; ++ai)
#pragma unroll
            for (int m = 0; m < 4; ++m) { const int row = row0 + ai * HALF + m * 16; bf16_t* rowp = O + (size_t)row * ldc + col0; const float rs = rscale[row];
                const f32x4 g0 = acc[ai][0][m][0] * rs, g1 = acc[ai][0][m][1] * rs, u0 = acc[ai][1][m][0] * rs, u1 = acc[ai][1][m][1] * rs;
                u32x4 w; w.x = cvt_pk_bf16(sg(g0[0], u0[0]), sg(g0[1], u0[1])); w.y = cvt_pk_bf16(sg(g0[2], u0[2]), sg(g0[3], u0[3]));
                w.z = cvt_pk_bf16(sg(g1[0], u1[0]), sg(g1[1], u1[1])); w.w = cvt_pk_bf16(sg(g1[2], u1[2]), sg(g1[3], u1[3]));
                *(u32x4*)rowp = w; }
    }
};
constexpr float QS_O = 96.f;
__device__ __forceinline__ float o_row_scale(int row) { return QS_O * sqrtf((float)(((row & 4095) >> 6) + 1)); }
template <class ACC = f32x4>
struct EpiResBf16 {
    static constexpr bool PERM = true; static constexpr int NSTORE = 26;
    const bf16_t* base; bf16_t* out; int ldc; float* ssqp; const float* qgain; unsigned char* xq; float qscale; float dq;
    __device__ __forceinline__ void operator()(const ACC (&acc)[2][2][4][2], const Unit& u, int wr, int wc, int fr, int fq) const {
        asm volatile("" : "+v"(fr), "+v"(fq));
        const int row0 = u.pm * BM + wr * 64 + fr, col0 = u.pn * BM + wc * 32 + 8 * fq;
        f32x4 gv[2][2]; float ssv[8];
#pragma unroll
        for (int bj = 0; bj < 2; ++bj)
#pragma unroll
            for (int n = 0; n < 2; ++n) gv[bj][n] = *(const f32x4*)(qgain + col0 + bj * HALF + 4 * n) * qscale;
#pragma unroll
        for (int ai = 0; ai < 2; ++ai)
#pragma unroll
            for (int m = 0; m < 4; ++m) { const int row = row0 + ai * HALF + m * 16; const size_t off = (size_t)row * ldc + col0; float ss = 0.f; u32x2v xq8[2];
                const float as = dq > 0.f ? dq * (1.0f / QS_O) * __builtin_amdgcn_rsqf((float)(((row & 4095) >> 6) + 1)) : 1.f;
#pragma unroll
                for (int bj = 0; bj < 2; ++bj) { const u32x4 b = *(const u32x4*)(base + off + bj * HALF);
                    const f32x4 v0 = tof(acc[ai][bj][m][0]) * as + (f32x4){lo16(b.x), hi16(b.x), lo16(b.y), hi16(b.y)}, v1 = tof(acc[ai][bj][m][1]) * as + (f32x4){lo16(b.z), hi16(b.z), lo16(b.w), hi16(b.w)};
                    ss += (v0[0] * v0[0] + v0[1] * v0[1]) + (v0[2] * v0[2] + v0[3] * v0[3]) + (v1[0] * v1[0] + v1[1] * v1[1]) + (v1[2] * v1[2] + v1[3] * v1[3]);
                    u32x4 w; w.x = cvt_pk_bf16(v0[0], v0[1]); w.y = cvt_pk_bf16(v0[2], v0[3]); w.z = cvt_pk_bf16(v1[0], v1[1]); w.w = cvt_pk_bf16(v1[2], v1[3]);
                    *(u32x4*)(out + off + bj * HALF) = w;
                    const f32x4 q0 = v0 * gv[bj][0], q1 = v1 * gv[bj][1];
                    xq8[bj].x = q8x4(q0[0], q0[1], q0[2], q0[3]); xq8[bj].y = q8x4(q1[0], q1[1], q1[2], q1[3]); }
                store16_pair(xq + off, xq + off + HALF, xq8[0], xq8[1], fq);
                ss += __int_as_float(__builtin_amdgcn_ds_swizzle(__float_as_int(ss), (16 << 10) | 0x1F));
                { auto rr = __builtin_amdgcn_permlane32_swap(__float_as_uint(ss), __float_as_uint(ss), false, false); ss = __uint_as_float(rr[0]) + __uint_as_float(rr[1]); }
                ssv[ai * 4 + m] = ss;
                if (m == 3) asm volatile("" ::: "memory"); }
#pragma unroll
        for (int j = 0; j < 2; ++j) { const float sv = (fq & 2) ? ((fq & 1) ? ssv[6 + j] : ssv[4 + j]) : ((fq & 1) ? ssv[2 + j] : ssv[j]);
            const int i = 2 * fq + j; ssqp[(size_t)(row0 + (i >> 2) * HALF + (i & 3) * 16) * 32 + u.pn * 4 + wc] = sv; }
    }
};
struct EpiResF32 {
    static constexpr bool PERM = false;
    const float* base; float* out; int ldc;
    __device__ __forceinline__ void operator()(const f32x4 (&acc)[2][2][4][2], const Unit& u, int wr, int wc, int fr, int fq) const {
        asm volatile("" : "+v"(fr), "+v"(fq));
        const int col0 = u.pn * BM + wc * 32 + 4 * fq;
#pragma unroll
        for (int ai = 0; ai < 2; ++ai)
#pragma unroll
            for (int m = 0; m < 4; ++m) { const size_t off = (size_t)(u.pm * BM + ai * HALF + wr * 64 + m * 16 + fr) * ldc + col0;
#pragma unroll
                for (int bj = 0; bj < 2; ++bj)
#pragma unroll
                    for (int n = 0; n < 2; ++n) { const f32x4 bs = *(const f32x4*)(base + off + bj * HALF + n * 16); *(f32x4*)(out + off + bj * HALF + n * 16) = bs + acc[ai][bj][m][n]; } }
    }
};
struct EpiLogits {   static constexpr bool NHALF = true;
    static constexpr bool PERM = false;
    float* out; int ldc; int ncol; size_t bstride;
    __device__ __forceinline__ void operator()(const f32x4 (&acc)[2][2][4][2], const Unit& u, int wr, int wc, int fr, int fq) const {
        asm volatile("" : "+v"(fr), "+v"(fq));
        const int col0 = wc * 32 + 4 * fq;
        if (wc * 32 >= ncol) return;
#pragma unroll
        for (int ai = 0; ai < 2; ++ai)
#pragma unroll
            for (int m = 0; m < 4; ++m) { const size_t off = (size_t)u.aux * bstride + (size_t)(u.pm * BM + ai * HALF + wr * 64 + m * 16 + fr) * ldc;
#pragma unroll
                for (int n = 0; n < 2; ++n) { const int c = col0 + n * 16; if (c < ncol) *(f32x4*)(out + off + c) = acc[ai][0][m][n]; } }
    }
};

template <class E, class = void> struct EpiHalfN { static constexpr bool v = false; };
template <class E> struct EpiHalfN<E, decltype((void)E::NHALF)> { static constexpr bool v = E::NHALF; };
template <class E, class = void> struct EpiStores { static constexpr int v = 0; };
template <class E> struct EpiStores<E, decltype((void)E::NSTORE)> { static constexpr int v = E::NSTORE; };
template <class Epi, class Sched, bool GATHER = false, bool I8 = false>
__device__ __forceinline__ void gemm_phase(PG8_LAS unsigned char* lds, const Gemm g, const Sched& S, const Epi& E) {
    int tid = threadIdx.x; asm volatile("" : "+v"(tid));
    const int wid = __builtin_amdgcn_readfirstlane(tid >> 6), lane = tid & 63, wr = wid >> 2, wc = wid & 3, fr = lane & 15, fq = lane >> 4;
    const int K = g.K, nt = K / BK, lda = g.lda, ldb = g.ldb;
    unsigned voffA[2], voffB[2]; int gR[2], gC[2];
#pragma unroll
    for (int i = 0; i < 2; ++i) { int R, C; stage_rc(tid * 16 + i * 8192, R, C); const int Rb = Epi::PERM ? ((R & ~31) + perm32(R & 31)) : R; gR[i] = R; gC[i] = C;
        voffA[i] = (unsigned)(R * lda + C) * 2u; voffB[i] = (unsigned)(Rb * ldb + C) * 2u; }
    unsigned cao[2][2], xao[2][2];
    PG8_LAS unsigned* stash = (PG8_LAS unsigned*)(lds + STAGE_BYTES + 4096) + tid;
#define PG8_GOFF(u, ao) do { _Pragma("unroll") for (int h_ = 0; h_ < 2; ++h_) _Pragma("unroll") for (int i_ = 0; i_ < 2; ++i_) { \
        const unsigned row_ = __hip_atomic_load((const unsigned*)g.rowtab + (u).pm * BM + h_ * HALF + gR[i_], __ATOMIC_RELAXED, __HIP_MEMORY_SCOPE_AGENT); \
        ao[h_][i_] = row_ * (unsigned)(lda * 2) + (unsigned)(gC[i_] * 2); } } while (0)
#define PG8_STAGE_A(bufoff, ptr, h, nx, kt) do { if constexpr (GATHER) { _Pragma("unroll") for (int _i = 0; _i < 2; ++_i) { const unsigned o_ = (nx) ? xao[h][_i] : cao[h][_i]; \
        __builtin_amdgcn_global_load_lds((const unsigned*)((const char*)g.A + o_ + (size_t)(kt) * (BK * 2)), (PG8_LAS unsigned*)(lds + (bufoff) + ldsw + _i * 8192), 16, 0, 0); } } \
        else PG8_STAGE(bufoff, ptr, voffA); } while (0)
    const size_t kstep = (size_t)(BK * 2);
    const size_t hstepA = (size_t)HALF * lda * 2, hstepB = (size_t)HALF * ldb * 2;
    const unsigned ldsw = (unsigned)wid * 1024u;
    const int aoff = lds_byte(wr * 64 + fr, fq * 8), boff = lds_byte(wc * 32 + fr, fq * 8);
#define PG8_SA(b, h) (((b) * 2 + (h)) * HTB)
#define PG8_SB(b, h) ((4 + (b) * 2 + (h)) * HTB)
#define PG8_STAGE(bufoff, gbase, voff) do { _Pragma("unroll") for (int _i = 0; _i < 2; ++_i) \
        __builtin_amdgcn_global_load_lds((const unsigned*)((const char*)(gbase) + (voff)[_i]), (PG8_LAS unsigned*)(lds + (bufoff) + ldsw + _i * 8192), 16, 0, 0); } while (0)
#define PG8_LDA(dst, b, h) do { _Pragma("unroll") for (int m = 0; m < 4; ++m) _Pragma("unroll") for (int k = 0; k < 2; ++k) dst[m][k] = *(const PG8_LAS bf16x8*)(lds + PG8_SA(b, h) + aoff + m * 2048 + k * 1024); } while (0)
#define PG8_LDB(dst, b, h) do { _Pragma("unroll") for (int n = 0; n < 2; ++n) _Pragma("unroll") for (int k = 0; k < 2; ++k) dst[n][k] = *(const PG8_LAS bf16x8*)(lds + PG8_SB(b, h) + boff + n * 2048 + k * 1024); } while (0)
#define PG8_MMA(ai, bj, At, Bt) do { __builtin_amdgcn_s_setprio(1); _Pragma("unroll") for (int m = 0; m < 4; ++m) _Pragma("unroll") for (int n = 0; n < 2; ++n) _Pragma("unroll") for (int k = 0; k < 2; ++k) \
        { if constexpr (I8) acc[ai][bj][m][n] = __builtin_bit_cast(acc_t, __builtin_amdgcn_mfma_i32_16x16x64_i8(__builtin_bit_cast(i32x4, Bt[n][k]), __builtin_bit_cast(i32x4, At[m][k]), __builtin_bit_cast(i32x4, acc[ai][bj][m][n]), 0, 0, 0)); \
          else acc[ai][bj][m][n] = __builtin_bit_cast(acc_t, __builtin_amdgcn_mfma_f32_16x16x32_bf16(Bt[n][k], At[m][k], __builtin_bit_cast(f32x4, acc[ai][bj][m][n]), 0, 0, 0)); } __builtin_amdgcn_s_setprio(0); } while (0)
#define PG8_WAIT_V(n) asm volatile("s_waitcnt vmcnt(" #n ")" ::: "memory")
#define PG8_WAIT_L(n) asm volatile("s_waitcnt lgkmcnt(" #n ")" ::: "memory")
#define PG8_WAIT_VE asm volatile("s_waitcnt vmcnt(%0)" :: "n"(8 + EpiStores<Epi>::v) : "memory")
#define PG8_BAR __builtin_amdgcn_s_barrier()
#define PG8_SCHED __builtin_amdgcn_sched_barrier(0)
    Unit cur, nxt; int ui = 0;
    if (!S.next(0, cur)) return;
    typedef typename AccT<I8>::type acc_t;
    acc_t acc[2][2][4][2];
#pragma unroll
    for (int a = 0; a < 2; ++a)
#pragma unroll
        for (int b = 0; b < 2; ++b)
#pragma unroll
            for (int m = 0; m < 4; ++m)
#pragma unroll
                for (int n = 0; n < 2; ++n) acc[a][b][m][n] = __builtin_bit_cast(acc_t, (f32x4){0.f, 0.f, 0.f, 0.f});
    bf16x8 At[4][2], B0[2][2], B1[2][2];
    const char* cA = S.abase(g, cur); const char* cB = S.bbase(g, cur);
    if constexpr (GATHER) { PG8_GOFF(cur, cao); }
    PG8_STAGE(PG8_SB(0, 0), cB, voffB); PG8_STAGE(PG8_SB(0, 1), cB + hstepB, voffB); PG8_STAGE_A(PG8_SA(0, 0), cA, 0, false, 0); PG8_STAGE_A(PG8_SA(0, 1), cA + hstepA, 1, false, 0);
    if (wr == 1) PG8_BAR;
    PG8_WAIT_V(2); PG8_BAR;
    PG8_STAGE(PG8_SB(1, 0), cB + kstep, voffB); PG8_STAGE_A(PG8_SA(1, 0), cA + kstep, 0, false, 1); PG8_STAGE(PG8_SB(1, 1), cB + hstepB + kstep, voffB);
    if constexpr (GATHER || EpiStores<Epi>::v == 0) { PG8_WAIT_V(6); } else { PG8_WAIT_V(0); }
    PG8_BAR;
    for (;;) {
        const bool has_next = S.next(ui + 1, nxt);
        const char* nA = has_next ? S.abase(g, nxt) : cA; const char* nB = has_next ? S.bbase(g, nxt) : cB;
        if constexpr (GATHER) { if (has_next) __builtin_amdgcn_global_load_lds((const unsigned*)g.rowtab + nxt.pm * BM + lane * 4, (PG8_LAS unsigned*)(lds + STAGE_BYTES + 4096), 16, 0, 0); }
#define PG8_KPAIR(t, last, WAITA) do { \
            const char* a1 = cA + (size_t)((t) + 1) * kstep;                                             \
            const char* a2 = (last) ? nA : cA + (size_t)((t) + 2) * kstep; const char* b2 = (last) ? nB : cB + (size_t)((t) + 2) * kstep;     \
            const char* a3 = a2 + kstep; const char* b3 = b2 + kstep;                                \
            const int k2 = (last) ? 0 : (t) + 2; \
            if constexpr (GATHER) { if (last) { if (has_next) { PG8_LAS const unsigned* sl_ = (PG8_LAS const unsigned*)(lds + STAGE_BYTES + 4096); _Pragma("unroll") for (int h_ = 0; h_ < 2; ++h_) _Pragma("unroll") for (int i_ = 0; i_ < 2; ++i_) xao[h_][i_] = sl_[h_ * HALF + gR[i_]] * (unsigned)(lda * 2) + (unsigned)(gC[i_] * 2); } \
                else { xao[0][0] = cao[0][0]; xao[0][1] = cao[0][1]; xao[1][0] = cao[1][0]; xao[1][1] = cao[1][1]; } } } \
              \
            PG8_LDB(B0, 0, 0); if constexpr (!EpiHalfN<Epi>::v) PG8_LDB(B1, 0, 1); PG8_SCHED; PG8_LDA(At, 0, 0); PG8_STAGE_A(PG8_SA(1, 1), a1 + hstepA, 1, false, (t) + 1); \
            WAITA; PG8_WAIT_L(0); PG8_BAR; PG8_MMA(0, 0, At, B0); if constexpr (!EpiHalfN<Epi>::v) PG8_MMA(0, 1, At, B1); PG8_BAR; PG8_SCHED; \
            PG8_LDA(At, 0, 1); PG8_STAGE(PG8_SB(0, 0), b2, voffB); PG8_STAGE(PG8_SB(0, 1), b2 + hstepB, voffB); PG8_STAGE_A(PG8_SA(0, 0), a2, 0, last, k2); \
            WAITA; PG8_WAIT_L(0); PG8_BAR; PG8_MMA(1, 0, At, B0); if constexpr (!EpiHalfN<Epi>::v) PG8_MMA(1, 1, At, B1); PG8_BAR; PG8_SCHED; \
              \
            PG8_LDB(B0, 1, 0); if constexpr (!EpiHalfN<Epi>::v) PG8_LDB(B1, 1, 1); PG8_SCHED; PG8_LDA(At, 1, 0); PG8_STAGE_A(PG8_SA(0, 1), a2 + hstepA, 1, last, k2); \
            PG8_WAIT_V(8); PG8_WAIT_L(0); PG8_BAR; PG8_MMA(0, 0, At, B0); if constexpr (!EpiHalfN<Epi>::v) PG8_MMA(0, 1, At, B1); PG8_BAR; PG8_SCHED; \
            PG8_LDA(At, 1, 1); PG8_STAGE(PG8_SB(1, 0), b3, voffB); PG8_STAGE(PG8_SB(1, 1), b3 + hstepB, voffB); PG8_STAGE_A(PG8_SA(1, 0), a3, 0, last, k2 + 1); \
            PG8_WAIT_V(8); PG8_WAIT_L(0); PG8_BAR; PG8_MMA(1, 0, At, B0); if constexpr (!EpiHalfN<Epi>::v) PG8_MMA(1, 1, At, B1); PG8_BAR; PG8_SCHED; } while (0)
        if constexpr (GATHER || EpiStores<Epi>::v == 0) { for (int t = 0; t < nt; t += 2) { const bool last = (t == nt - 2); PG8_KPAIR(t, last, PG8_WAIT_V(8)); } }
        else { PG8_KPAIR(0, false, PG8_WAIT_VE);
               for (int t = 2; t < nt; t += 2) { const bool last = (t == nt - 2); PG8_KPAIR(t, last, PG8_WAIT_V(8)); } }
        if (wr == 0) PG8_BAR;
        { int l2 = threadIdx.x; asm volatile("" : "+v"(l2)); E(acc, cur, wr, wc, l2 & 15, (l2 >> 4) & 3); }
        if (!has_next) break;
#pragma unroll
        for (int a = 0; a < 2; ++a)
#pragma unroll
            for (int b = 0; b < 2; ++b)
#pragma unroll
                for (int m = 0; m < 4; ++m)
#pragma unroll
                    for (int n = 0; n < 2; ++n) acc[a][b][m][n] = __builtin_bit_cast(acc_t, (f32x4){0.f, 0.f, 0.f, 0.f});
        cur = nxt; cA = nA; cB = nB; ++ui;
        if constexpr (GATHER) { cao[0][0] = xao[0][0]; cao[0][1] = xao[0][1]; cao[1][0] = xao[1][0]; cao[1][1] = xao[1][1]; }
        if (wr == 1) PG8_BAR;
    }
    PG8_WAIT_V(0);
    PG8_BAR;
#undef PG8_SA
#undef PG8_SB
#undef PG8_STAGE
#undef PG8_STAGE_A
#undef PG8_GOFF
#undef PG8_LDA
#undef PG8_LDB
#undef PG8_MMA
#undef PG8_WAIT_V
#undef PG8_WAIT_L
#undef PG8_WAIT_VE
#undef PG8_KPAIR
#undef PG8_BAR
#undef PG8_SCHED
}
}
namespace att {
#define ATT_LAS __attribute__((address_space(3)))
typedef unsigned short bf16_t;
typedef short bf16x8 __attribute__((ext_vector_type(8)));
typedef short s16x4 __attribute__((ext_vector_type(4)));
typedef float f32x16 __attribute__((ext_vector_type(16)));
typedef unsigned u32x4 __attribute__((ext_vector_type(4)));
typedef unsigned u32x2 __attribute__((ext_vector_type(2)));
constexpr int SEQ = 4096, NHEAD = 16, QPITCH = 3072, KVPITCH = 4096, OPITCH = 2048, HQK = 192, HKV = 256, VOFF = 128, HV = 128;
constexpr int KT_BYTES = 64 * 256, VT_BYTES = 64 * 128 * 2;
constexpr float QK8 = 16.f;
typedef int i32x4 __attribute__((ext_vector_type(4)));
typedef int i32x16 __attribute__((ext_vector_type(16)));
constexpr int SLOT_BYTES = KT_BYTES + VT_BYTES, NSLOT = 4, LDS_BYTES = NSLOT * SLOT_BYTES;
constexpr float THR = 8.f;

typedef __bf16 bf16x2_t __attribute__((ext_vector_type(2)));
typedef float f32x2_t __attribute__((ext_vector_type(2)));
__device__ __forceinline__ unsigned cvtpk(float lo, float hi) { f32x2_t v = {lo, hi}; bf16x2_t r = __builtin_convertvector(v, bf16x2_t); return __builtin_bit_cast(unsigned, r); }
__device__ __forceinline__ bf16x8 pack8(const f32x16& p, int b) {
    u32x4 w = {cvtpk(p[b + 0], p[b + 1]), cvtpk(p[b + 2], p[b + 3]), cvtpk(p[b + 4], p[b + 5]), cvtpk(p[b + 6], p[b + 7])};
    return __builtin_bit_cast(bf16x8, w);
}
typedef float f32x4v __attribute__((ext_vector_type(4)));
__device__ __forceinline__ float bf2f(short s) { return __uint_as_float(((unsigned)(unsigned short)s) << 16); }
__device__ __forceinline__ bf16x8 pack8f(const float (&v)[8]) { u32x4 w = {cvtpk(v[0], v[1]), cvtpk(v[2], v[3]), cvtpk(v[4], v[5]), cvtpk(v[6], v[7])}; return __builtin_bit_cast(bf16x8, w); }
__device__ __forceinline__ i32x4 pack16q(const float (&v)[16]) { i32x4 w;
    w[0] = (int)pg8::q8x4(v[0], v[1], v[2], v[3]); w[1] = (int)pg8::q8x4(v[4], v[5], v[6], v[7]); w[2] = (int)pg8::q8x4(v[8], v[9], v[10], v[11]); w[3] = (int)pg8::q8x4(v[12], v[13], v[14], v[15]); return w; }
__device__ __forceinline__ int xhalf_imax(int v) { auto rr = __builtin_amdgcn_permlane32_swap((unsigned)v, (unsigned)v, false, false); const int a = (int)rr[0], b = (int)rr[1]; return a > b ? a : b; }
__device__ __forceinline__ s16x4 vtr(ATT_LAS const unsigned char* p) {
    typedef short v4i16_t __attribute__((ext_vector_type(4)));
    return __builtin_bit_cast(s16x4, __builtin_amdgcn_ds_read_tr16_b64_v4i16((ATT_LAS v4i16_t*)p));
}
__device__ __forceinline__ float xhalf_max(float v) { auto rr = __builtin_amdgcn_permlane32_swap(__float_as_uint(v), __float_as_uint(v), false, false); return fmaxf(__uint_as_float(rr[0]), __uint_as_float(rr[1])); }
__device__ __forceinline__ float xhalf_sum(float v) { auto rr = __builtin_amdgcn_permlane32_swap(__float_as_uint(v), __float_as_uint(v), false, false); return __uint_as_float(rr[0]) + __uint_as_float(rr[1]); }

__device__ __forceinline__ void attn_unit(ATT_LAS unsigned char* lds, const bf16_t* __restrict__ Q, const bf16_t* __restrict__ KV, bf16_t* __restrict__ O, const float* __restrict__ qn, const float* __restrict__ CS, int b, int h, int qb) {
    int tid = threadIdx.x; asm volatile("" : "+v"(tid));
    const int lane = tid & 63, c = lane & 31, hi = lane >> 5;
    const int wid = __builtin_amdgcn_readfirstlane(tid >> 6);
    const size_t row0 = (size_t)b * SEQ;
    const int q0 = qb * 256;
    const int NT = 4 * qb + 4;
    const int my_nt = 4 * qb + (wid >> 1) + 1;
    const char* kvh = (const char*)(KV + row0 * KVPITCH + h * HKV);
    unsigned koff[2], voff[2];
#pragma unroll
    for (int i = 0; i < 2; ++i) { const int qi = 64 * (wid + 8 * i) + lane, krow = qi >> 4, pos = qi & 15, kc = pos ^ (krow & 15);
        koff[i] = (unsigned)(krow * KVPITCH * 2 + kc * 16); }
#pragma unroll
    for (int j = 0; j < 2; ++j) { const int sg = 2 * (wid + 8 * j) + (lane >> 5), kb = sg >> 2, cg = sg & 3, vrow = kb * 8 + ((lane & 31) >> 2), vcol = cg * 32 + (lane & 3) * 8;
        voff[j] = (unsigned)(vrow * KVPITCH * 2 + (VOFF + vcol) * 2); }
#define ATT_DMA_K(t, kbuf) do { const char* tb_ = kvh + (size_t)(t) * 64 * KVPITCH * 2; \
        _Pragma("unroll") for (int i_ = 0; i_ < 2; ++i_) __builtin_amdgcn_global_load_lds((const unsigned*)(tb_ + koff[i_]), (ATT_LAS unsigned*)(lds + (kbuf) + 1024 * (wid + 8 * i_)), 16, 0, 0); } while (0)
#define ATT_DMA_V(t, vbuf) do { const char* tb_ = kvh + (size_t)(t) * 64 * KVPITCH * 2; \
        _Pragma("unroll") for (int j_ = 0; j_ < 2; ++j_) __builtin_amdgcn_global_load_lds((const unsigned*)(tb_ + voff[j_]), (ATT_LAS unsigned*)(lds + (vbuf) + 1024 * (wid + 8 * j_)), 16, 0, 0); } while (0)
    asm volatile("s_waitcnt lgkmcnt(0)\n\ts_barrier" ::: "memory");
    ATT_DMA_K(0, 0); ATT_DMA_K(1, KT_BYTES); ATT_DMA_V(0, 4 * KT_BYTES);
    i32x4 qf[6];
    { const size_t trow = row0 + q0 + 32 * wid + c;
      const unsigned char* qp = (const unsigned char*)Q + trow * QPITCH + h * HQK + 16 * hi;
      float qr[6][16];
#pragma unroll
      for (int s = 0; s < 6; ++s) { const i32x4 w = *(const i32x4*)(qp + 32 * s);
#pragma unroll
          for (int e = 0; e < 16; ++e) qr[s][e] = (float)((w[e >> 2] << (24 - 8 * (e & 3))) >> 24); }
      float ss = 0.f;
#pragma unroll
      for (int s = 0; s < 6; ++s)
#pragma unroll
          for (int e = 0; e < 16; ++e) { const float v = qr[s][e]; ss += v * v; }
      ss = xhalf_sum(ss);
      const float rs = (1.0f / sqrtf(ss * (1.0f / 192.f) + 1e-6f * 256.f)) * QK8;
#pragma unroll
      for (int s = 0; s < 4; ++s) { float v[16];
#pragma unroll
          for (int q4 = 0; q4 < 4; ++q4) { const f32x4v g = *(const f32x4v*)(qn + 32 * s + 16 * hi + 4 * q4);
#pragma unroll
              for (int e = 0; e < 4; ++e) v[4 * q4 + e] = qr[s][4 * q4 + e] * rs * g[e]; }
          qf[s] = pack16q(v); }
      const float* csr = CS + trow * 64 + 16 * hi;
      { float o1[16], o2[16];
#pragma unroll
        for (int q4 = 0; q4 < 4; ++q4) { const f32x4v ga = *(const f32x4v*)(qn + 128 + 16 * hi + 4 * q4), gb = *(const f32x4v*)(qn + 160 + 16 * hi + 4 * q4);
            const f32x4v cc = *(const f32x4v*)(csr + 4 * q4), sn = *(const f32x4v*)(csr + 32 + 4 * q4);
#pragma unroll
            for (int e = 0; e < 4; ++e) { const int idx = 4 * q4 + e; const float n1 = qr[4][idx] * rs * ga[e], n2 = qr[5][idx] * rs * gb[e];
                o1[idx] = n1 * cc[e] - n2 * sn[e]; o2[idx] = n2 * cc[e] + n1 * sn[e]; } }
        qf[4] = pack16q(o1); qf[5] = pack16q(o2); } }
    unsigned ko[6];
#pragma unroll
    for (int s = 0; s < 6; ++s) ko[s] = (unsigned)(c * 256 + 16 * ((2 * s + hi) ^ (c & 15)));
    const unsigned vbase = (unsigned)(hi * 256 + ((lane >> 2) & 3) * 64 + ((lane >> 4) & 1) * 32 + (lane & 3) * 8);
    f32x16 o[4];
#pragma unroll
    for (int d = 0; d < 4; ++d)
#pragma unroll
        for (int r = 0; r < 16; ++r) o[d][r] = 0.f;
    float l_run = 0.f;
    constexpr float CSC = 0.07216878364870322f * 1.4426950408889634f / (QK8 * QK8);
#define ATT_QKH(A, koff_) do { ATT_LAS const unsigned char* kp = lds + (koff_); \
            { const i32x16 z = {0, 0, 0, 0, 0, 0, 0, 0, 0, 0, 0, 0, 0, 0, 0, 0}; const i32x4 k0 = *(ATT_LAS const i32x4*)(kp + ko[0]); A = __builtin_amdgcn_mfma_i32_32x32x32_i8(k0, qf[0], z, 0, 0, 0); } \
            _Pragma("unroll") for (int s = 1; s < 6; ++s) { const i32x4 k0 = *(ATT_LAS const i32x4*)(kp + ko[s]); A = __builtin_amdgcn_mfma_i32_32x32x32_i8(k0, qf[s], A, 0, 0, 0); } } while (0)
#define ATT_EXPH(A, P0, P1) do { float pe[16]; \
            _Pragma("unroll") for (int r = 0; r < 16; ++r) pe[r] = __builtin_amdgcn_exp2f((float)A[r] * CSC); \
            { u32x4 w = {cvtpk(pe[0], pe[1]), cvtpk(pe[2], pe[3]), cvtpk(pe[4], pe[5]), cvtpk(pe[6], pe[7])}; P0 = __builtin_bit_cast(bf16x8, w); } \
            { u32x4 w = {cvtpk(pe[8], pe[9]), cvtpk(pe[10], pe[11]), cvtpk(pe[12], pe[13]), cvtpk(pe[14], pe[15])}; P1 = __builtin_bit_cast(bf16x8, w); } \
            float ps = 0.f; \
            _Pragma("unroll") for (int r = 0; r < 16; ++r) ps += pe[r]; \
            l_run += ps; } while (0)
#define ATT_PVH(P0, P1, voff_) do { ATT_LAS const unsigned char* vp = lds + (voff_) + vbase; \
            _Pragma("unroll") for (int d = 0; d < 4; ++d) { \
                    const s16x4 lo = vtr(vp + d * 512), hh = vtr(vp + 2048 + d * 512); \
                    const bf16x8 a = {lo[0], lo[1], lo[2], lo[3], hh[0], hh[1], hh[2], hh[3]}; \
                    o[d] = __builtin_amdgcn_mfma_f32_32x32x16_bf16(a, P0, o[d], 0, 0, 0); } \
            _Pragma("unroll") for (int d = 0; d < 4; ++d) { \
                    const s16x4 lo = vtr(vp + 4096 + d * 512), hh = vtr(vp + 4096 + 2048 + d * 512); \
                    const bf16x8 a = {lo[0], lo[1], lo[2], lo[3], hh[0], hh[1], hh[2], hh[3]}; \
                    o[d] = __builtin_amdgcn_mfma_f32_32x32x16_bf16(a, P1, o[d], 0, 0, 0); } } while (0)
#define ATT_VF(j_) ({ const int d_ = (j_) & 3, h_ = (j_) >> 2; const s16x4 lo_ = vtr(vp_s + h_ * 4096 + d_ * 512), hh_ = vtr(vp_s + h_ * 4096 + 2048 + d_ * 512); \
        bf16x8 a_ = {lo_[0], lo_[1], lo_[2], lo_[3], hh_[0], hh_[1], hh_[2], hh_[3]}; a_; })
#define ATT_PV1(j_, vf_, P0, P1) o[(j_) & 3] = __builtin_amdgcn_mfma_f32_32x32x16_bf16(vf_, ((j_) < 4 ? P0 : P1), o[(j_) & 3], 0, 0, 0)
#define ATT_E(r_) pe[r_] = __builtin_amdgcn_exp2f((float)Ain_[r_] * CSC)
#define ATT_HALF(A, koff_, P0, P1, voff_, AinV, Pout0, Pout1) do { \
        ATT_LAS const unsigned char* kp_s = lds + (koff_); ATT_LAS const unsigned char* vp_s = lds + (voff_) + vbase; const i32x16 Ain_ = AinV; float pe[16]; \
        i32x4 kf = *(ATT_LAS const i32x4*)(kp_s + ko[0]); bf16x8 va_ = ATT_VF(0), vb_ = ATT_VF(1); \
        __builtin_amdgcn_sched_barrier(0); \
        { const i32x16 z = {0, 0, 0, 0, 0, 0, 0, 0, 0, 0, 0, 0, 0, 0, 0, 0}; A = __builtin_amdgcn_mfma_i32_32x32x32_i8(kf, qf[0], z, 0, 0, 0); } asm volatile("" : "+v"(A)); ATT_PV1(0, va_, P0, P1); ATT_PV1(1, vb_, P0, P1); \
        kf = *(ATT_LAS const i32x4*)(kp_s + ko[1]); va_ = ATT_VF(2); ATT_E(0); ATT_E(1); ATT_E(2); \
        __builtin_amdgcn_sched_barrier(0); \
        A = __builtin_amdgcn_mfma_i32_32x32x32_i8(kf, qf[1], A, 0, 0, 0); asm volatile("" : "+v"(A)); ATT_PV1(2, va_, P0, P1); \
        kf = *(ATT_LAS const i32x4*)(kp_s + ko[2]); va_ = ATT_VF(3); ATT_E(3); ATT_E(4); ATT_E(5); \
        __builtin_amdgcn_sched_barrier(0); \
        A = __builtin_amdgcn_mfma_i32_32x32x32_i8(kf, qf[2], A, 0, 0, 0); asm volatile("" : "+v"(A)); ATT_PV1(3, va_, P0, P1); \
        kf = *(ATT_LAS const i32x4*)(kp_s + ko[3]); va_ = ATT_VF(4); vb_ = ATT_VF(5); ATT_E(6); ATT_E(7); \
        { u32x4 w = {cvtpk(pe[0], pe[1]), cvtpk(pe[2], pe[3]), cvtpk(pe[4], pe[5]), cvtpk(pe[6], pe[7])}; Pout0 = __builtin_bit_cast(bf16x8, w); } \
        __builtin_amdgcn_sched_barrier(0); \
        A = __builtin_amdgcn_mfma_i32_32x32x32_i8(kf, qf[3], A, 0, 0, 0); asm volatile("" : "+v"(A)); ATT_PV1(4, va_, P0, P1); ATT_PV1(5, vb_, P0, P1); \
        kf = *(ATT_LAS const i32x4*)(kp_s + ko[4]); va_ = ATT_VF(6); ATT_E(8); ATT_E(9); ATT_E(10); \
        __builtin_amdgcn_sched_barrier(0); \
        A = __builtin_amdgcn_mfma_i32_32x32x32_i8(kf, qf[4], A, 0, 0, 0); asm volatile("" : "+v"(A)); ATT_PV1(6, va_, P0, P1); \
        kf = *(ATT_LAS const i32x4*)(kp_s + ko[5]); va_ = ATT_VF(7); ATT_E(11); ATT_E(12); ATT_E(13); \
        __builtin_amdgcn_sched_barrier(0); \
        A = __builtin_amdgcn_mfma_i32_32x32x32_i8(kf, qf[5], A, 0, 0, 0); asm volatile("" : "+v"(A)); ATT_PV1(7, va_, P0, P1); \
        ATT_E(14); ATT_E(15); \
        { u32x4 w = {cvtpk(pe[8], pe[9]), cvtpk(pe[10], pe[11]), cvtpk(pe[12], pe[13]), cvtpk(pe[14], pe[15])}; Pout1 = __builtin_bit_cast(bf16x8, w); } \
        { float ps = 0.f; _Pragma("unroll") for (int r = 0; r < 16; ++r) ps += pe[r]; l_run += ps; } \
        __builtin_amdgcn_sched_barrier(0); } while (0)
    { i32x16 aX, aY; bf16x8 pX0, pX1, pY0, pY1;
      for (int t = -1; t <= NT; ++t) {
          if (t + 2 < NT) asm volatile("s_waitcnt vmcnt(4) lgkmcnt(0)\n\ts_barrier" ::: "memory");
          else if (t + 1 < NT) asm volatile("s_waitcnt vmcnt(2) lgkmcnt(0)\n\ts_barrier" ::: "memory");
          else asm volatile("s_waitcnt vmcnt(0) lgkmcnt(0)\n\ts_barrier" ::: "memory");
          if (t + 3 < NT) ATT_DMA_K(t + 3, ((t + 3) & 3) * KT_BYTES);
          if (t + 2 < NT) ATT_DMA_V(t + 2, 4 * KT_BYTES + ((t + 2) & 3) * VT_BYTES);
          const int kc = (t & 3) * KT_BYTES + 32 * 256, kn = ((t + 1) & 3) * KT_BYTES;
          const int vp_ = 4 * KT_BYTES + ((t - 1) & 3) * VT_BYTES + 2 * 4096, vc = 4 * KT_BYTES + (t & 3) * VT_BYTES;
          const bool act = (t >= 0 && t < my_nt), v0 = (t >= 1 && t <= my_nt), q1 = (t + 1 < my_nt);
          if (act && v0 && q1) {
              ATT_HALF(aY, kc, pY0, pY1, vp_, aX, pX0, pX1);
              ATT_HALF(aX, kn, pX0, pX1, vc, aY, pY0, pY1);
          } else {
              if (act) ATT_QKH(aY, kc);
              if (v0) ATT_PVH(pY0, pY1, vp_);
              if (act) ATT_EXPH(aX, pX0, pX1);
              __builtin_amdgcn_sched_barrier(0);
              if (q1) ATT_QKH(aX, kn);
              if (act) { ATT_PVH(pX0, pX1, vc); ATT_EXPH(aY, pY0, pY1); }
              __builtin_amdgcn_sched_barrier(0);
          }
      } }
#undef ATT_HALF
#undef ATT_E
#undef ATT_PV1
#undef ATT_VF
#undef ATT_PVH
#undef ATT_EXPH
#undef ATT_QKH
    l_run = xhalf_sum(l_run);
#undef ATT_STEP
#undef ATT_STAGES
#undef ATT_CHUNK
#undef ATT_QK1
    { const int spos = q0 + 32 * wid + c; const float sc = pg8::o_row_scale(spos) / l_run;
      unsigned char* op = (unsigned char*)O + (row0 + spos) * 2048 + h * HV;
#pragma unroll
      for (int d = 0; d < 4; ++d)
          { u32x4 w;
#pragma unroll
            for (int j = 0; j < 2; ++j) { const int g0 = j, g1 = j + 2;
              const unsigned w0 = pg8::q8x4(o[d][4 * g0] * sc, o[d][4 * g0 + 1] * sc, o[d][4 * g0 + 2] * sc, o[d][4 * g0 + 3] * sc);
              const unsigned w1 = pg8::q8x4(o[d][4 * g1] * sc, o[d][4 * g1 + 1] * sc, o[d][4 * g1 + 2] * sc, o[d][4 * g1 + 3] * sc);
              auto rr = __builtin_amdgcn_permlane32_swap(w0, w1, false, false);
              if (j == 0) { w.x = rr[0]; w.y = rr[1]; } else { w.z = rr[0]; w.w = rr[1]; } }
            *(u32x4*)(op + 32 * d + (hi ? 16 : 0)) = w; } }
#undef ATT_DMA_K
#undef ATT_DMA_V
}
__device__ __forceinline__ void attn_phase(ATT_LAS unsigned char* lds, const bf16_t* Q, const bf16_t* KV, bf16_t* O, const float* qn, const float* CS, unsigned* queues, int xcc) {
    ATT_LAS unsigned* tk = (ATT_LAS unsigned*)(lds + LDS_BYTES);
    for (int s = 0; s < 8; ++s) {
        const int qx = (xcc + s) & 7;
        for (;;) {
            if (threadIdx.x == 0) *tk = __hip_atomic_fetch_add(queues + 64 * qx, 1u, __ATOMIC_RELAXED, __HIP_MEMORY_SCOPE_AGENT);
            asm volatile("s_waitcnt vmcnt(0) lgkmcnt(0)\n\ts_barrier" ::: "memory");
            const unsigned pr = (unsigned)__builtin_amdgcn_readfirstlane((int)*tk);
            asm volatile("s_waitcnt lgkmcnt(0)\n\ts_barrier" ::: "memory");
            if (pr >= 128u) break;
            const int pair = qx * 128 + (int)pr, bh = pair >> 3, x = pair & 7, b = bh >> 4, h = bh & 15;
#pragma nounroll
            for (int u = 0; u < 2; ++u) attn_unit(lds, Q, KV, O, qn, CS, b, h, u ? x : 15 - x);
        }
    }
    asm volatile("s_waitcnt vmcnt(0) lgkmcnt(0)\n\ts_barrier" ::: "memory");
}
}
#ifndef MK_MULTI
#define MK_MULTI 0
#endif
constexpr int NWAVES = 8;
constexpr int T = 32768, DM = 2048, SEQ = 4096, NB = 8, NH = 16;
constexpr int NPHASE = 20;
constexpr float EPS = 1e-6f;
constexpr int PSLOTS = 81920;
constexpr size_t MiB = 1u << 20;
constexpr size_t WS_CTL = 0, CTL_ZERO_BYTES = 1 * MiB;
constexpr size_t WS_WIN = 1 * MiB;
constexpr size_t WS_WQ = 6 * MiB;
constexpr size_t WS_WKV = 9 * MiB;
constexpr size_t WS_WO = 13 * MiB;
constexpr size_t WS_PWIN = 21 * MiB;
constexpr size_t WS_WG = 29 * MiB;
constexpr size_t WS_PWO = 31 * MiB;
constexpr size_t WS_RW = 39 * MiB;
constexpr size_t WS_CS = 41 * MiB;
constexpr size_t WS_GUT = 50 * MiB;
constexpr size_t WS_DT = 562 * MiB;
constexpr size_t WS_XB0 = 818 * MiB;
constexpr size_t WS_LOG = 946 * MiB;
constexpr size_t WS_MISC = 956 * MiB;
constexpr size_t WS_U = 960 * MiB;
constexpr size_t WS_C = WS_U, WS_CQ = WS_U + 80 * MiB, WS_CKV = WS_U + 112 * MiB, WS_Q = WS_U + 144 * MiB, WS_KV = WS_U + 336 * MiB, WS_O = WS_U + 656 * MiB;
constexpr size_t WS_CQ8 = WS_U + 80 * MiB;
constexpr size_t WS_XQ = WS_U;
constexpr size_t WS_XS = WS_U, WS_H = WS_U + 320 * MiB, WS_Y = WS_U + 400 * MiB;
constexpr size_t WS_LOG1 = WS_U + 736 * MiB;
constexpr size_t WS_SSQC = WS_U + 746 * MiB;
constexpr size_t WS_UU = WS_U, WS_PM = WS_U + 128 * MiB, WS_Y2 = WS_U + 256 * MiB;
constexpr size_t WS_XB1 = WS_U + 784 * MiB;
constexpr size_t WS_SSQP = WS_XB1 + 128 * MiB;
constexpr size_t WS_WPT = WS_SSQP + 4 * MiB;
constexpr size_t WS_END = WS_WPT + 8 * MiB;
constexpr size_t MS_TOKE = 0;
constexpr size_t MS_TOKW = 256 * 1024;
constexpr size_t MS_SLOT = 512 * 1024;
constexpr size_t MS_BC = 768 * 1024;
constexpr size_t MS_TILE = 896 * 1024;
constexpr size_t MS_RSTD0 = 1024 * 1024;
constexpr size_t MS_RSTD2 = 1152 * 1024;
constexpr size_t MS_RSTOK = 1280 * 1024;
constexpr size_t MS_RSSLOT = 1408 * 1024;
constexpr size_t MS_STOK = 1792 * 1024;
constexpr int CW_BAR = 4096;
constexpr int LDS_TILE_OFF = 143360;
constexpr int CW_ATTQ = 8192;
constexpr int CW_CONVQ = 8192 + 1024;
constexpr int NCONV = 6;

#define GAS __attribute__((address_space(1)))
#define LAS __attribute__((address_space(3)))
typedef unsigned short bf16;
typedef unsigned v4u __attribute__((ext_vector_type(4)));
typedef unsigned v2u __attribute__((ext_vector_type(2)));
typedef float f32x4 __attribute__((ext_vector_type(4)));
#define RLX_AGENT __ATOMIC_RELAXED, __HIP_MEMORY_SCOPE_AGENT
__device__ __forceinline__ unsigned pk2(float lo, float hi) { return pg8::cvt_pk_bf16(lo, hi); }
__device__ __forceinline__ float bf_lo(unsigned w) { return __uint_as_float(w << 16); }
__device__ __forceinline__ float bf_hi(unsigned w) { return __uint_as_float(w & 0xffff0000u); }

#define XB_TMO      128
#define XB_XCNT(j)  (256  + 64 * (j))
#define XB_XSUB(j)  (1280 + 64 * (j))
#define XB_XGEN(j)  (2304 + 64 * (j))
#define XB_TOP      3328
#define XB_TOPGEN   3392
#define XCD_BAR_WORDS 3456
#define XB_SPIN_CAP (1u << 18)
__device__ __forceinline__ unsigned xb_ld(unsigned* p)              { return __hip_atomic_load(p, __ATOMIC_RELAXED, __HIP_MEMORY_SCOPE_AGENT); }
__device__ __forceinline__ unsigned xb_add(unsigned* p, unsigned v) { return __hip_atomic_fetch_add(p, v, __ATOMIC_RELAXED, __HIP_MEMORY_SCOPE_AGENT); }
__device__ __forceinline__ unsigned xb_xcc_id() { return (unsigned)__builtin_amdgcn_s_getreg((3 << 11) | 20) & 0xFu; }
#define XB_SPIN(cond, bar) do { unsigned _sp = 0; while (cond) { __builtin_amdgcn_s_sleep(1); \
    if ((++_sp & 255u) == 0u) { if (xb_ld(&(bar)[XB_TMO])) break; if (_sp > XB_SPIN_CAP) { atomicAdd(&(bar)[XB_TMO], 1u); break; } } } } while (0)
struct XcdBarrier { unsigned* bar; unsigned x; volatile LAS unsigned* st; };
__device__ __forceinline__ XcdBarrier xcd_barrier_post(unsigned* bar, volatile LAS unsigned* st) {
    XcdBarrier b; b.bar = bar; b.x = xb_xcc_id(); b.st = st;
    if (threadIdx.x == 0) (void)xb_add(&bar[XB_XCNT(b.x)], 1u);
    return b;
}
__device__ __forceinline__ void xcd_barrier_complete(unsigned* bar, unsigned x, unsigned& nloc, unsigned& nx) {
    const unsigned G = gridDim.x * gridDim.y * gridDim.z;
    unsigned sum, cnt, mine, sp = 0u;
    for (;;) {
        sum = 0u; cnt = 0u; mine = 0u;
#pragma unroll
        for (unsigned j = 0; j < 16; ++j) { const unsigned c = xb_ld(&bar[XB_XCNT(j)]); sum += c; cnt += (c > 0u) ? 1u : 0u; mine = (j == x) ? c : mine; }
        if (sum == G) break;
        __builtin_amdgcn_s_sleep(1);
        if ((++sp & 255u) == 0u) { if (xb_ld(&bar[XB_TMO])) break; if (sp > XB_SPIN_CAP) { atomicAdd(&bar[XB_TMO], 1u); break; } }
    }
    nloc = mine > 0u ? mine : 1u; nx = cnt > 0u ? cnt : 1u;
}
__device__ __forceinline__ void xcd_barrier(const XcdBarrier& b) {
    asm volatile("s_waitcnt vmcnt(0)" ::: "memory");
    __syncthreads();
    if (threadIdx.x == 0) {
        unsigned* bar = b.bar;
        __builtin_amdgcn_s_waitcnt(0);
        unsigned nloc = b.st[0], nx = b.st[1];
        if (nloc == 0u) { xcd_barrier_complete(bar, b.x, nloc, nx); b.st[0] = nloc; b.st[1] = nx; }
        const unsigned old = xb_add(&bar[XB_XSUB(b.x)], 1u);
        const unsigned gen = old / nloc;
        if (old + 1u == (gen + 1u) * nloc) {
            __builtin_amdgcn_fence(__ATOMIC_RELEASE, "agent");
            asm volatile("s_waitcnt vmcnt(0)" ::: "memory");
            const unsigned og = xb_add(&bar[XB_TOP], 1u);
            const unsigned tg = og / nx;
            if (og + 1u == (tg + 1u) * nx) xb_add(&bar[XB_TOPGEN], 1u);
            else XB_SPIN(xb_ld(&bar[XB_TOPGEN]) == tg, bar);
            __builtin_amdgcn_fence(__ATOMIC_ACQUIRE, "agent");
            xb_add(&bar[XB_XGEN(b.x)], 1u);
            asm volatile("s_waitcnt vmcnt(0)" ::: "memory");
        } else {
            XB_SPIN(xb_ld(&bar[XB_XGEN(b.x)]) == gen, bar);
            __builtin_amdgcn_fence(__ATOMIC_ACQUIRE, "agent");
            asm volatile("s_waitcnt vmcnt(0)" ::: "memory");
        }
    }
    __syncthreads();
}

__device__ __forceinline__ void ld8(const bf16* p, float (&v)[8]) { const v4u a = *(const v4u*)p;
    v[0] = bf_lo(a.x); v[1] = bf_hi(a.x); v[2] = bf_lo(a.y); v[3] = bf_hi(a.y); v[4] = bf_lo(a.z); v[5] = bf_hi(a.z); v[6] = bf_lo(a.w); v[7] = bf_hi(a.w); }
#define SWZ_XOR(k) (((k) << 10) | 0x1F)
__device__ __forceinline__ float wave_sum(float v) {
    v += __int_as_float(__builtin_amdgcn_ds_swizzle(__float_as_int(v), SWZ_XOR(1)));
    v += __int_as_float(__builtin_amdgcn_ds_swizzle(__float_as_int(v), SWZ_XOR(2)));
    v += __int_as_float(__builtin_amdgcn_ds_swizzle(__float_as_int(v), SWZ_XOR(4)));
    v += __int_as_float(__builtin_amdgcn_ds_swizzle(__float_as_int(v), SWZ_XOR(8)));
    v += __int_as_float(__builtin_amdgcn_ds_swizzle(__float_as_int(v), SWZ_XOR(16)));
    auto rr = __builtin_amdgcn_permlane32_swap(__float_as_uint(v), __float_as_uint(v), false, false);
    return __uint_as_float(rr[0]) + __uint_as_float(rr[1]);
}
struct Ctx { LAS unsigned char* lds; int tid, lane, wave, vcu, G, gw, NGW, bx; };
__device__ __forceinline__ Ctx make_ctx(LAS unsigned char* lds) {
    Ctx X; X.lds = lds;
    int tid = threadIdx.x, G = gridDim.x, bx = blockIdx.x; asm volatile("" : "+v"(tid)); asm volatile("" : "+s"(G), "+s"(bx));
    X.tid = tid; X.lane = tid & 63; X.wave = __builtin_amdgcn_readfirstlane(tid >> 6); X.G = G; X.bx = bx;
    X.vcu = (G % 8 == 0) ? (bx % 8) * (G / 8) + bx / 8 : bx;
    X.gw = X.vcu * NWAVES + X.wave; X.NGW = G * NWAVES;
    return X;
}

__device__ __forceinline__ void tr_item(const float* __restrict__ W, int N, bf16* __restrict__ WT, int ldk, int k0, int n0, int orow0, const float* __restrict__ kscale, int lane) {
    const int c = lane & 15, g = lane >> 4;
    const float* src = W + (size_t)(k0 + 8 * g) * N + n0 + 4 * c;
    f32x4 v[2][8];
#pragma unroll
    for (int hh = 0; hh < 2; ++hh)
#pragma unroll
        for (int j = 0; j < 8; ++j) v[hh][j] = *(const f32x4*)(src + (size_t)(32 * hh + j) * N);
    if (kscale) {
#pragma unroll
        for (int hh = 0; hh < 2; ++hh) { const f32x4 s0 = *(const f32x4*)(kscale + k0 + 32 * hh + 8 * g), s1 = *(const f32x4*)(kscale + k0 + 32 * hh + 8 * g + 4);
#pragma unroll
            for (int j = 0; j < 8; ++j) v[hh][j] = v[hh][j] * (j < 4 ? s0[j & 3] : s1[j & 3]); }
    }
#pragma unroll
    for (int hh = 0; hh < 2; ++hh)
#pragma unroll
        for (int jj = 0; jj < 4; ++jj) {
            v4u o; o.x = pk2(v[hh][0][jj], v[hh][1][jj]); o.y = pk2(v[hh][2][jj], v[hh][3][jj]); o.z = pk2(v[hh][4][jj], v[hh][5][jj]); o.w = pk2(v[hh][6][jj], v[hh][7][jj]);
            *(v4u*)(WT + (size_t)(orow0 + 4 * c + jj) * ldk + k0 + 32 * hh + 8 * g) = o;
        }
}
__device__ __forceinline__ float store_row_rstd(const f32x4 (&v)[8], bf16* __restrict__ orow, int lane) {
    float s = 0.f;
#pragma unroll
    for (int j = 0; j < 8; ++j) s += (v[j][0] * v[j][0] + v[j][1] * v[j][1]) + (v[j][2] * v[j][2] + v[j][3] * v[j][3]);
#pragma unroll
    for (int j = 0; j < 8; ++j) { v2u w; w.x = pk2(v[j][0], v[j][1]); w.y = pk2(v[j][2], v[j][3]); *(v2u*)(orow + 4 * lane + 256 * j) = w; }
    return 1.0f / sqrtf(wave_sum(s) * (1.0f / DM) + EPS);
}

struct Params {
    const float* in[23]; float* out; unsigned char* ws; int ph_lo, ph_hi;
};
typedef const __attribute__((address_space(4))) Params* KP;
__device__ __forceinline__ KP kargs() { KP k = (KP)__builtin_amdgcn_kernarg_segment_ptr(); asm volatile("" : "+s"(k)); return k; }

constexpr int MOE_ITEMS = 128 * 768, CONV_CHUNK = 8, CONV_TICKETS = MOE_ITEMS / CONV_CHUNK;
struct TrJob { const float* W; unsigned char* WT; int N, ldk, k0, n0, orow0; float scale; const float* ks; };
constexpr float QS_Q = 16.f;
constexpr float QS_Y = 32.f;
constexpr float QS_A = 16.f, QS_WGU = 1024.f, QS_H = 16.f, QS_WD = 512.f, QS_X = 16.f, QS_WIN = 1024.f, QS_C = 16.f, QS_WQK = 512.f;
__device__ __forceinline__ TrJob moe_job(KP p, int r) {
    unsigned char* GUT = (unsigned char*)(p->ws + WS_GUT); unsigned char* DT = (unsigned char*)(p->ws + WS_DT);
    const int le = r / 768, rr = r % 768, which = rr / 256, id = rr % 256; TrJob j;
    if (which < 2) { const int kb = id / 16, nb = id % 16, n0 = 32 * nb;
        j.W = p->in[20 + which] + (size_t)le * 2048 * 512; j.N = 512; j.WT = GUT + (size_t)le * 1024 * 2048; j.ldk = 2048; j.k0 = 128 * kb; j.n0 = n0; j.orow0 = 256 * (n0 >> 7) + (n0 & 127) + 128 * which; j.scale = QS_WGU; j.ks = nullptr;
    } else { const int kb = id / 64, nb = id % 64;
        j.W = p->in[22] + (size_t)le * 512 * 2048; j.N = 2048; j.WT = DT + (size_t)le * 2048 * 512; j.ldk = 512; j.k0 = 128 * kb; j.n0 = 32 * nb; j.orow0 = 32 * nb; j.scale = QS_WD; j.ks = nullptr; }
    return j;
}
__device__ __forceinline__ void tr_load(const TrJob& j, f32x4 (&v)[16], int lane) {
    const int c = lane & 7, g = lane >> 3; const float* src = j.W + (size_t)(j.k0 + 16 * g) * j.N + j.n0 + 4 * c;
#pragma unroll
    for (int q = 0; q < 16; ++q) v[q] = __builtin_nontemporal_load((const f32x4*)(src + (size_t)q * j.N));
}
__device__ __forceinline__ void tr_store(const TrJob& j, f32x4 (&v)[16], int lane) {
    const int c = lane & 7, g = lane >> 3;
    if (j.ks) {
#pragma unroll
        for (int q4 = 0; q4 < 4; ++q4) { const f32x4 s = *(const f32x4*)(j.ks + j.k0 + 16 * g + 4 * q4);
#pragma unroll
            for (int e = 0; e < 4; ++e) v[4 * q4 + e] = v[4 * q4 + e] * s[e]; } }
#pragma unroll
    for (int jj = 0; jj < 4; ++jj) {
        v4u o; o.x = pg8::q8x4(v[0][jj] * j.scale, v[1][jj] * j.scale, v[2][jj] * j.scale, v[3][jj] * j.scale); o.y = pg8::q8x4(v[4][jj] * j.scale, v[5][jj] * j.scale, v[6][jj] * j.scale, v[7][jj] * j.scale);
        o.z = pg8::q8x4(v[8][jj] * j.scale, v[9][jj] * j.scale, v[10][jj] * j.scale, v[11][jj] * j.scale); o.w = pg8::q8x4(v[12][jj] * j.scale, v[13][jj] * j.scale, v[14][jj] * j.scale, v[15][jj] * j.scale);
        *(v4u*)(j.WT + (size_t)(j.orow0 + 4 * c + jj) * j.ldk + j.k0 + 16 * g) = o;
    }
}
__device__ __forceinline__ void moe_convert_drain(KP p, unsigned* q, int lane) {
    for (;;) {
        unsigned t = 0u; if (lane == 0) t = __hip_atomic_fetch_add(q, 1u, RLX_AGENT);
        t = (unsigned)__builtin_amdgcn_readfirstlane((int)t);
        if (t >= (unsigned)CONV_TICKETS) break;
        for (int i = 0; i < CONV_CHUNK; i += 2) {
            const TrJob ja = moe_job(p, (int)t * CONV_CHUNK + i), jb = moe_job(p, (int)t * CONV_CHUNK + i + 1);
            f32x4 va[16], vb[16]; tr_load(ja, va, lane); tr_load(jb, vb, lane); tr_store(ja, va, lane); tr_store(jb, vb, lane); }
    }
}

__device__ __forceinline__ void phase_prologue(const Ctx& X, KP p) {
    unsigned char* ws = p->ws;
    bf16* WinT = (bf16*)(ws + WS_WIN); bf16* WqT = (bf16*)(ws + WS_WQ); bf16* WkvT = (bf16*)(ws + WS_WKV); bf16* WoT = (bf16*)(ws + WS_WO);
    bf16* PwinT = (bf16*)(ws + WS_PWIN); bf16* WgT = (bf16*)(ws + WS_WG); bf16* PwoT = (bf16*)(ws + WS_PWO); bf16* RW = (bf16*)(ws + WS_RW);
    float* CS = (float*)(ws + WS_CS); bf16* XB0 = (bf16*)(ws + WS_XB0); float* RSTD0 = (float*)(ws + WS_MISC + MS_RSTD0);
    constexpr int I_WIN = 16 * 34, I_WQ = 4 * 96, I_WKV = 4 * 128, I_SQ = 32 * 32, I_WG = 4 * 64;
    constexpr int NITEMS = I_WIN + I_WQ + I_WKV + 2 * I_SQ + I_WG;
    const int lane = X.lane;
#pragma clang loop unroll(disable)
    for (int it = X.gw; it < NITEMS; it += X.NGW) {
        int r = it;
        if (r < I_WIN) { const int kb = r / 34, nb = r % 34; TrJob j{p->in[3], (unsigned char*)WinT, 1088, 2048, 128 * kb, 32 * nb, 32 * nb, QS_WIN, p->in[2]}; f32x4 v[16]; tr_load(j, v, lane); tr_store(j, v, lane); continue; } r -= I_WIN;
        if (r < I_WQ) { const int kb = r / 96, nb = r % 96; TrJob j{p->in[6], (unsigned char*)WqT, 3072, 512, 128 * kb, 32 * nb, 32 * nb, QS_WQK, p->in[4]}; f32x4 v[16]; tr_load(j, v, lane); tr_store(j, v, lane); continue; } r -= I_WQ;
        if (r < I_WKV) { const int kb = r / 128, nb = r % 128; TrJob j{p->in[7], (unsigned char*)WkvT, 4096, 512, 128 * kb, 32 * nb, 32 * nb, QS_WQK, p->in[5]}; f32x4 v[16]; tr_load(j, v, lane); tr_store(j, v, lane); continue; } r -= I_WKV;
        if (r < I_SQ) { const int kb = r / 64, nb = r % 64; TrJob j{p->in[10], (unsigned char*)WoT, 2048, 2048, 128 * kb, 32 * nb, 32 * nb, QS_WIN, nullptr}; f32x4 v[16]; tr_load(j, v, lane); tr_store(j, v, lane); continue; } r -= I_SQ;
        if (r < I_SQ) { const int kb = r / 32, nb = r % 32; tr_item(p->in[14], 2048, PwoT, 2048, 64 * kb, 64 * nb, 64 * nb, nullptr, lane); continue; } r -= I_SQ;
        if (r < I_WG) { const int g = r / 64, q = r % 64, kb = q / 8, nb = q % 8; tr_item(p->in[12] + (size_t)g * 512 * 512, 512, WgT, 512, 64 * kb, 64 * nb, g * 512 + 64 * nb, nullptr, lane); }
    }
    const int gt = X.vcu * (NWAVES * 64) + X.tid, NGT = X.G * NWAVES * 64;
    for (int i = gt; i < 2048 * 2048 / 8; i += NGT) { const f32x4 a = *(const f32x4*)(p->in[11] + (size_t)i * 8), b = *(const f32x4*)(p->in[11] + (size_t)i * 8 + 4);
        v4u o; o.x = pk2(a[0], a[1]); o.y = pk2(a[2], a[3]); o.z = pk2(b[0], b[1]); o.w = pk2(b[2], b[3]); *(v4u*)(PwinT + (size_t)i * 8) = o; }
    for (int i = gt; i < 192 * 128; i += NGT) *(v4u*)((unsigned char*)WinT + (size_t)1088 * 2048 + (size_t)i * 16) = (v4u){0u, 0u, 0u, 0u};
    for (int i = gt; i < 2 * 256 * 256; i += NGT) {
        const int l = i >> 16, n = (i >> 8) & 255, k0 = (i & 255) * 8; float v[8];
#pragma unroll
        for (int j = 0; j < 8; ++j) v[j] = (n < 8 ? p->in[16][((size_t)l * 2048 + k0 + j) * 8 + n] : (n < 72 ? p->in[18][((size_t)l * 2048 + k0 + j) * 64 + (n - 8)] : 0.f)) * p->in[15][l * 2048 + k0 + j];
        v4u o; o.x = pk2(v[0], v[1]); o.y = pk2(v[2], v[3]); o.z = pk2(v[4], v[5]); o.w = pk2(v[6], v[7]);
        *(v4u*)(RW + ((size_t)l * 256 + n) * 2048 + k0) = o;
    }
    { const int* pos = (const int*)p->in[1];
      for (int i = gt; i < T * 32; i += NGT) { const int t = i >> 5, j = i & 31;
          const float inv_freq = __builtin_amdgcn_exp2f(-(float)j * 0.41524101186092029f);
          const float ang = (float)pos[t] * inv_freq;
          double rev = (double)ang * 0.15915494309189535; rev -= rint(rev);
          const float xr = (float)rev;
          CS[(size_t)t * 64 + j] = __builtin_amdgcn_cosf(xr); CS[(size_t)t * 64 + 32 + j] = __builtin_amdgcn_sinf(xr); } }
#pragma clang loop unroll(disable)
    for (int m = X.gw; m < T; m += X.NGW) { const float* xr = p->in[0] + (size_t)m * DM; f32x4 v[8];
#pragma unroll
        for (int j = 0; j < 8; ++j) v[j] = *(const f32x4*)(xr + 4 * lane + 256 * j);
        const float rs = store_row_rstd(v, XB0 + (size_t)m * DM, lane);
        if (lane == 0) RSTD0[m] = rs;
        unsigned char* xq0 = (unsigned char*)(p->ws + WS_XB1) + (size_t)m * DM;
#pragma unroll
        for (int j = 0; j < 8; ++j) *(unsigned*)(xq0 + 4 * lane + 256 * j) = pg8::q8x4(v[j][0] * QS_X, v[j][1] * QS_X, v[j][2] * QS_X, v[j][3] * QS_X); }
}

__device__ __forceinline__ void phase_latent(const Ctx& X, KP p) {
    const bf16* C = (const bf16*)(p->ws + WS_C); bf16* CQ = (bf16*)(p->ws + WS_CQ); bf16* CKV = (bf16*)(p->ws + WS_CKV);
    const int lane = X.lane;
#pragma clang loop unroll(disable)
    for (int t = X.gw; t < T; t += X.NGW) {
        const v4u a = *(const v4u*)(C + (size_t)t * 1280 + 8 * lane), b = *(const v4u*)(C + (size_t)t * 1280 + 512 + 8 * lane);
        float xa[8] = {bf_lo(a.x), bf_hi(a.x), bf_lo(a.y), bf_hi(a.y), bf_lo(a.z), bf_hi(a.z), bf_lo(a.w), bf_hi(a.w)};
        float xb[8] = {bf_lo(b.x), bf_hi(b.x), bf_lo(b.y), bf_hi(b.y), bf_lo(b.z), bf_hi(b.z), bf_lo(b.w), bf_hi(b.w)};
        float sa = 0.f, sb = 0.f;
#pragma unroll
        for (int j = 0; j < 8; ++j) { sa += xa[j] * xa[j]; sb += xb[j] * xb[j]; }
        const float ra = 1.0f / sqrtf(wave_sum(sa) * (1.0f / 512.f) + EPS), rb = 1.0f / sqrtf(wave_sum(sb) * (1.0f / 512.f) + EPS);
        const f32x4 ga0 = *(const f32x4*)(p->in[4] + 8 * lane), ga1 = *(const f32x4*)(p->in[4] + 8 * lane + 4);
        const f32x4 gb0 = *(const f32x4*)(p->in[5] + 8 * lane), gb1 = *(const f32x4*)(p->in[5] + 8 * lane + 4);
        v4u oa, ob;
        oa.x = pk2(xa[0] * ra * ga0[0], xa[1] * ra * ga0[1]); oa.y = pk2(xa[2] * ra * ga0[2], xa[3] * ra * ga0[3]); oa.z = pk2(xa[4] * ra * ga1[0], xa[5] * ra * ga1[1]); oa.w = pk2(xa[6] * ra * ga1[2], xa[7] * ra * ga1[3]);
        ob.x = pk2(xb[0] * rb * gb0[0], xb[1] * rb * gb0[1]); ob.y = pk2(xb[2] * rb * gb0[2], xb[3] * rb * gb0[3]); ob.z = pk2(xb[4] * rb * gb1[0], xb[5] * rb * gb1[1]); ob.w = pk2(xb[6] * rb * gb1[2], xb[7] * rb * gb1[3]);
        *(v4u*)(CQ + (size_t)t * 512 + 8 * lane) = oa; *(v4u*)(CKV + (size_t)t * 512 + 8 * lane) = ob;
    }
}

__device__ __forceinline__ void phase_knorm(const Ctx& X, KP p) {
    bf16* KV = (bf16*)(p->ws + WS_KV); const bf16* C = (const bf16*)(p->ws + WS_C); const float* CS = (const float*)(p->ws + WS_CS); const float* gain = p->in[9];
    const int lane = X.lane, hd = lane >> 2, q = lane & 3;
    float gk[32], g1[8], g2[8];
#pragma unroll
    for (int i = 0; i < 32; ++i) gk[i] = gain[32 * q + i];
#pragma unroll
    for (int i = 0; i < 8; ++i) { g1[i] = gain[128 + 8 * q + i]; g2[i] = gain[160 + 8 * q + i]; }
#pragma clang loop unroll(disable)
    for (int t = X.gw; t < T; t += X.NGW) {
        bf16* kp = KV + (size_t)t * 5120 + hd * 320 + 32 * q;
        float kx[32], r1[8], r2[8];
#pragma unroll
        for (int i = 0; i < 4; ++i) { float v[8]; ld8(kp + 8 * i, v);
#pragma unroll
            for (int e = 0; e < 8; ++e) kx[8 * i + e] = v[e]; }
        ld8(C + (size_t)t * 1280 + 1024 + 8 * q, r1); ld8(C + (size_t)t * 1280 + 1056 + 8 * q, r2);
        float ss = 0.f;
#pragma unroll
        for (int i = 0; i < 32; ++i) ss += kx[i] * kx[i];
#pragma unroll
        for (int i = 0; i < 8; ++i) ss += r1[i] * r1[i] + r2[i] * r2[i];
        ss += __int_as_float(__builtin_amdgcn_ds_swizzle(__float_as_int(ss), SWZ_XOR(1))); ss += __int_as_float(__builtin_amdgcn_ds_swizzle(__float_as_int(ss), SWZ_XOR(2)));
        const float rstd = 1.0f / sqrtf(ss * (1.0f / 192.f) + EPS);
#pragma unroll
        for (int i = 0; i < 4; ++i) { v4u w;
            w.x = pk2(kx[8 * i] * rstd * gk[8 * i], kx[8 * i + 1] * rstd * gk[8 * i + 1]); w.y = pk2(kx[8 * i + 2] * rstd * gk[8 * i + 2], kx[8 * i + 3] * rstd * gk[8 * i + 3]);
            w.z = pk2(kx[8 * i + 4] * rstd * gk[8 * i + 4], kx[8 * i + 5] * rstd * gk[8 * i + 5]); w.w = pk2(kx[8 * i + 6] * rstd * gk[8 * i + 6], kx[8 * i + 7] * rstd * gk[8 * i + 7]);
            *(v4u*)(kp + 8 * i) = w; }
        const float* cs = CS + (size_t)t * 64 + 8 * q;
        const f32x4 c0 = *(const f32x4*)cs, c1 = *(const f32x4*)(cs + 4), s0 = *(const f32x4*)(cs + 32), s1 = *(const f32x4*)(cs + 36);
        float o1[8], o2[8];
#pragma unroll
        for (int e = 0; e < 8; ++e) { const float n1 = r1[e] * rstd * g1[e], n2 = r2[e] * rstd * g2[e], cc = e < 4 ? c0[e & 3] : c1[e & 3], sn = e < 4 ? s0[e & 3] : s1[e & 3];
            o1[e] = n1 * cc - n2 * sn; o2[e] = n2 * cc + n1 * sn; }
        v4u w1, w2; w1.x = pk2(o1[0], o1[1]); w1.y = pk2(o1[2], o1[3]); w1.z = pk2(o1[4], o1[5]); w1.w = pk2(o1[6], o1[7]);
        w2.x = pk2(o2[0], o2[1]); w2.y = pk2(o2[2], o2[3]); w2.z = pk2(o2[4], o2[5]); w2.w = pk2(o2[6], o2[7]);
        bf16* rp = KV + (size_t)t * 5120 + hd * 320 + 128 + 8 * q;
        *(v4u*)rp = w1; *(v4u*)(rp + 32) = w2;
    }
}

__device__ __forceinline__ unsigned dpp_x1(unsigned v) { return (unsigned)__builtin_amdgcn_mov_dpp((int)v, 0xB1, 0xF, 0xF, true); }
__device__ __forceinline__ unsigned dpp_x2(unsigned v) { return (unsigned)__builtin_amdgcn_mov_dpp((int)v, 0x4E, 0xF, 0xF, true); }
__device__ __forceinline__ void quad_tr(unsigned (&a)[4], int lane) {
    const bool o1 = lane & 1, o2 = lane & 2;
    unsigned b[4];
#pragma unroll
    for (int m = 0; m < 2; ++m) { const unsigned r = dpp_x1(o1 ? a[2 * m] : a[2 * m + 1]); b[2 * m] = o1 ? r : a[2 * m]; b[2 * m + 1] = o1 ? a[2 * m + 1] : r; }
#pragma unroll
    for (int j = 0; j < 2; ++j) { const unsigned r = dpp_x2(o2 ? b[j] : b[2 + j]); a[j] = o2 ? r : b[j]; a[2 + j] = o2 ? b[2 + j] : r; }
}
__device__ __forceinline__ void pair_tr(v2u& a0, v2u& a1, int lane) {
    const bool o1 = lane & 1; v2u s = o1 ? a0 : a1, r; r.x = dpp_x1(s.x); r.y = dpp_x1(s.y);
    if (o1) a0 = r; else a1 = r;
}
template <bool FINAL>
__device__ __forceinline__ void phase_combine(const Ctx& X, KP p, const bf16* __restrict__ xin, bf16* __restrict__ xout, float* __restrict__ rstd, float* __restrict__ outf) {
    const unsigned char* Y = (const unsigned char*)(p->ws + WS_Y); const int* SLOT = (const int*)(p->ws + WS_MISC + MS_SLOT); const float* TOKW = (const float*)(p->ws + WS_MISC + MS_TOKW);
    const int lane = X.lane;
    const int xo = 256 * (lane & 1) + 8 * (lane >> 1), yo = 256 * (lane & 3) + 16 * (lane >> 2);
#pragma clang loop unroll(disable)
    for (int m = X.gw; m < T; m += X.NGW) {
        const int s0 = (int)__hip_atomic_load((const unsigned*)SLOT + 2 * m, RLX_AGENT), s1 = (int)__hip_atomic_load((const unsigned*)SLOT + 2 * m + 1, RLX_AGENT);
        const float w0 = __uint_as_float(__hip_atomic_load((const unsigned*)TOKW + 2 * m, RLX_AGENT)), w1 = __uint_as_float(__hip_atomic_load((const unsigned*)TOKW + 2 * m + 1, RLX_AGENT));
        const bf16* xr = xin + (size_t)m * DM; const unsigned char* y0 = Y + (size_t)s0 * DM, * y1 = Y + (size_t)s1 * DM; f32x4 v[8];
        const float u0 = w0 * (1.0f / QS_Y), u1 = w1 * (1.0f / QS_Y);
        v4u xw[4], ya[2], yb[2];
#pragma unroll
        for (int g = 0; g < 4; ++g) xw[g] = *(const v4u*)(xr + 512 * g + xo);
#pragma unroll
        for (int g = 0; g < 2; ++g) { ya[g] = *(const v4u*)(y0 + 1024 * g + yo); yb[g] = *(const v4u*)(y1 + 1024 * g + yo); }
#pragma unroll
        for (int g = 0; g < 2; ++g) { unsigned a[4] = {ya[g].x, ya[g].y, ya[g].z, ya[g].w}, b[4] = {yb[g].x, yb[g].y, yb[g].z, yb[g].w}; quad_tr(a, lane); quad_tr(b, lane);
#pragma unroll
            for (int k = 0; k < 4; ++k) { const int j = 4 * g + k; v2u lo, hi; lo.x = xw[j >> 1].x; lo.y = xw[j >> 1].y; hi.x = xw[j >> 1].z; hi.y = xw[j >> 1].w;
                if ((k & 1) == 0) { pair_tr(lo, hi, lane); xw[j >> 1].x = lo.x; xw[j >> 1].y = lo.y; xw[j >> 1].z = hi.x; xw[j >> 1].w = hi.y; }
                v2u xv; xv.x = (k & 1) ? xw[j >> 1].z : xw[j >> 1].x; xv.y = (k & 1) ? xw[j >> 1].w : xw[j >> 1].y;
                const int aa = (int)a[k], bb = (int)b[k];
                f32x4 q;
                q[0] = bf_lo(xv.x) + (u0 * (float)((aa << 24) >> 24) + u1 * (float)((bb << 24) >> 24)); q[1] = bf_hi(xv.x) + (u0 * (float)((aa << 16) >> 24) + u1 * (float)((bb << 16) >> 24));
                q[2] = bf_lo(xv.y) + (u0 * (float)((aa << 8) >> 24) + u1 * (float)((bb << 8) >> 24)); q[3] = bf_hi(xv.y) + (u0 * (float)(aa >> 24) + u1 * (float)(bb >> 24));
                v[j] = q; if (FINAL) *(f32x4*)(outf + (size_t)m * DM + 4 * lane + 256 * j) = q; } }
        if (!FINAL) { const float rs = store_row_rstd(v, xout + (size_t)m * DM, lane); if (lane == 0) rstd[m] = rs; }
    }
}

__device__ __forceinline__ void phase_pool(const Ctx& X, KP p) {
    const bf16* U = (const bf16*)(p->ws + WS_UU); bf16* PM = (bf16*)(p->ws + WS_Y2); const float* scl = p->in[13];
    const int gt = X.vcu * (NWAVES * 64) + X.tid, NGT = X.G * NWAVES * 64;
#pragma clang loop unroll(disable)
    for (int task = gt; task < (T / 32) * 256; task += NGT) {
        const int run = task >> 8, cc = task & 255, col = cc * 8, w = 2 << (col >> 9);
        const int t0 = run * 32, s0 = t0 & (SEQ - 1);
        const f32x4 sc0 = *(const f32x4*)(scl + col), sc1 = *(const f32x4*)(scl + col + 4);
        float sum[8];
#pragma unroll
        for (int e = 0; e < 8; ++e) sum[e] = 0.f;
        { v4u wu[16];
#pragma unroll
          for (int j = 0; j < 16; ++j) { const int i = s0 - 1 - j; const bool ok = (j < w) && (i >= 0); wu[j] = *(const v4u*)(U + (size_t)(ok ? t0 - s0 + i : t0) * DM + col); }
#pragma unroll
          for (int j = 0; j < 16; ++j) { const int i = s0 - 1 - j; const bool ok = (j < w) && (i >= 0);
              if (ok) { sum[0] += bf_lo(wu[j].x); sum[1] += bf_hi(wu[j].x); sum[2] += bf_lo(wu[j].y); sum[3] += bf_hi(wu[j].y); sum[4] += bf_lo(wu[j].z); sum[5] += bf_hi(wu[j].z); sum[6] += bf_lo(wu[j].w); sum[7] += bf_hi(wu[j].w); } } }
#pragma clang loop unroll(disable)
        for (int kb = 0; kb < 32; kb += 8) {
            v4u cur[8], old_[8];
#pragma unroll
            for (int j = 0; j < 8; ++j) { const int t = t0 + kb + j, s = s0 + kb + j; cur[j] = *(const v4u*)(U + (size_t)t * DM + col);
                old_[j] = *(const v4u*)(U + (size_t)(s >= w ? t - w : t) * DM + col); }
#pragma unroll
            for (int j = 0; j < 8; ++j) { const int t = t0 + kb + j, s = s0 + kb + j; float v[8], o[8];
                v[0] = bf_lo(cur[j].x); v[1] = bf_hi(cur[j].x); v[2] = bf_lo(cur[j].y); v[3] = bf_hi(cur[j].y); v[4] = bf_lo(cur[j].z); v[5] = bf_hi(cur[j].z); v[6] = bf_lo(cur[j].w); v[7] = bf_hi(cur[j].w);
                o[0] = bf_lo(old_[j].x); o[1] = bf_hi(old_[j].x); o[2] = bf_lo(old_[j].y); o[3] = bf_hi(old_[j].y); o[4] = bf_lo(old_[j].z); o[5] = bf_hi(old_[j].z); o[6] = bf_lo(old_[j].w); o[7] = bf_hi(old_[j].w);
#pragma unroll
                for (int e = 0; e < 8; ++e) sum[e] += v[e];
                if (s >= w) {
#pragma unroll
                    for (int e = 0; e < 8; ++e) sum[e] -= o[e]; }
                const float ic = 1.0f / (float)(s + 1 < w ? s + 1 : w);
                v4u r; r.x = pk2((sum[0] * ic - v[0]) * sc0[0], (sum[1] * ic - v[1]) * sc0[1]); r.y = pk2((sum[2] * ic - v[2]) * sc0[2], (sum[3] * ic - v[3]) * sc0[3]);
                r.z = pk2((sum[4] * ic - v[4]) * sc1[0], (sum[5] * ic - v[5]) * sc1[1]); r.w = pk2((sum[6] * ic - v[6]) * sc1[2], (sum[7] * ic - v[7]) * sc1[3]);
                *(v4u*)(PM + (size_t)t * DM + col) = r; } }
    }
}

__device__ __forceinline__ void phase_route(const Ctx& X, KP p, int layer) {
    const float* LOG = (const float*)(p->ws + WS_LOG); const float* LOG1 = (const float*)(p->ws + WS_LOG1); unsigned* TOKE = (unsigned*)(p->ws + WS_MISC + MS_TOKE); float* TOKW = (float*)(p->ws + WS_MISC + MS_TOKW);
    unsigned* BC = (unsigned*)(p->ws + WS_MISC + MS_BC);
    const float* brg = p->in[17] + layer * 8; const float* bre = p->in[19] + layer * 64;
    const float* SSQP = (const float*)(p->ws + WS_SSQP); float* RSTOK = (float*)(p->ws + WS_MISC + MS_RSTOK);
    LAS unsigned* hist = (LAS unsigned*)X.lds;
    { int* STOK = (int*)(p->ws + WS_MISC + MS_STOK); for (int i = X.vcu * (NWAVES * 64) + X.tid; i < PSLOTS; i += X.G * NWAVES * 64) STOK[i] = 0; }
#pragma clang loop unroll(disable)
    for (int ch = X.vcu; ch < 256; ch += X.G) {
        if (X.tid < 64) hist[X.tid] = 0u;
        __syncthreads();
        if (X.tid < 128) {
            const int t = ch * 128 + X.tid; const float* lg = LOG + (size_t)t * 72; const float* lh = LOG1 + (size_t)t * 72;
            float ssq = 0.f;
#pragma unroll
            for (int j = 0; j < 8; ++j) { const f32x4 q = *(const f32x4*)(SSQP + (size_t)t * 32 + 4 * j); ssq += (q[0] + q[1]) + (q[2] + q[3]); }
            const float rstd = 1.0f / sqrtf(ssq * (1.0f / DM) + EPS);
            RSTOK[t] = rstd;
            float g[8]; int gs = 0; float gm;
#pragma unroll
            for (int j = 0; j < 8; ++j) g[j] = (lg[j] + lh[j]) * rstd + brg[j];
            gm = g[0];
#pragma unroll
            for (int j = 1; j < 8; ++j) if (g[j] > gm) { gm = g[j]; gs = j; }
            float den = 0.f;
#pragma unroll
            for (int j = 0; j < 8; ++j) den += expf(g[j] - gm);
            const float psel = 1.0f / den;
            float e[8];
#pragma unroll
            for (int j = 0; j < 8; ++j) e[j] = (lg[8 + gs * 8 + j] + lh[8 + gs * 8 + j]) * rstd + bre[gs * 8 + j];
            int i1 = 0; float m1 = e[0];
#pragma unroll
            for (int j = 1; j < 8; ++j) if (e[j] > m1) { m1 = e[j]; i1 = j; }
            int i2 = -1; float m2 = -3.0e38f;
#pragma unroll
            for (int j = 0; j < 8; ++j) if (j != i1 && e[j] > m2) { m2 = e[j]; i2 = j; }
            const float a2 = expf(m2 - m1), q1 = 1.0f / (1.0f + a2), q2 = a2 / (1.0f + a2);
            const unsigned e1 = (unsigned)(gs * 8 + i1), e2 = (unsigned)(gs * 8 + i2);
            const unsigned r1 = __hip_atomic_fetch_add(&hist[e1], 1u, __ATOMIC_RELAXED, __HIP_MEMORY_SCOPE_WORKGROUP), r2 = __hip_atomic_fetch_add(&hist[e2], 1u, __ATOMIC_RELAXED, __HIP_MEMORY_SCOPE_WORKGROUP);
            TOKE[t] = e1 | (e2 << 8) | (r1 << 16) | (r2 << 24);
            TOKW[2 * t] = psel * q1; TOKW[2 * t + 1] = psel * q2;
        }
        __syncthreads();
        if (X.tid < 64) BC[ch * 64 + X.tid] = hist[X.tid];
        __syncthreads();
    }
}
__device__ __forceinline__ void phase_slots(const Ctx& X, KP p) {
    const unsigned* TOKE = (const unsigned*)(p->ws + WS_MISC + MS_TOKE); int* SLOT = (int*)(p->ws + WS_MISC + MS_SLOT);
    const unsigned* BC = (const unsigned*)(p->ws + WS_MISC + MS_BC); int* TILE = (int*)(p->ws + WS_MISC + MS_TILE);
    const bf16* HN = (const bf16*)(p->ws + WS_XB1); bf16* XS = (bf16*)(p->ws + WS_XS);
    const float* RSTOK = (const float*)(p->ws + WS_MISC + MS_RSTOK); float* RSSLOT = (float*)(p->ws + WS_MISC + MS_RSSLOT); int* STOK = (int*)(p->ws + WS_MISC + MS_STOK);
    LAS unsigned* part = (LAS unsigned*)X.lds;
    LAS unsigned* pstart = part + 512;
    LAS unsigned* cbase = pstart + 64;
    LAS int* slots = (LAS int*)(cbase + 64);
    { const int e = X.tid & 63, g = X.tid >> 6; unsigned s = 0u;
#pragma unroll
      for (int i = 0; i < 32; ++i) s += BC[(32 * g + i) * 64 + e];
      part[g * 64 + e] = s; }
    __syncthreads();
    if (X.tid < 64) { const int e = X.tid; unsigned tot = 0u;
#pragma unroll
        for (int g = 0; g < 8; ++g) tot += part[g * 64 + e];
        const unsigned ntile = (tot + 255u) >> 8;
        cbase[e] = ntile;
        __builtin_amdgcn_fence(__ATOMIC_RELEASE, "workgroup"); __builtin_amdgcn_wave_barrier(); __builtin_amdgcn_fence(__ATOMIC_ACQUIRE, "workgroup");
        unsigned excl = 0u;
#pragma unroll
        for (int j = 0; j < 64; ++j) { const unsigned v = cbase[j]; excl += (j < e) ? v : 0u; }
        pstart[e] = excl << 8;
        { LAS int* LT = (LAS int*)(X.lds + LDS_TILE_OFF); for (unsigned k = 0; k < ntile; ++k) if (excl + k < 320u) LT[64 + excl + k] = e; if (e == 63) LT[0] = (int)(excl + ntile); }
        if (blockIdx.x == 0) { for (unsigned k = 0; k < ntile; ++k) TILE[64 + excl + k] = e; if (e == 63) TILE[0] = (int)(excl + ntile); } }
    __syncthreads();
#pragma clang loop unroll(disable)
    for (int ch = X.vcu; ch < 256; ch += X.G) {
        if (X.tid < 64) { const int e = X.tid, g = ch >> 5; unsigned s = 0u;
            for (int gg = 0; gg < g; ++gg) s += part[gg * 64 + e];
#pragma unroll
            for (int i = 0; i < 31; ++i) { const int c = 32 * g + i; const unsigned v = BC[(c < ch ? c : 32 * g) * 64 + e]; s += (c < ch) ? v : 0u; }
            cbase[e] = s; }
        __syncthreads();
        if (X.tid < 128) { const int t = ch * 128 + X.tid; const unsigned te = TOKE[t];
            const unsigned e1 = te & 255u, e2 = (te >> 8) & 255u, r1 = (te >> 16) & 255u, r2 = te >> 24;
            const int s1 = (int)(pstart[e1] + cbase[e1] + r1), s2 = (int)(pstart[e2] + cbase[e2] + r2);
            SLOT[2 * t] = s1; SLOT[2 * t + 1] = s2; slots[2 * X.tid] = s1; slots[2 * X.tid + 1] = s2;
            const float rs = RSTOK[t]; RSSLOT[s1] = rs; RSSLOT[s2] = rs; STOK[s1] = t; STOK[s2] = t; }
        __syncthreads();
        __syncthreads();
    }
}

struct MoeOrder {
    LAS const int* tile; int ntile, nN, G, c; size_t bstride;
    __device__ void init(LAS const int* tile_, int nN_, int G_, int c_, size_t bstride_) { tile = tile_; nN = nN_; G = G_; c = c_; bstride = bstride_;
        ntile = tile_[0]; ntile = ntile < 320 ? ntile : 320; }
    __device__ bool next(int i, pg8::Unit& u) const {
        const long L = (long)i * G + c; if (L >= (long)ntile * nN) return false;
        u.pm = (int)(L / nN); u.pn = (int)(L % nN); u.aux = tile[64 + u.pm] & 63; return true;
    }
    __device__ __forceinline__ const char* abase(const pg8::Gemm& g, const pg8::Unit& u) const { return (const char*)g.A + (size_t)u.pm * 256 * g.lda * 2; }
    __device__ __forceinline__ const char* bbase(const pg8::Gemm& g, const pg8::Unit& u) const { return (const char*)g.Bt + (size_t)u.aux * bstride + (size_t)u.pn * 256 * g.K * 2; }
};
struct RouterOrder {
    int G, c;
    __device__ bool next(int i, pg8::Unit& u) const { const int L = i * G + c; if (L >= 256) return false; u.pm = L >> 1; u.pn = 0; u.aux = L & 1; return true; }
    __device__ __forceinline__ const char* abase(const pg8::Gemm& g, const pg8::Unit& u) const { return (const char*)g.A + (size_t)u.pm * 256 * g.lda * 2 + (size_t)u.aux * g.K * 2; }
    __device__ __forceinline__ const char* bbase(const pg8::Gemm& g, const pg8::Unit& u) const { return (const char*)g.Bt + (size_t)u.aux * g.K * 2; }
};
struct ProdOrder {
    int bx, G;
    __device__ bool next(int i, pg8::Unit& u) const { const int c = (bx + G - (128 % G)) % G, L = i * G + c; if (L >= 64) return false; u.pm = L >> 3; u.pn = L & 7; u.aux = 0; return true; }
    __device__ __forceinline__ const char* abase(const pg8::Gemm& g, const pg8::Unit& u) const { return (const char*)g.A + (size_t)u.pm * 256 * g.lda * 2; }
    __device__ __forceinline__ const char* bbase(const pg8::Gemm& g, const pg8::Unit& u) const { return (const char*)g.Bt + (size_t)u.pn * 256 * g.ldb * 2 + (size_t)(u.pm >> 1) * 512 * 2; }
};
struct Col4Order {
    int bx, G;
    __device__ bool next(int i, pg8::Unit& u) const { const int L = i * G + bx; if (L >= 128) return false; u.pm = L; u.pn = 4; u.aux = 0; return true; }
    __device__ __forceinline__ const char* abase(const pg8::Gemm& g, const pg8::Unit& u) const { return (const char*)g.A + (size_t)u.pm * 256 * g.lda * 2; }
    __device__ __forceinline__ const char* bbase(const pg8::Gemm& g, const pg8::Unit& u) const { return (const char*)g.Bt + (size_t)u.pn * 256 * g.ldb * 2; }
};
struct GroupOrder {
    pg8::StaticOrder so;
    __device__ bool next(int i, pg8::Unit& u) const { return so.next(i, u); }
    __device__ __forceinline__ const char* abase(const pg8::Gemm& g, const pg8::Unit& u) const { return (const char*)g.A + (size_t)u.pm * 256 * g.lda * 2 + (size_t)(u.pn >> 1) * 512 * 2; }
    __device__ __forceinline__ const char* bbase(const pg8::Gemm& g, const pg8::Unit& u) const { return (const char*)g.Bt + (size_t)u.pn * 256 * g.K * 2; }
};

constexpr int RING_BYTES = 131072, MISC_OFF = RING_BYTES, LDS_BYTES = 147456;
__global__ void __launch_bounds__(NWAVES * 64, 2) mk_fwd(Params p_unused) {
    extern __shared__ __attribute__((aligned(16))) unsigned char lds_raw[];
    LAS unsigned char* const lds0 = (LAS unsigned char*)lds_raw;
    volatile LAS unsigned* MISC = (volatile LAS unsigned*)(lds0 + MISC_OFF);
    for (int u = threadIdx.x; u < (LDS_BYTES - MISC_OFF) / 4; u += NWAVES * 64) ((LAS unsigned*)(lds0 + MISC_OFF))[u] = 0u;
    __syncthreads();
    XcdBarrier bar; int lo, hi;
    { KP k = kargs(); lo = k->ph_lo; hi = k->ph_hi; unsigned* bw = (unsigned*)(k->ws + WS_CTL) + CW_BAR;
      bar.bar = bw; bar.x = 0; bar.st = nullptr;
      if (!MK_MULTI) bar = xcd_barrier_post(bw, MISC + 8); }
#define IN(k_) (lo <= (k_) && (k_) < hi)
#define SEAM(k_) do { if (IN(k_) && IN((k_) + 1)) xcd_barrier(bar); } while (0)
#define PH_BEGIN KP k = kargs(); const Ctx X = make_ctx(lds0); unsigned char* ws = k->ws; const int G = X.G, bx = X.bx, vcu = X.vcu; (void)ws; (void)G; (void)bx; (void)vcu;
#ifdef PROBE_ATT
#define PROBE_ATT_BODY xcd_barrier(bar); if (bx == 0 && threadIdx.x < 8) __hip_atomic_store(ctl + CW_ATTQ + 64 * threadIdx.x, 0u, __ATOMIC_RELAXED, __HIP_MEMORY_SCOPE_AGENT); xcd_barrier(bar); \
    att::attn_phase(X.lds, (const bf16*)(ws + WS_Q), (const bf16*)(ws + WS_KV), (bf16*)(ws + WS_O), k->in[8], (const float*)(ws + WS_CS), ctl + CW_ATTQ, (int)(xb_xcc_id() & 7u));
#else
#define PROBE_ATT_BODY
#endif
#ifndef PROBE_REP
#define PROBE_REP 0u
#endif
#define PHASE(k_, ...) do { if (IN(k_)) { { PH_BEGIN __VA_ARGS__ } if ((PROBE_REP >> (k_)) & 1u) { xcd_barrier(bar); { PH_BEGIN __VA_ARGS__ } } } } while (0)

    PHASE(0, phase_prologue(X, k);); SEAM(0);
    PHASE(1, pg8::Gemm g{(const bf16*)(ws + WS_XB1), (const bf16*)(ws + WS_WIN), 1024, 1024, 1024, nullptr}; pg8::StaticOrder S; S.init(T, 1024, G, bx);
        typedef pg8::EpiBf16<pg8::i32x4, false, true, false, true, true, true, 4> EC; EC E{(bf16*)(ws + WS_C), 1280, 256, 128, nullptr, (const float*)(ws + WS_MISC + MS_RSTD0), nullptr, 0, 20, (float*)(ws + WS_SSQC), 1.0f / (QS_X * QS_WIN), (unsigned char*)(ws + WS_CQ8), 1280, QS_C, 4}; pg8::gemm_phase<EC, pg8::StaticOrder, false, true>(X.lds, g, S, E);
        { Col4Order S4; S4.bx = bx; S4.G = G;
          typedef pg8::EpiBf16<pg8::i32x4, false, true, false, true, false, true, -1, true> EC4; EC4 E4{(bf16*)(ws + WS_C), 1280, 256, 128, nullptr, (const float*)(ws + WS_MISC + MS_RSTD0), nullptr, 0, 20, (float*)(ws + WS_SSQC), 1.0f / (QS_X * QS_WIN), nullptr, 0, 0.f, -1};
          pg8::gemm_phase<EC4, Col4Order, false, true>(X.lds, g, S4, E4); }
        { pg8::Gemm g2{(const bf16*)(ws + WS_WG), (const bf16*)(ws + WS_PWIN), 512, 512, 2048, nullptr}; ProdOrder S2; S2.bx = bx; S2.G = G;
          typedef pg8::EpiBf16<pg8::f32x4, true> EP; EP E2{(bf16*)(ws + WS_WPT), 2048, 256, 128, k->in[2] + 2048, nullptr, nullptr, 0, 0, nullptr, 1.f, nullptr, 0, 0.f, -1}; pg8::gemm_phase(X.lds, g2, S2, E2); }); SEAM(1);
    PHASE(2,
        { pg8::Gemm g{(const bf16*)(ws + WS_CQ8), (const bf16*)(ws + WS_WQ), 256, 640, 256, nullptr}; pg8::StaticOrder S; S.init(T, 3072, G, bx);
          typedef pg8::EpiBf16<pg8::i32x4, false, false, true, false, true, false> EQ; EQ E{(bf16*)(ws + WS_Q), 3072, 256, 128, nullptr, nullptr, (const float*)(ws + WS_SSQC), 0, 20, nullptr, 1.0f / (QS_C * QS_WQK), (unsigned char*)(ws + WS_Q), 3072, QS_Q, 9999}; pg8::gemm_phase<EQ, pg8::StaticOrder, false, true>(X.lds, g, S, E); }
        { if (threadIdx.x < 48) ((LAS f32x4*)(X.lds + pg8::STAGE_BYTES + 4096 + 6144))[threadIdx.x] = *(const f32x4*)(k->in[9] + 4 * threadIdx.x);
          __syncthreads();
          pg8::Gemm g{(const bf16*)(ws + WS_CQ8) + 256, (const bf16*)(ws + WS_WKV), 256, 640, 256, nullptr}; pg8::StaticOrder S; S.init(T, 4096, G, bx);
          pg8::EpiKV<pg8::i32x4> E{(bf16*)(ws + WS_KV), (const float*)(ws + WS_SSQC), (const bf16*)(ws + WS_C), (const float*)(ws + WS_CS), k->in[9], X.lds + pg8::STAGE_BYTES + 4096, 0, 1.0f / (QS_C * QS_WQK)}; pg8::gemm_phase<pg8::EpiKV<pg8::i32x4>, pg8::StaticOrder, false, true>(X.lds, g, S, E); }); SEAM(2);
    PHASE(3, unsigned* ctl = (unsigned*)(ws + WS_CTL);
        if ((vcu & 31) >= 32 - NCONV) moe_convert_drain(k, ctl + CW_CONVQ, X.lane);
        att::attn_phase(X.lds, (const bf16*)(ws + WS_Q), (const bf16*)(ws + WS_KV), (bf16*)(ws + WS_O), k->in[8], (const float*)(ws + WS_CS), ctl + CW_ATTQ, (int)(xb_xcc_id() & 7u));
        { int ln = threadIdx.x; asm volatile("" : "+v"(ln)); moe_convert_drain(k, ctl + CW_CONVQ, ln & 63); }
        PROBE_ATT_BODY); SEAM(3);
    PHASE(4, pg8::Gemm g{(const bf16*)(ws + WS_O), (const bf16*)(ws + WS_WO), 1024, 1024, 1024, nullptr}; pg8::StaticOrder S; S.init(T, 2048, G, bx);
        pg8::EpiResBf16<pg8::i32x4> E{(const bf16*)(ws + WS_XB0), (bf16*)(ws + WS_XB1), 2048, (float*)(ws + WS_SSQP), k->in[15], (unsigned char*)(ws + WS_XQ), QS_A, 1.0f / QS_WIN}; pg8::gemm_phase<pg8::EpiResBf16<pg8::i32x4>, pg8::StaticOrder, false, true>(X.lds, g, S, E);); SEAM(4);
#define MOE_BLOCK(mb, layer) \
    PHASE(mb, pg8::Gemm g{(const bf16*)(ws + WS_XB1), (const bf16*)(ws + WS_RW) + (size_t)(layer) * 256 * 2048, 1024, 2048, 2048, nullptr}; RouterOrder S; S.G = G; S.c = vcu; \
        pg8::EpiLogits E{(float*)(ws + WS_LOG), 72, 72, (size_t)(WS_LOG1 - WS_LOG) / 4}; pg8::gemm_phase(X.lds, g, S, E);); SEAM(mb); \
    PHASE(mb + 1, phase_route(X, k, layer);); SEAM(mb + 1); \
    PHASE(mb + 2, phase_slots(X, k);); SEAM(mb + 2); \
    PHASE(mb + 3, pg8::Gemm g{(const bf16*)(ws + WS_XQ), (const bf16*)(ws + WS_GUT) + (size_t)(layer) * 64 * 1024 * 1024, 1024, 1024, 1024, (const int*)(ws + WS_MISC + MS_STOK)}; \
        MoeOrder S; S.init((LAS const int*)(X.lds + LDS_TILE_OFF), 4, G, vcu, (size_t)1024 * 2048); \
        pg8::EpiSwiGLU8 E{(unsigned char*)(ws + WS_H), 512, (const float*)(ws + WS_MISC + MS_RSSLOT), 1.0f / (QS_A * QS_WGU), QS_H}; pg8::gemm_phase<pg8::EpiSwiGLU8, MoeOrder, true, true>(X.lds, g, S, E);); SEAM(mb + 3); \
    PHASE(mb + 4, pg8::Gemm g{(const bf16*)(ws + WS_H), (const bf16*)(ws + WS_DT) + (size_t)(layer) * 64 * 2048 * 256, 256, 256, 256, nullptr}; \
        MoeOrder S; S.init((LAS const int*)(X.lds + LDS_TILE_OFF), 8, G, vcu, (size_t)2048 * 512); \
        pg8::EpiY8 E{(unsigned char*)(ws + WS_Y), 2048, QS_Y / (QS_H * QS_WD)}; pg8::gemm_phase<pg8::EpiY8, MoeOrder, false, true>(X.lds, g, S, E);); SEAM(mb + 4);
    MOE_BLOCK(5, 0)
    PHASE(10, phase_combine<false>(X, k, (const bf16*)(ws + WS_XB1), (bf16*)(ws + WS_XB0), (float*)(ws + WS_MISC + MS_RSTD2), nullptr);); SEAM(10);
    PHASE(11, pg8::Gemm g{(const bf16*)(ws + WS_XB0), (const bf16*)(ws + WS_WPT), 2048, 2048, 2048, nullptr}; pg8::StaticOrder S; S.init(T, 2048, G, bx);
        typedef pg8::EpiBf16<pg8::f32x4, false, true> EU; EU E{(bf16*)(ws + WS_UU), 2048, 256, 128, nullptr, (const float*)(ws + WS_MISC + MS_RSTD2), nullptr, 0, 0, nullptr, 1.f, nullptr, 0, 0.f, -1}; pg8::gemm_phase(X.lds, g, S, E);); SEAM(11);
    PHASE(12, phase_pool(X, k);); SEAM(12);
    PHASE(13, pg8::Gemm g{(const bf16*)(ws + WS_Y2), (const bf16*)(ws + WS_PWO), 2048, 2048, 2048, nullptr}; pg8::StaticOrder S; S.init(T, 2048, G, bx);
        pg8::EpiResBf16<> E{(const bf16*)(ws + WS_XB0), (bf16*)(ws + WS_XB1), 2048, (float*)(ws + WS_SSQP), k->in[15] + 2048, (unsigned char*)(ws + WS_XQ), QS_A, 0.f}; pg8::gemm_phase(X.lds, g, S, E);); SEAM(13);
    MOE_BLOCK(14, 1)
    PHASE(19, phase_combine<true>(X, k, (const bf16*)(ws + WS_XB1), nullptr, nullptr, k->out););
#undef MOE_BLOCK
#undef IN
#undef SEAM
#undef PH_BEGIN
#undef PHASE
}

extern "C" void kernel_launch(void* const* d_in, const int* in_sizes, int n_in, void* d_out, int out_size, void* d_ws, size_t ws_size, hipStream_t stream) {
    static int grid = 0;
    if (grid == 0) {
        if (n_in != 23 || out_size != T * DM || ws_size < WS_END) { fprintf(stderr, "kernel_launch: unexpected shapes (n_in %d out %d ws %zu); nothing launched\n", n_in, out_size, ws_size); grid = -1; return; }
        int dev = 0, cus = 0, per_cu = 0;
        if (hipGetDevice(&dev) != hipSuccess || hipDeviceGetAttribute(&cus, hipDeviceAttributeMultiprocessorCount, dev) != hipSuccess) { grid = -1; return; }
        if (hipFuncSetAttribute((const void*)mk_fwd, hipFuncAttributeMaxDynamicSharedMemorySize, LDS_BYTES) != hipSuccess) { fprintf(stderr, "kernel_launch: hipFuncSetAttribute failed\n"); grid = -1; return; }
        if (hipOccupancyMaxActiveBlocksPerMultiprocessor(&per_cu, (const void*)mk_fwd, NWAVES * 64, LDS_BYTES) != hipSuccess || per_cu < 1) { fprintf(stderr, "kernel_launch: occupancy query reports %d blocks per CU\n", per_cu); }
        (void)hipGetLastError();
        grid = cus;
    }
    if (grid < 0) return;
    if (hipMemsetAsync((char*)d_ws + WS_CTL, 0, CTL_ZERO_BYTES, stream) != hipSuccess) return;
    Params p{};
    for (int i = 0; i < 23; ++i) p.in[i] = (const float*)d_in[i];
    p.out = (float*)d_out; p.ws = (unsigned char*)d_ws;
#if MK_MULTI
    for (int k = 0; k < NPHASE; ++k) { p.ph_lo = k; p.ph_hi = k + 1; hipLaunchKernelGGL(mk_fwd, dim3(grid), dim3(NWAVES * 64), LDS_BYTES, stream, p); }
#else
    p.ph_lo = 0; p.ph_hi = NPHASE;
    hipLaunchKernelGGL(mk_fwd, dim3(grid), dim3(NWAVES * 64), LDS_BYTES, stream, p);
#endif
}
```

```cpp
#include <hip/hip_runtime.h>
#include <cstdio>
#include <cstdint>

namespace pg8 {
#define PG8_LAS __attribute__((address_space(3)))
typedef unsigned short bf16_t;
typedef short bf16x8 __attribute__((ext_vector_type(8)));
typedef float f32x4 __attribute__((ext_vector_type(4)));
typedef unsigned u32x4 __attribute__((ext_vector_type(4)));
typedef int i32x4 __attribute__((ext_vector_type(4)));
template <bool I8> struct AccT { typedef f32x4 type; };
template <> struct AccT<true> { typedef i32x4 type; };
constexpr int BM = 256, BK = 64, HALF = 128, HTB = HALF * BK * 2  , STAGE_BYTES = 8 * HTB, NXCD = 8, WGM = 8;

__host__ __device__ __forceinline__ int lds_byte(int r, int c) { const int st = (r >> 4) * 2 + (c >> 5), rr = r & 15, cc = c & 31, ob = rr * 64 + cc * 2; return st * 1024 + (ob ^ (((ob >> 9) & 1) << 5)); }
__host__ __device__ __forceinline__ void stage_rc(int b, int& R, int& C) { const int st = b / 1024, sb = b % 1024, swz = sb ^ (((sb >> 9) & 1) << 5); R = (st >> 1) * 16 + swz / 64; C = (st & 1) * 32 + (swz % 64) / 2; }
__host__ __device__ __forceinline__ int perm32(int rho) { const int n = rho >> 4, i = rho & 15; return 8 * (i >> 2) + 4 * n + (i & 3); }

struct Unit { int pm, pn, aux; };
struct Gemm { const bf16_t* A; const bf16_t* Bt; int K; int lda; int ldb; const int* rowtab; };

struct StaticOrder {
    int nM, nN, nwg, G, c;
    __device__ void init(int M, int N, int G_, int c_) { nM = M / BM; nN = N / BM; nwg = nM * nN; G = G_; c = c_; }
    __device__ bool next(int i, Unit& u) const {
        const long L = (long)i * G + c; if (L >= nwg) return false;
        int wgid = (int)L; { const int q = nwg / NXCD, r = nwg % NXCD, xcd = wgid % NXCD, off = wgid / NXCD; wgid = (xcd < r ? xcd * (q + 1) : r * (q + 1) + (xcd - r) * q) + off; }
        const int nig = WGM * nN, gid = wgid / nig, fm = gid * WGM, gsz = (nM - fm) < WGM ? (nM - fm) : WGM;
        u.pm = fm + ((wgid % nig) % gsz); u.pn = (wgid % nig) / gsz; u.aux = 0; return true;
    }
    __device__ __forceinline__ const char* abase(const Gemm& g, const Unit& u) const { return (const char*)g.A + (size_t)u.pm * BM * g.lda * 2; }
    __device__ __forceinline__ const char* bbase(const Gemm& g, const Unit& u) const { return (const char*)g.Bt + (size_t)u.pn * BM * g.ldb * 2; }
};

__device__ __forceinline__ unsigned cvt_pk_bf16(float lo, float hi) { unsigned r; asm volatile("v_cvt_pk_bf16_f32 %0, %1, %2" : "=v"(r) : "v"(lo), "v"(hi)); return r; }

__device__ __forceinline__ float lo16(unsigned w) { return __uint_as_float(w << 16); }
__device__ __forceinline__ float hi16(unsigned w) { return __uint_as_float(w & 0xffff0000u); }
__device__ __forceinline__ unsigned q8x4(float a, float b, float c, float d) {
    unsigned w = __builtin_amdgcn_cvt_pk_u8_f32((a + 128.f), 0, 0u); w = __builtin_amdgcn_cvt_pk_u8_f32((b + 128.f), 1, w);
    w = __builtin_amdgcn_cvt_pk_u8_f32((c + 128.f), 2, w); w = __builtin_amdgcn_cvt_pk_u8_f32((d + 128.f), 3, w); return w ^ 0x80808080u; }
template <class A> __device__ __forceinline__ A pin(const A& v) { A t = v; asm volatile("" : "+v"(t) :: "memory"); return t; }
typedef unsigned u32x2v __attribute__((ext_vector_type(2)));
__device__ __forceinline__ void store16_pair(unsigned char* pa, unsigned char* pb, u32x2v xa, u32x2v xb, int fq) {
    auto r0 = __builtin_amdgcn_permlane16_swap(xa.x, xb.x, false, false);
    auto r1 = __builtin_amdgcn_permlane16_swap(xa.y, xb.y, false, false);
    u32x4 w; w.x = r0[0]; w.y = r1[0]; w.z = r0[1]; w.w = r1[1];
    *(u32x4*)((fq & 1) ? pb - 8 : pa) = w;
}
template <class F> __device__ __forceinline__ void rows8(int fq, F f, float (&out)[8]) {
    const unsigned v0 = __float_as_uint(f(2 * fq)), v1 = __float_as_uint(f(2 * fq + 1));
    auto p0 = __builtin_amdgcn_permlane16_swap(v0, v0, false, false); auto p1 = __builtin_amdgcn_permlane16_swap(v1, v1, false, false);
    const unsigned w[4] = {p0[0], p1[0], p0[1], p1[1]};
#pragma unroll
    for (int k = 0; k < 4; ++k) { auto q = __builtin_amdgcn_permlane32_swap(w[k], w[k], false, false); out[k] = __uint_as_float(q[0]); out[4 + k] = __uint_as_float(q[1]); }
}
__device__ __forceinline__ f32x4 tof(const f32x4& v) { return v; }
__device__ __forceinline__ f32x4 tof(const i32x4& v) { return (f32x4){(float)v[0], (float)v[1], (float)v[2], (float)v[3]}; }
template <class ACC = f32x4, bool CS = false, bool RS = false, bool SSQI = false, bool SSQO = false, bool Q8 = false, bool BF = true, int BFPN = -1, bool NH = false>
struct EpiBf16 {   static constexpr bool NHALF = NH;       static constexpr int NSTORE = (Q8 ? 8 : 0) + ((BF && BFPN < 0) ? (NH ? 8 : 16) : 0) + (SSQO ? 2 : 0);
    static constexpr bool PERM = true;
    bf16_t* O; int ldc; int tile_cs; int bj_s; const float* cscale; const float* rscale; const float* ssq_in; int ssq_off; int ssq_ld; float* ssq_out; float dq; unsigned char* q8out; int q8ld; float q8scale; int bf_only_pn;
    __device__ __forceinline__ void operator()(const ACC (&acc)[2][2][4][2], const Unit& u, int wr, int wc, int fr, int fq) const {
        asm volatile("" : "+v"(fr), "+v"(fq));
        const int row0 = u.pm * BM + wr * 64 + fr;
        const int col0 = u.pn * tile_cs + wc * 32 + 8 * fq, lcol0 = u.pn * BM + wc * 32 + 8 * fq;
        f32x4 sv[2][2]; float ssv[8] = {0.f, 0.f, 0.f, 0.f, 0.f, 0.f, 0.f, 0.f}; float rs8[8] = {0.f, 0.f, 0.f, 0.f, 0.f, 0.f, 0.f, 0.f};
        if (RS || SSQI) rows8(fq, [&](int i) -> float { const size_t row = (size_t)(row0 + (i >> 2) * HALF + (i & 3) * 16); float r = RS ? rscale[row] : 1.f;
            if (SSQI) { const f32x4 a = *(const f32x4*)(ssq_in + row * ssq_ld + ssq_off), b = *(const f32x4*)(ssq_in + row * ssq_ld + ssq_off + 4);
                r = __builtin_amdgcn_rsqf(((a[0] + a[1]) + (a[2] + a[3]) + (b[0] + b[1]) + (b[2] + b[3])) * (1.0f / 512.f) + 1e-6f); }
            return r * dq; }, rs8);
#pragma unroll
        for (int bj = 0; bj < (NH ? 1 : 2); ++bj)
#pragma unroll
            for (int n = 0; n < 2; ++n) sv[bj][n] = CS ? *(const f32x4*)(cscale + lcol0 + bj * HALF + 4 * n) : (f32x4){1.f, 1.f, 1.f, 1.f};
#pragma unroll
        for (int ai = 0; ai < 2; ++ai)
#pragma unroll
            for (int m = 0; m < 4; ++m) { const int row = row0 + ai * HALF + m * 16; bf16_t* rowp = O + (size_t)row * ldc + col0;
                const float rs = (RS || SSQI) ? rs8[ai * 4 + m] : dq;
                float ss = 0.f; u32x2v xq8[2];
#pragma unroll
                for (int bj = 0; bj < (NH ? 1 : 2); ++bj) { const f32x4 v0 = tof(pin(acc[ai][bj][m][0])) * sv[bj][0] * rs, v1 = tof(pin(acc[ai][bj][m][1])) * sv[bj][1] * rs;
                    ss += (v0[0] * v0[0] + v0[1] * v0[1]) + (v0[2] * v0[2] + v0[3] * v0[3]) + (v1[0] * v1[0] + v1[1] * v1[1]) + (v1[2] * v1[2] + v1[3] * v1[3]);
                    if (BF && (BFPN < 0 || u.pn == BFPN)) { u32x4 w; w.x = cvt_pk_bf16(v0[0], v0[1]); w.y = cvt_pk_bf16(v0[2], v0[3]); w.z = cvt_pk_bf16(v1[0], v1[1]); w.w = cvt_pk_bf16(v1[2], v1[3]);
                        *(u32x4*)(rowp + bj * bj_s) = w; }
                    if (Q8) { xq8[bj].x = q8x4(v0[0] * q8scale, v0[1] * q8scale, v0[2] * q8scale, v0[3] * q8scale); xq8[bj].y = q8x4(v1[0] * q8scale, v1[1] * q8scale, v1[2] * q8scale, v1[3] * q8scale); } }
                if (Q8) { unsigned char* qp = q8out + (size_t)row * q8ld + col0; store16_pair(qp, qp + bj_s, xq8[0], xq8[1], fq); }
                if (SSQO) {
                    ss += __int_as_float(__builtin_amdgcn_ds_swizzle(__float_as_int(ss), (16 << 10) | 0x1F));
                    { auto rr = __builtin_amdgcn_permlane32_swap(__float_as_uint(ss), __float_as_uint(ss), false, false); ss = __uint_as_float(rr[0]) + __uint_as_float(rr[1]); }
                    ssv[ai * 4 + m] = ss; } }
        if (SSQO) {
#pragma unroll
            for (int j = 0; j < 2; ++j) { const float sv = (fq & 2) ? ((fq & 1) ? ssv[6 + j] : ssv[4 + j]) : ((fq & 1) ? ssv[2 + j] : ssv[j]);
                const int i = 2 * fq + j; ssq_out[(size_t)(row0 + (i >> 2) * HALF + (i & 3) * 16) * ssq_ld + u.pn * 4 + wc] = sv; } }
    }
};
template <class ACC = f32x4>
struct EpiKV {
    static constexpr bool PERM = true; static constexpr int NSTORE = 14;
    bf16_t* KV; const float* ssqc; const bf16_t* C; const float* CS; const float* gk; PG8_LAS unsigned char* xl; mutable int par; float dq;
    __device__ __forceinline__ void operator()(const ACC (&acc)[2][2][4][2], const Unit& u, int wr, int wc, int fr, int fq) const {
        asm volatile("" : "+v"(fr), "+v"(fq));
        PG8_LAS float* P = (PG8_LAS float*)xl;
        PG8_LAS float* RS = P + 1024;
        const int rl0 = wr * 64 + fr, col0 = wc * 32 + 8 * fq;
        const int tid = (wr * 4 + wc) * 64 + fq * 16 + fr;
        f32x4 sa = {0.f, 0.f, 0.f, 0.f}, sb = sa, sr = sa;
        if (wr == 0) { const float* sp = ssqc + ((size_t)u.pm * BM + tid) * 20; sa = *(const f32x4*)(sp + 8); sb = *(const f32x4*)(sp + 12); sr = *(const f32x4*)(sp + 16); }
        PG8_LAS const float* gl = (PG8_LAS const float*)(xl + 6144);
        const f32x4 g0 = *(PG8_LAS const f32x4*)(gl + col0), g1 = *(PG8_LAS const f32x4*)(gl + col0 + 4);
#pragma unroll
        for (int ai = 0; ai < 2; ++ai)
#pragma unroll
            for (int m = 0; m < 4; ++m) {
                const f32x4 k0 = tof(pin(acc[ai][0][m][0])), k1 = tof(pin(acc[ai][0][m][1]));
                float ss = (k0[0] * k0[0] + k0[1] * k0[1]) + (k0[2] * k0[2] + k0[3] * k0[3]) + (k1[0] * k1[0] + k1[1] * k1[1]) + (k1[2] * k1[2] + k1[3] * k1[3]);
                ss += __int_as_float(__builtin_amdgcn_ds_swizzle(__float_as_int(ss), (16 << 10) | 0x1F));
                { auto rr = __builtin_amdgcn_permlane32_swap(__float_as_uint(ss), __float_as_uint(ss), false, false); ss = __uint_as_float(rr[0]) + __uint_as_float(rr[1]); }
                if (fq == 0) P[(rl0 + ai * HALF + m * 16) * 4 + wc] = ss; }
        asm volatile("s_waitcnt lgkmcnt(0)" ::: "memory"); __builtin_amdgcn_s_barrier(); asm volatile("" ::: "memory");
        if (wr == 0) { const f32x4 pp = *(const PG8_LAS f32x4*)(P + tid * 4);
            const float rs = dq * __builtin_amdgcn_rsqf(((sa[0] + sa[1]) + (sa[2] + sa[3]) + (sb[0] + sb[1]) + (sb[2] + sb[3])) * (1.0f / 512.f) + 1e-6f);
            const float rkn = __builtin_amdgcn_rsqf((((pp[0] + pp[1]) + (pp[2] + pp[3])) * (rs * rs) + (sr[0] + sr[1]) + (sr[2] + sr[3])) * (1.0f / 192.f) + 1e-6f);
            typedef float f32x2v __attribute__((ext_vector_type(2))); *(PG8_LAS f32x2v*)(RS + 2 * tid) = (f32x2v){rs, rkn}; }
        asm volatile("s_waitcnt lgkmcnt(0)" ::: "memory"); __builtin_amdgcn_s_barrier(); asm volatile("" ::: "memory");
        unsigned char* tb = (unsigned char*)KV + (size_t)u.pm * BM * 8192 + u.pn * 512;
#pragma unroll
        for (int ai = 0; ai < 2; ++ai)
#pragma unroll
            for (int mp = 0; mp < 2; ++mp) { u32x2v wk[2];
#pragma unroll
                for (int mm = 0; mm < 2; ++mm) { const int m = 2 * mp + mm; const int rl = rl0 + ai * HALF + m * 16;
                    typedef float f32x2v __attribute__((ext_vector_type(2))); const f32x2v st = *(const PG8_LAS f32x2v*)(RS + 2 * rl);
                    const float rs = st[0], rk = st[0] * st[1];
                    bf16_t* rowp = (bf16_t*)(tb + (unsigned)rl * 8192u + 256) + col0;
                    const f32x4 k0 = tof(pin(acc[ai][0][m][0])) * rk * g0, k1 = tof(pin(acc[ai][0][m][1])) * rk * g1, v0 = tof(pin(acc[ai][1][m][0])) * rs, v1 = tof(pin(acc[ai][1][m][1])) * rs;
                    wk[mm].x = q8x4(k0[0] * 16.f, k0[1] * 16.f, k0[2] * 16.f, k0[3] * 16.f); wk[mm].y = q8x4(k1[0] * 16.f, k1[1] * 16.f, k1[2] * 16.f, k1[3] * 16.f);
                    u32x4 x; x.x = cvt_pk_bf16(v0[0], v0[1]); x.y = cvt_pk_bf16(v0[2], v0[3]); x.z = cvt_pk_bf16(v1[0], v1[1]); x.w = cvt_pk_bf16(v1[2], v1[3]); *(u32x4*)rowp = x; }
                unsigned char* ka = tb + (unsigned)(rl0 + ai * HALF + 2 * mp * 16) * 8192u + col0;
                store16_pair(ka, ka + 16 * 8192, wk[0], wk[1], fq);
                asm volatile("" ::: "memory"); }
        { const int rl = tid >> 1, j0 = 16 * (tid & 1); const size_t row = (size_t)u.pm * BM + rl;
          const float rk = RS[2 * rl + 1];
          const bf16_t* cr = C + row * 1280 + 1024 + j0; const float* cs = CS + row * 64 + j0; unsigned char* kp = tb + (unsigned)rl * 8192u + 128 + j0;
          u32x2v w1[2], w2[2];
#pragma unroll
          for (int q = 0; q < 2; ++q) { const u32x4 a = *(const u32x4*)(cr + 8 * q), b = *(const u32x4*)(cr + 32 + 8 * q);
              const f32x4 c0 = *(const f32x4*)(cs + 8 * q), c1 = *(const f32x4*)(cs + 8 * q + 4), s0 = *(const f32x4*)(cs + 32 + 8 * q), s1 = *(const f32x4*)(cs + 32 + 8 * q + 4);
              const f32x4 ga0 = *(PG8_LAS const f32x4*)(gl + 128 + j0 + 8 * q), ga1 = *(PG8_LAS const f32x4*)(gl + 128 + j0 + 8 * q + 4), gb0 = *(PG8_LAS const f32x4*)(gl + 160 + j0 + 8 * q), gb1 = *(PG8_LAS const f32x4*)(gl + 160 + j0 + 8 * q + 4);
              const f32x4 x10 = (f32x4){lo16(a.x), hi16(a.x), lo16(a.y), hi16(a.y)} * rk * ga0, x11 = (f32x4){lo16(a.z), hi16(a.z), lo16(a.w), hi16(a.w)} * rk * ga1;
              const f32x4 x20 = (f32x4){lo16(b.x), hi16(b.x), lo16(b.y), hi16(b.y)} * rk * gb0, x21 = (f32x4){lo16(b.z), hi16(b.z), lo16(b.w), hi16(b.w)} * rk * gb1;
              const f32x4 o10 = x10 * c0 - x20 * s0, o11 = x11 * c1 - x21 * s1, o20 = x20 * c0 + x10 * s0, o21 = x21 * c1 + x11 * s1;
              w1[q].x = q8x4(o10[0] * 16.f, o10[1] * 16.f, o10[2] * 16.f, o10[3] * 16.f); w1[q].y = q8x4(o11[0] * 16.f, o11[1] * 16.f, o11[2] * 16.f, o11[3] * 16.f);
              w2[q].x = q8x4(o20[0] * 16.f, o20[1] * 16.f, o20[2] * 16.f, o20[3] * 16.f); w2[q].y = q8x4(o21[0] * 16.f, o21[1] * 16.f, o21[2] * 16.f, o21[3] * 16.f); }
          { u32x4 w; w.x = w1[0].x; w.y = w1[0].y; w.z = w1[1].x; w.w = w1[1].y; *(u32x4*)kp = w; }
          { u32x4 w; w.x = w2[0].x; w.y = w2[0].y; w.z = w2[1].x; w.w = w2[1].y; *(u32x4*)(kp + 32) = w; } }
    }
};
struct EpiSwiGLU8 {   static constexpr int NSTORE = 4;
    static constexpr bool PERM = true;
    unsigned char* O; int ldc; const float* rscale; float dq; float hscale; PG8_LAS const float* rsl; mutable int par;
    __device__ __forceinline__ static float sg(float g, float u) { return g * u * __builtin_amdgcn_rcpf(1.f + __builtin_amdgcn_exp2f(-1.4426950408889634f * g)); }
    __device__ __forceinline__ void operator()(const i32x4 (&acc)[2][2][4][2], const Unit& u, int wr, int wc, int fr, int fq) const {
        asm volatile("" : "+v"(fr), "+v"(fq));
        const int row0 = u.pm * BM + wr * 64 + fr, col0 = u.pn * HALF + wc * 32 + 8 * fq;
        PG8_LAS const float* rl = rsl + (par & 1) * 256; par ^= 1;
        float rs8[8]; rows8(fq, [&](int i) -> float { return rl[wr * 64 + fr + (i >> 2) * HALF + (i & 3) * 16] * dq; }, rs8);
#pragma unroll
        for (int ai = 0; ai < 2; ++ai)
#pragma unroll
            for (int mp = 0; mp < 2; ++mp) { u32x2v w[2];
#pragma unroll
                for (int mm = 0; mm < 2; ++mm) { const int m = 2 * mp + mm; const float rs = rs8[ai * 4 + m]; float h[8];
#pragma unroll
                    for (int n = 0; n < 2; ++n)
#pragma unroll
                        for (int e = 0; e < 4; ++e) h[4 * n + e] = sg((float)acc[ai][0][m][n][e] * rs, (float)acc[ai][1][m][n][e] * rs) * hscale;
                    w[mm].x = q8x4(h[0], h[1], h[2], h[3]); w[mm].y = q8x4(h[4], h[5], h[6], h[7]); }
                unsigned char* pa = O + (size_t)(row0 + ai * HALF + 2 * mp * 16) * ldc + col0;
                store16_pair(pa, pa + (size_t)16 * ldc, w[0], w[1], fq); }
    }
};
struct EpiY8 {   static constexpr int NSTORE = 8;
    static constexpr bool PERM = true;
    unsigned char* O; int ldc; float dq;
    __device__ __forceinline__ void operator()(const i32x4 (&acc)[2][2][4][2], const Unit& u, int wr, int wc, int fr, int fq) const {
        asm volatile("" : "+v"(fr), "+v"(fq));
        const int row0 = u.pm * BM + wr * 64 + fr, col0 = u.pn * BM + wc * 32 + 8 * fq;
#pragma unroll
        for (int ai = 0; ai < 2; ++ai)
#pragma unroll
            for (int m = 0; m < 4; ++m) { unsigned char* rowp = O + (size_t)(row0 + ai * HALF + m * 16) * ldc + col0;
                u32x2v w[2];
#pragma unroll
                for (int bj = 0; bj < 2; ++bj) { const i32x4 a0 = acc[ai][bj][m][0], a1 = acc[ai][bj][m][1];
                    w[bj].x = q8x4((float)a0[0] * dq, (float)a0[1] * dq, (float)a0[2] * dq, (float)a0[3] * dq); w[bj].y = q8x4((float)a1[0] * dq, (float)a1[1] * dq, (float)a1[2] * dq, (float)a1[3] * dq); }
                store16_pair(rowp, rowp + HALF, w[0], w[1], fq); }
    }
};
struct EpiSwiGLU {
    static constexpr bool PERM = true;
    bf16_t* O; int ldc; const float* rscale;
    __device__ __forceinline__ static float sg(float g, float u) { return g * u * __builtin_amdgcn_rcpf(1.f + __builtin_amdgcn_exp2f(-1.4426950408889634f * g)); }
    __device__ __forceinline__ void operator()(const f32x4 (&acc)[2][2][4][2], const Unit& u, int wr, int wc, int fr, int fq) const {
        asm volatile("" : "+v"(fr), "+v"(fq));
        const int row0 = u.pm * BM + wr * 64 + fr, col0 = u.pn * HALF + wc * 32 + 8 * fq;
#pragma unroll
        for (int ai = 0; ai < 2; ++ai)
#pragma unroll
            for (int m = 0; m < 4; ++m) { const int row = row0 + ai * HALF + m * 16; bf16_t* rowp = O + (size_t)row * ldc + col0; const float rs = rscale[row];
                const f32x4 g0 = acc[ai][0][m][0] * rs, g1 = acc[ai][0][m][1] * rs, u0 = acc[ai][1][m][0] * rs, u1 = acc[ai][1][m][1] * rs;
                u32x4 w; w.x = cvt_pk_bf16(sg(g0[0], u0[0]), sg(g0[1], u0[1])); w.y = cvt_pk_bf16(sg(g0[2], u0[2]), sg(g0[3], u0[3]));
                w.z = cvt_pk_bf16(sg(g1[0], u1[0]), sg(g1[1], u1[1])); w.w = cvt_pk_bf16(sg(g1[2], u1[2]), sg(g1[3], u1[3]));
                *(u32x4*)rowp = w; }
    }
};
constexpr float QS_O = 96.f;
__device__ __forceinline__ float o_row_scale(int row) { return QS_O * sqrtf((float)(((row & 4095) >> 6) + 1)); }
template <class ACC = f32x4>
struct EpiResBf16 {
    static constexpr bool PERM = true; static constexpr int NSTORE = 26;
    const bf16_t* base; bf16_t* out; int ldc; float* ssqp; const float* qgain; unsigned char* xq; float qscale; float dq;
    __device__ __forceinline__ void operator()(const ACC (&acc)[2][2][4][2], const Unit& u, int wr, int wc, int fr, int fq) const {
        asm volatile("" : "+v"(fr), "+v"(fq));
        const int row0 = u.pm * BM + wr * 64 + fr, col0 = u.pn * BM + wc * 32 + 8 * fq;
        f32x4 gv[2][2]; float ssv[8];
#pragma unroll
        for (int bj = 0; bj < 2; ++bj)
#pragma unroll
            for (int n = 0; n < 2; ++n) gv[bj][n] = *(const f32x4*)(qgain + col0 + bj * HALF + 4 * n) * qscale;
#pragma unroll
        for (int ai = 0; ai < 2; ++ai)
#pragma unroll
            for (int m = 0; m < 4; ++m) { const int row = row0 + ai * HALF + m * 16; const size_t off = (size_t)row * ldc + col0; float ss = 0.f; u32x2v xq8[2];
                const float as = dq > 0.f ? dq * (1.0f / QS_O) * __builtin_amdgcn_rsqf((float)(((row & 4095) >> 6) + 1)) : 1.f;
#pragma unroll
                for (int bj = 0; bj < 2; ++bj) { const u32x4 b = *(const u32x4*)(base + off + bj * HALF);
                    const f32x4 v0 = tof(acc[ai][bj][m][0]) * as + (f32x4){lo16(b.x), hi16(b.x), lo16(b.y), hi16(b.y)}, v1 = tof(acc[ai][bj][m][1]) * as + (f32x4){lo16(b.z), hi16(b.z), lo16(b.w), hi16(b.w)};
                    ss += (v0[0] * v0[0] + v0[1] * v0[1]) + (v0[2] * v0[2] + v0[3] * v0[3]) + (v1[0] * v1[0] + v1[1] * v1[1]) + (v1[2] * v1[2] + v1[3] * v1[3]);
                    u32x4 w; w.x = cvt_pk_bf16(v0[0], v0[1]); w.y = cvt_pk_bf16(v0[2], v0[3]); w.z = cvt_pk_bf16(v1[0], v1[1]); w.w = cvt_pk_bf16(v1[2], v1[3]);
                    *(u32x4*)(out + off + bj * HALF) = w;
                    const f32x4 q0 = v0 * gv[bj][0], q1 = v1 * gv[bj][1];
                    xq8[bj].x = q8x4(q0[0], q0[1], q0[2], q0[3]); xq8[bj].y = q8x4(q1[0], q1[1], q1[2], q1[3]); }
                store16_pair(xq + off, xq + off + HALF, xq8[0], xq8[1], fq);
                ss += __int_as_float(__builtin_amdgcn_ds_swizzle(__float_as_int(ss), (16 << 10) | 0x1F));
                { auto rr = __builtin_amdgcn_permlane32_swap(__float_as_uint(ss), __float_as_uint(ss), false, false); ss = __uint_as_float(rr[0]) + __uint_as_float(rr[1]); }
                ssv[ai * 4 + m] = ss;
                if (m == 3) asm volatile("" ::: "memory"); }
#pragma unroll
        for (int j = 0; j < 2; ++j) { const float sv = (fq & 2) ? ((fq & 1) ? ssv[6 + j] : ssv[4 + j]) : ((fq & 1) ? ssv[2 + j] : ssv[j]);
            const int i = 2 * fq + j; ssqp[(size_t)(row0 + (i >> 2) * HALF + (i & 3) * 16) * 32 + u.pn * 4 + wc] = sv; }
    }
};
struct EpiResF32 {
    static constexpr bool PERM = false;
    const float* base; float* out; int ldc;
    __device__ __forceinline__ void operator()(const f32x4 (&acc)[2][2][4][2], const Unit& u, int wr, int wc, int fr, int fq) const {
        asm volatile("" : "+v"(fr), "+v"(fq));
        const int col0 = u.pn * BM + wc * 32 + 4 * fq;
#pragma unroll
        for (int ai = 0; ai < 2; ++ai)
#pragma unroll
            for (int m = 0; m < 4; ++m) { const size_t off = (size_t)(u.pm * BM + ai * HALF + wr * 64 + m * 16 + fr) * ldc + col0;
#pragma unroll
                for (int bj = 0; bj < 2; ++bj)
#pragma unroll
                    for (int n = 0; n < 2; ++n) { const f32x4 bs = *(const f32x4*)(base + off + bj * HALF + n * 16); *(f32x4*)(out + off + bj * HALF + n * 16) = bs + acc[ai][bj][m][n]; } }
    }
};
struct EpiLogits {   static constexpr bool NHALF = true;
    static constexpr bool PERM = false;
    float* out; int ldc; int ncol; size_t bstride;
    __device__ __forceinline__ void operator()(const f32x4 (&acc)[2][2][4][2], const Unit& u, int wr, int wc, int fr, int fq) const {
        asm volatile("" : "+v"(fr), "+v"(fq));
        const int col0 = wc * 32 + 4 * fq;
        if (wc * 32 >= ncol) return;
#pragma unroll
        for (int ai = 0; ai < 2; ++ai)
#pragma unroll
            for (int m = 0; m < 4; ++m) { const size_t off = (size_t)u.aux * bstride + (size_t)(u.pm * BM + ai * HALF + wr * 64 + m * 16 + fr) * ldc;
#pragma unroll
                for (int n = 0; n < 2; ++n) { const int c = col0 + n * 16; if (c < ncol) *(f32x4*)(out + off + c) = acc[ai][0][m][n]; } }
    }
};

template <class E, class = void> struct EpiHalfN { static constexpr bool v = false; };
template <class E> struct EpiHalfN<E, decltype((void)E::NHALF)> { static constexpr bool v = E::NHALF; };
template <class E, class = void> struct EpiStores { static constexpr int v = 0; };
template <class E> struct EpiStores<E, decltype((void)E::NSTORE)> { static constexpr int v = E::NSTORE; };
template <class Epi, class Sched, bool GATHER = false, bool I8 = false>
__device__ __forceinline__ void gemm_phase(PG8_LAS unsigned char* lds, const Gemm g, const Sched& S, const Epi& E) {
    int tid = threadIdx.x; asm volatile("" : "+v"(tid));
    const int wid = __builtin_amdgcn_readfirstlane(tid >> 6), lane = tid & 63, wr = wid >> 2, wc = wid & 3, fr = lane & 15, fq = lane >> 4;
    const int K = g.K, nt = K / BK, lda = g.lda, ldb = g.ldb;
    unsigned voffA[2], voffB[2]; int gR[2], gC[2];
#pragma unroll
    for (int i = 0; i < 2; ++i) { int R, C; stage_rc(tid * 16 + i * 8192, R, C); const int Rb = Epi::PERM ? ((R & ~31) + perm32(R & 31)) : R; gR[i] = R; gC[i] = C;
        voffA[i] = (unsigned)(R * lda + C) * 2u; voffB[i] = (unsigned)(Rb * ldb + C) * 2u; }
    unsigned cao[2][2], xao[2][2];
    PG8_LAS unsigned* stash = (PG8_LAS unsigned*)(lds + STAGE_BYTES + 4096) + tid;
#define PG8_GOFF(u, ao) do { _Pragma("unroll") for (int h_ = 0; h_ < 2; ++h_) _Pragma("unroll") for (int i_ = 0; i_ < 2; ++i_) { \
        const unsigned row_ = __hip_atomic_load((const unsigned*)g.rowtab + (u).pm * BM + h_ * HALF + gR[i_], __ATOMIC_RELAXED, __HIP_MEMORY_SCOPE_AGENT); \
        ao[h_][i_] = row_ * (unsigned)(lda * 2) + (unsigned)(gC[i_] * 2); } } while (0)
#define PG8_STAGE_A(bufoff, ptr, h, nx, kt) do { if constexpr (GATHER) { _Pragma("unroll") for (int _i = 0; _i < 2; ++_i) { const unsigned o_ = (nx) ? xao[h][_i] : cao[h][_i]; \
        __builtin_amdgcn_global_load_lds((const unsigned*)((const char*)g.A + o_ + (size_t)(kt) * (BK * 2)), (PG8_LAS unsigned*)(lds + (bufoff) + ldsw + _i * 8192), 16, 0, 0); } } \
        else PG8_STAGE(bufoff, ptr, voffA); } while (0)
    const size_t kstep = (size_t)(BK * 2);
    const size_t hstepA = (size_t)HALF * lda * 2, hstepB = (size_t)HALF * ldb * 2;
    const unsigned ldsw = (unsigned)wid * 1024u;
    const int aoff = lds_byte(wr * 64 + fr, fq * 8), boff = lds_byte(wc * 32 + fr, fq * 8);
#define PG8_SA(b, h) (((b) * 2 + (h)) * HTB)
#define PG8_SB(b, h) ((4 + (b) * 2 + (h)) * HTB)
#define PG8_STAGE(bufoff, gbase, voff) do { _Pragma("unroll") for (int _i = 0; _i < 2; ++_i) \
        __builtin_amdgcn_global_load_lds((const unsigned*)((const char*)(gbase) + (voff)[_i]), (PG8_LAS unsigned*)(lds + (bufoff) + ldsw + _i * 8192), 16, 0, 0); } while (0)
#define PG8_LDA(dst, b, h) do { _Pragma("unroll") for (int m = 0; m < 4; ++m) _Pragma("unroll") for (int k = 0; k < 2; ++k) dst[m][k] = *(const PG8_LAS bf16x8*)(lds + PG8_SA(b, h) + aoff + m * 2048 + k * 1024); } while (0)
#define PG8_LDB(dst, b, h) do { _Pragma("unroll") for (int n = 0; n < 2; ++n) _Pragma("unroll") for (int k = 0; k < 2; ++k) dst[n][k] = *(const PG8_LAS bf16x8*)(lds + PG8_SB(b, h) + boff + n * 2048 + k * 1024); } while (0)
#define PG8_MMA(ai, bj, At, Bt) do { __builtin_amdgcn_s_setprio(1); _Pragma("unroll") for (int m = 0; m < 4; ++m) _Pragma("unroll") for (int n = 0; n < 2; ++n) _Pragma("unroll") for (int k = 0; k < 2; ++k) \
        { if constexpr (I8) acc[ai][bj][m][n] = __builtin_bit_cast(acc_t, __builtin_amdgcn_mfma_i32_16x16x64_i8(__builtin_bit_cast(i32x4, Bt[n][k]), __builtin_bit_cast(i32x4, At[m][k]), __builtin_bit_cast(i32x4, acc[ai][bj][m][n]), 0, 0, 0)); \
          else acc[ai][bj][m][n] = __builtin_bit_cast(acc_t, __builtin_amdgcn_mfma_f32_16x16x32_bf16(Bt[n][k], At[m][k], __builtin_bit_cast(f32x4, acc[ai][bj][m][n]), 0, 0, 0)); } __builtin_amdgcn_s_setprio(0); } while (0)
#define PG8_WAIT_V(n) asm volatile("s_waitcnt vmcnt(" #n ")" ::: "memory")
#define PG8_WAIT_L(n) asm volatile("s_waitcnt lgkmcnt(" #n ")" ::: "memory")
#define PG8_WAIT_VE asm volatile("s_waitcnt vmcnt(%0)" :: "n"(8 + EpiStores<Epi>::v) : "memory")
#define PG8_BAR __builtin_amdgcn_s_barrier()
#define PG8_SCHED __builtin_amdgcn_sched_barrier(0)
    Unit cur, nxt; int ui = 0;
    if (!S.next(0, cur)) return;
    typedef typename AccT<I8>::type acc_t;
    acc_t acc[2][2][4][2];
#pragma unroll
    for (int a = 0; a < 2; ++a)
#pragma unroll
        for (int b = 0; b < 2; ++b)
#pragma unroll
            for (int m = 0; m < 4; ++m)
#pragma unroll
                for (int n = 0; n < 2; ++n) acc[a][b][m][n] = __builtin_bit_cast(acc_t, (f32x4){0.f, 0.f, 0.f, 0.f});
    bf16x8 At[4][2], B0[2][2], B1[2][2];
    const char* cA = S.abase(g, cur); const char* cB = S.bbase(g, cur);
    if constexpr (GATHER) { PG8_GOFF(cur, cao); }
    PG8_STAGE(PG8_SB(0, 0), cB, voffB); PG8_STAGE(PG8_SB(0, 1), cB + hstepB, voffB); PG8_STAGE_A(PG8_SA(0, 0), cA, 0, false, 0); PG8_STAGE_A(PG8_SA(0, 1), cA + hstepA, 1, false, 0);
    if (wr == 1) PG8_BAR;
    PG8_WAIT_V(2); PG8_BAR;
    PG8_STAGE(PG8_SB(1, 0), cB + kstep, voffB); PG8_STAGE_A(PG8_SA(1, 0), cA + kstep, 0, false, 1); PG8_STAGE(PG8_SB(1, 1), cB + hstepB + kstep, voffB);
    if constexpr (GATHER || EpiStores<Epi>::v == 0) { PG8_WAIT_V(6); } else { PG8_WAIT_V(0); }
    PG8_BAR;
    for (;;) {
        const bool has_next = S.next(ui + 1, nxt);
        const char* nA = has_next ? S.abase(g, nxt) : cA; const char* nB = has_next ? S.bbase(g, nxt) : cB;
        if constexpr (GATHER) { if (has_next) __builtin_amdgcn_global_load_lds((const unsigned*)g.rowtab + nxt.pm * BM + lane * 4, (PG8_LAS unsigned*)(lds + STAGE_BYTES + 4096), 16, 0, 0); }
        if constexpr (GATHER) __builtin_amdgcn_global_load_lds((const unsigned*)E.rscale + cur.pm * BM + lane * 4, (PG8_LAS unsigned*)(lds + STAGE_BYTES + 4096 + 1024 + (ui & 1) * 1024), 16, 0, 0);
#define PG8_KPAIR(t, last, WAITA) do { \
            const char* a1 = cA + (size_t)((t) + 1) * kstep;                                             \
            const char* a2 = (last) ? nA : cA + (size_t)((t) + 2) * kstep; const char* b2 = (last) ? nB : cB + (size_t)((t) + 2) * kstep;     \
            const char* a3 = a2 + kstep; const char* b3 = b2 + kstep;                                \
            const int k2 = (last) ? 0 : (t) + 2; \
            if constexpr (GATHER) { if (last) { if (has_next) { PG8_LAS const unsigned* sl_ = (PG8_LAS const unsigned*)(lds + STAGE_BYTES + 4096); _Pragma("unroll") for (int h_ = 0; h_ < 2; ++h_) _Pragma("unroll") for (int i_ = 0; i_ < 2; ++i_) xao[h_][i_] = sl_[h_ * HALF + gR[i_]] * (unsigned)(lda * 2) + (unsigned)(gC[i_] * 2); } \
                else { xao[0][0] = cao[0][0]; xao[0][1] = cao[0][1]; xao[1][0] = cao[1][0]; xao[1][1] = cao[1][1]; } } } \
              \
            PG8_LDB(B0, 0, 0); if constexpr (!EpiHalfN<Epi>::v) PG8_LDB(B1, 0, 1); PG8_SCHED; PG8_LDA(At, 0, 0); PG8_STAGE_A(PG8_SA(1, 1), a1 + hstepA, 1, false, (t) + 1); \
            WAITA; PG8_WAIT_L(0); PG8_BAR; PG8_MMA(0, 0, At, B0); if constexpr (!EpiHalfN<Epi>::v) PG8_MMA(0, 1, At, B1); PG8_BAR; PG8_SCHED; \
            PG8_LDA(At, 0, 1); PG8_STAGE(PG8_SB(0, 0), b2, voffB); PG8_STAGE(PG8_SB(0, 1), b2 + hstepB, voffB); PG8_STAGE_A(PG8_SA(0, 0), a2, 0, last, k2); \
            WAITA; PG8_WAIT_L(0); PG8_BAR; PG8_MMA(1, 0, At, B0); if constexpr (!EpiHalfN<Epi>::v) PG8_MMA(1, 1, At, B1); PG8_BAR; PG8_SCHED; \
              \
            PG8_LDB(B0, 1, 0); if constexpr (!EpiHalfN<Epi>::v) PG8_LDB(B1, 1, 1); PG8_SCHED; PG8_LDA(At, 1, 0); PG8_STAGE_A(PG8_SA(0, 1), a2 + hstepA, 1, last, k2); \
            PG8_WAIT_V(8); PG8_WAIT_L(0); PG8_BAR; PG8_MMA(0, 0, At, B0); if constexpr (!EpiHalfN<Epi>::v) PG8_MMA(0, 1, At, B1); PG8_BAR; PG8_SCHED; \
            PG8_LDA(At, 1, 1); PG8_STAGE(PG8_SB(1, 0), b3, voffB); PG8_STAGE(PG8_SB(1, 1), b3 + hstepB, voffB); PG8_STAGE_A(PG8_SA(1, 0), a3, 0, last, k2 + 1); \
            PG8_WAIT_V(8); PG8_WAIT_L(0); PG8_BAR; PG8_MMA(1, 0, At, B0); if constexpr (!EpiHalfN<Epi>::v) PG8_MMA(1, 1, At, B1); PG8_BAR; PG8_SCHED; } while (0)
        if constexpr (GATHER || EpiStores<Epi>::v == 0) { for (int t = 0; t < nt; t += 2) { const bool last = (t == nt - 2); PG8_KPAIR(t, last, PG8_WAIT_V(8)); } }
        else { PG8_KPAIR(0, false, PG8_WAIT_VE);
               for (int t = 2; t < nt; t += 2) { const bool last = (t == nt - 2); PG8_KPAIR(t, last, PG8_WAIT_V(8)); } }
        if (wr == 0) PG8_BAR;
        { int l2 = threadIdx.x; asm volatile("" : "+v"(l2)); E(acc, cur, wr, wc, l2 & 15, (l2 >> 4) & 3); }
        if (!has_next) break;
#pragma unroll
        for (int a = 0; a < 2; ++a)
#pragma unroll
            for (int b = 0; b < 2; ++b)
#pragma unroll
                for (int m = 0; m < 4; ++m)
#pragma unroll
                    for (int n = 0; n < 2; ++n) acc[a][b][m][n] = __builtin_bit_cast(acc_t, (f32x4){0.f, 0.f, 0.f, 0.f});
        cur = nxt; cA = nA; cB = nB; ++ui;
        if constexpr (GATHER) { cao[0][0] = xao[0][0]; cao[0][1] = xao[0][1]; cao[1][0] = xao[1][0]; cao[1][1] = xao[1][1]; }
        if (wr == 1) PG8_BAR;
    }
    PG8_WAIT_V(0);
    PG8_BAR;
#undef PG8_SA
#undef PG8_SB
#undef PG8_STAGE
#undef PG8_STAGE_A
#undef PG8_GOFF
#undef PG8_LDA
#undef PG8_LDB
#undef PG8_MMA
#undef PG8_WAIT_V
#undef PG8_WAIT_L
#undef PG8_WAIT_VE
#undef PG8_KPAIR
#undef PG8_BAR
#undef PG8_SCHED
}
}
namespace att {
#define ATT_LAS __attribute__((address_space(3)))
typedef unsigned short bf16_t;
typedef short bf16x8 __attribute__((ext_vector_type(8)));
typedef short s16x4 __attribute__((ext_vector_type(4)));
typedef float f32x16 __attribute__((ext_vector_type(16)));
typedef unsigned u32x4 __attribute__((ext_vector_type(4)));
typedef unsigned u32x2 __attribute__((ext_vector_type(2)));
constexpr int SEQ = 4096, NHEAD = 16, QPITCH = 3072, KVPITCH = 4096, OPITCH = 2048, HQK = 192, HKV = 256, VOFF = 128, HV = 128;
constexpr int KT_BYTES = 64 * 256, VT_BYTES = 64 * 128 * 2;
constexpr float QK8 = 16.f;
typedef int i32x4 __attribute__((ext_vector_type(4)));
typedef int i32x16 __attribute__((ext_vector_type(16)));
constexpr int SLOT_BYTES = KT_BYTES + VT_BYTES, NSLOT = 4, LDS_BYTES = NSLOT * SLOT_BYTES;
constexpr float THR = 8.f;

typedef __bf16 bf16x2_t __attribute__((ext_vector_type(2)));
typedef float f32x2_t __attribute__((ext_vector_type(2)));
__device__ __forceinline__ unsigned cvtpk(float lo, float hi) { f32x2_t v = {lo, hi}; bf16x2_t r = __builtin_convertvector(v, bf16x2_t); return __builtin_bit_cast(unsigned, r); }
__device__ __forceinline__ bf16x8 pack8(const f32x16& p, int b) {
    u32x4 w = {cvtpk(p[b + 0], p[b + 1]), cvtpk(p[b + 2], p[b + 3]), cvtpk(p[b + 4], p[b + 5]), cvtpk(p[b + 6], p[b + 7])};
    return __builtin_bit_cast(bf16x8, w);
}
typedef float f32x4v __attribute__((ext_vector_type(4)));
__device__ __forceinline__ float bf2f(short s) { return __uint_as_float(((unsigned)(unsigned short)s) << 16); }
__device__ __forceinline__ bf16x8 pack8f(const float (&v)[8]) { u32x4 w = {cvtpk(v[0], v[1]), cvtpk(v[2], v[3]), cvtpk(v[4], v[5]), cvtpk(v[6], v[7])}; return __builtin_bit_cast(bf16x8, w); }
__device__ __forceinline__ i32x4 pack16q(const float (&v)[16]) { i32x4 w;
    w[0] = (int)pg8::q8x4(v[0], v[1], v[2], v[3]); w[1] = (int)pg8::q8x4(v[4], v[5], v[6], v[7]); w[2] = (int)pg8::q8x4(v[8], v[9], v[10], v[11]); w[3] = (int)pg8::q8x4(v[12], v[13], v[14], v[15]); return w; }
__device__ __forceinline__ int xhalf_imax(int v) { auto rr = __builtin_amdgcn_permlane32_swap((unsigned)v, (unsigned)v, false, false); const int a = (int)rr[0], b = (int)rr[1]; return a > b ? a : b; }
__device__ __forceinline__ s16x4 vtr(ATT_LAS const unsigned char* p) {
    typedef short v4i16_t __attribute__((ext_vector_type(4)));
    return __builtin_bit_cast(s16x4, __builtin_amdgcn_ds_read_tr16_b64_v4i16((ATT_LAS v4i16_t*)p));
}
__device__ __forceinline__ float xhalf_max(float v) { auto rr = __builtin_amdgcn_permlane32_swap(__float_as_uint(v), __float_as_uint(v), false, false); return fmaxf(__uint_as_float(rr[0]), __uint_as_float(rr[1])); }
__device__ __forceinline__ float xhalf_sum(float v) { auto rr = __builtin_amdgcn_permlane32_swap(__float_as_uint(v), __float_as_uint(v), false, false); return __uint_as_float(rr[0]) + __uint_as_float(rr[1]); }

__device__ __forceinline__ void attn_unit(ATT_LAS unsigned char* lds, const bf16_t* __restrict__ Q, const bf16_t* __restrict__ KV, bf16_t* __restrict__ O, const float* __restrict__ qn, const float* __restrict__ CS, int b, int h, int qb) {
    int tid = threadIdx.x; asm volatile("" : "+v"(tid));
    const int lane = tid & 63, c = lane & 31, hi = lane >> 5;
    const int wid = __builtin_amdgcn_readfirstlane(tid >> 6);
    const size_t row0 = (size_t)b * SEQ;
    const int q0 = qb * 256;
    const int NT = 4 * qb + 4;
    const int my_nt = 4 * qb + (wid >> 1) + 1;
    const char* kvh = (const char*)(KV + row0 * KVPITCH + h * HKV);
    unsigned koff[2], voff[2];
#pragma unroll
    for (int i = 0; i < 2; ++i) { const int qi = 64 * (wid + 8 * i) + lane, krow = qi >> 4, pos = qi & 15, kc = pos ^ (krow & 15);
        koff[i] = (unsigned)(krow * KVPITCH * 2 + kc * 16); }
#pragma unroll
    for (int j = 0; j < 2; ++j) { const int sg = 2 * (wid + 8 * j) + (lane >> 5), kb = sg >> 2, cg = sg & 3, vrow = kb * 8 + ((lane & 31) >> 2), vcol = cg * 32 + (lane & 3) * 8;
        voff[j] = (unsigned)(vrow * KVPITCH * 2 + (VOFF + vcol) * 2); }
#define ATT_DMA_K(t, kbuf) do { const char* tb_ = kvh + (size_t)(t) * 64 * KVPITCH * 2; \
        _Pragma("unroll") for (int i_ = 0; i_ < 2; ++i_) __builtin_amdgcn_global_load_lds((const unsigned*)(tb_ + koff[i_]), (ATT_LAS unsigned*)(lds + (kbuf) + 1024 * (wid + 8 * i_)), 16, 0, 0); } while (0)
#define ATT_DMA_V(t, vbuf) do { const char* tb_ = kvh + (size_t)(t) * 64 * KVPITCH * 2; \
        _Pragma("unroll") for (int j_ = 0; j_ < 2; ++j_) __builtin_amdgcn_global_load_lds((const unsigned*)(tb_ + voff[j_]), (ATT_LAS unsigned*)(lds + (vbuf) + 1024 * (wid + 8 * j_)), 16, 0, 0); } while (0)
    asm volatile("s_waitcnt lgkmcnt(0)\n\ts_barrier" ::: "memory");
    ATT_DMA_K(0, 0); ATT_DMA_K(1, KT_BYTES); ATT_DMA_V(0, 4 * KT_BYTES);
    i32x4 qf[6];
    { const size_t trow = row0 + q0 + 32 * wid + c;
      const unsigned char* qp = (const unsigned char*)Q + trow * QPITCH + h * HQK + 16 * hi;
      float qr[6][16];
#pragma unroll
      for (int s = 0; s < 6; ++s) { const i32x4 w = *(const i32x4*)(qp + 32 * s);
#pragma unroll
          for (int e = 0; e < 16; ++e) qr[s][e] = (float)((w[e >> 2] << (24 - 8 * (e & 3))) >> 24); }
      float ss = 0.f;
#pragma unroll
      for (int s = 0; s < 6; ++s)
#pragma unroll
          for (int e = 0; e < 16; ++e) { const float v = qr[s][e]; ss += v * v; }
      ss = xhalf_sum(ss);
      const float rs = (1.0f / sqrtf(ss * (1.0f / 192.f) + 1e-6f * 256.f)) * QK8;
#pragma unroll
      for (int s = 0; s < 4; ++s) { float v[16];
#pragma unroll
          for (int q4 = 0; q4 < 4; ++q4) { const f32x4v g = *(const f32x4v*)(qn + 32 * s + 16 * hi + 4 * q4);
#pragma unroll
              for (int e = 0; e < 4; ++e) v[4 * q4 + e] = qr[s][4 * q4 + e] * rs * g[e]; }
          qf[s] = pack16q(v); }
      const float* csr = CS + trow * 64 + 16 * hi;
      { float o1[16], o2[16];
#pragma unroll
        for (int q4 = 0; q4 < 4; ++q4) { const f32x4v ga = *(const f32x4v*)(qn + 128 + 16 * hi + 4 * q4), gb = *(const f32x4v*)(qn + 160 + 16 * hi + 4 * q4);
            const f32x4v cc = *(const f32x4v*)(csr + 4 * q4), sn = *(const f32x4v*)(csr + 32 + 4 * q4);
#pragma unroll
            for (int e = 0; e < 4; ++e) { const int idx = 4 * q4 + e; const float n1 = qr[4][idx] * rs * ga[e], n2 = qr[5][idx] * rs * gb[e];
                o1[idx] = n1 * cc[e] - n2 * sn[e]; o2[idx] = n2 * cc[e] + n1 * sn[e]; } }
        qf[4] = pack16q(o1); qf[5] = pack16q(o2); } }
    unsigned ko[6];
#pragma unroll
    for (int s = 0; s < 6; ++s) ko[s] = (unsigned)(c * 256 + 16 * ((2 * s + hi) ^ (c & 15)));
    const unsigned vbase = (unsigned)(hi * 256 + ((lane >> 2) & 3) * 64 + ((lane >> 4) & 1) * 32 + (lane & 3) * 8);
    f32x16 o[4];
#pragma unroll
    for (int d = 0; d < 4; ++d)
#pragma unroll
        for (int r = 0; r < 16; ++r) o[d][r] = 0.f;
    float l_run = 0.f;
    constexpr float CSC = 0.07216878364870322f * 1.4426950408889634f / (QK8 * QK8);
#define ATT_QKH(A, koff_) do { ATT_LAS const unsigned char* kp = lds + (koff_); \
            { const i32x16 z = {0, 0, 0, 0, 0, 0, 0, 0, 0, 0, 0, 0, 0, 0, 0, 0}; const i32x4 k0 = *(ATT_LAS const i32x4*)(kp + ko[0]); A = __builtin_amdgcn_mfma_i32_32x32x32_i8(k0, qf[0], z, 0, 0, 0); } \
            _Pragma("unroll") for (int s = 1; s < 6; ++s) { const i32x4 k0 = *(ATT_LAS const i32x4*)(kp + ko[s]); A = __builtin_amdgcn_mfma_i32_32x32x32_i8(k0, qf[s], A, 0, 0, 0); } } while (0)
#define ATT_EXPH(A, P0, P1) do { float pe[16]; \
            _Pragma("unroll") for (int r = 0; r < 16; ++r) pe[r] = __builtin_amdgcn_exp2f((float)A[r] * CSC); \
            { u32x4 w = {cvtpk(pe[0], pe[1]), cvtpk(pe[2], pe[3]), cvtpk(pe[4], pe[5]), cvtpk(pe[6], pe[7])}; P0 = __builtin_bit_cast(bf16x8, w); } \
            { u32x4 w = {cvtpk(pe[8], pe[9]), cvtpk(pe[10], pe[11]), cvtpk(pe[12], pe[13]), cvtpk(pe[14], pe[15])}; P1 = __builtin_bit_cast(bf16x8, w); } \
            float ps = 0.f; \
            _Pragma("unroll") for (int r = 0; r < 16; ++r) ps += pe[r]; \
            l_run += ps; } while (0)
#define ATT_PVH(P0, P1, voff_) do { ATT_LAS const unsigned char* vp = lds + (voff_) + vbase; \
            _Pragma("unroll") for (int d = 0; d < 4; ++d) { \
                    const s16x4 lo = vtr(vp + d * 512), hh = vtr(vp + 2048 + d * 512); \
                    const bf16x8 a = {lo[0], lo[1], lo[2], lo[3], hh[0], hh[1], hh[2], hh[3]}; \
                    o[d] = __builtin_amdgcn_mfma_f32_32x32x16_bf16(a, P0, o[d], 0, 0, 0); } \
            _Pragma("unroll") for (int d = 0; d < 4; ++d) { \
                    const s16x4 lo = vtr(vp + 4096 + d * 512), hh = vtr(vp + 4096 + 2048 + d * 512); \
                    const bf16x8 a = {lo[0], lo[1], lo[2], lo[3], hh[0], hh[1], hh[2], hh[3]}; \
                    o[d] = __builtin_amdgcn_mfma_f32_32x32x16_bf16(a, P1, o[d], 0, 0, 0); } } while (0)
#define ATT_VF(j_) ({ const int d_ = (j_) & 3, h_ = (j_) >> 2; const s16x4 lo_ = vtr(vp_s + h_ * 4096 + d_ * 512), hh_ = vtr(vp_s + h_ * 4096 + 2048 + d_ * 512); \
        bf16x8 a_ = {lo_[0], lo_[1], lo_[2], lo_[3], hh_[0], hh_[1], hh_[2], hh_[3]}; a_; })
#define ATT_PV1(j_, vf_, P0, P1) o[(j_) & 3] = __builtin_amdgcn_mfma_f32_32x32x16_bf16(vf_, ((j_) < 4 ? P0 : P1), o[(j_) & 3], 0, 0, 0)
#define ATT_E(r_) pe[r_] = __builtin_amdgcn_exp2f((float)Ain_[r_] * CSC)
#define ATT_HALF(A, koff_, P0, P1, voff_, AinV, Pout0, Pout1) do { \
        ATT_LAS const unsigned char* kp_s = lds + (koff_); ATT_LAS const unsigned char* vp_s = lds + (voff_) + vbase; const i32x16 Ain_ = AinV; float pe[16]; \
        i32x4 kf = *(ATT_LAS const i32x4*)(kp_s + ko[0]); bf16x8 va_ = ATT_VF(0), vb_ = ATT_VF(1); \
        __builtin_amdgcn_sched_barrier(0); \
        { const i32x16 z = {0, 0, 0, 0, 0, 0, 0, 0, 0, 0, 0, 0, 0, 0, 0, 0}; A = __builtin_amdgcn_mfma_i32_32x32x32_i8(kf, qf[0], z, 0, 0, 0); } asm volatile("" : "+v"(A)); ATT_PV1(0, va_, P0, P1); ATT_PV1(1, vb_, P0, P1); \
        kf = *(ATT_LAS const i32x4*)(kp_s + ko[1]); va_ = ATT_VF(2); ATT_E(0); ATT_E(1); ATT_E(2); \
        __builtin_amdgcn_sched_barrier(0); \
        A = __builtin_amdgcn_mfma_i32_32x32x32_i8(kf, qf[1], A, 0, 0, 0); asm volatile("" : "+v"(A)); ATT_PV1(2, va_, P0, P1); \
        kf = *(ATT_LAS const i32x4*)(kp_s + ko[2]); va_ = ATT_VF(3); ATT_E(3); ATT_E(4); ATT_E(5); \
        __builtin_amdgcn_sched_barrier(0); \
        A = __builtin_amdgcn_mfma_i32_32x32x32_i8(kf, qf[2], A, 0, 0, 0); asm volatile("" : "+v"(A)); ATT_PV1(3, va_, P0, P1); \
        kf = *(ATT_LAS const i32x4*)(kp_s + ko[3]); va_ = ATT_VF(4); vb_ = ATT_VF(5); ATT_E(6); ATT_E(7); \
        { u32x4 w = {cvtpk(pe[0], pe[1]), cvtpk(pe[2], pe[3]), cvtpk(pe[4], pe[5]), cvtpk(pe[6], pe[7])}; Pout0 = __builtin_bit_cast(bf16x8, w); } \
        __builtin_amdgcn_sched_barrier(0); \
        A = __builtin_amdgcn_mfma_i32_32x32x32_i8(kf, qf[3], A, 0, 0, 0); asm volatile("" : "+v"(A)); ATT_PV1(4, va_, P0, P1); ATT_PV1(5, vb_, P0, P1); \
        kf = *(ATT_LAS const i32x4*)(kp_s + ko[4]); va_ = ATT_VF(6); ATT_E(8); ATT_E(9); ATT_E(10); \
        __builtin_amdgcn_sched_barrier(0); \
        A = __builtin_amdgcn_mfma_i32_32x32x32_i8(kf, qf[4], A, 0, 0, 0); asm volatile("" : "+v"(A)); ATT_PV1(6, va_, P0, P1); \
        kf = *(ATT_LAS const i32x4*)(kp_s + ko[5]); va_ = ATT_VF(7); ATT_E(11); ATT_E(12); ATT_E(13); \
        __builtin_amdgcn_sched_barrier(0); \
        A = __builtin_amdgcn_mfma_i32_32x32x32_i8(kf, qf[5], A, 0, 0, 0); asm volatile("" : "+v"(A)); ATT_PV1(7, va_, P0, P1); \
        ATT_E(14); ATT_E(15); \
        { u32x4 w = {cvtpk(pe[8], pe[9]), cvtpk(pe[10], pe[11]), cvtpk(pe[12], pe[13]), cvtpk(pe[14], pe[15])}; Pout1 = __builtin_bit_cast(bf16x8, w); } \
        { float ps = 0.f; _Pragma("unroll") for (int r = 0; r < 16; ++r) ps += pe[r]; l_run += ps; } \
        __builtin_amdgcn_sched_barrier(0); } while (0)
    { i32x16 aX, aY; bf16x8 pX0, pX1, pY0, pY1;
      for (int t = -1; t <= NT; ++t) {
          if (t + 2 < NT) asm volatile("s_waitcnt vmcnt(4) lgkmcnt(0)\n\ts_barrier" ::: "memory");
          else if (t + 1 < NT) asm volatile("s_waitcnt vmcnt(2) lgkmcnt(0)\n\ts_barrier" ::: "memory");
          else asm volatile("s_waitcnt vmcnt(0) lgkmcnt(0)\n\ts_barrier" ::: "memory");
          if (t + 3 < NT) ATT_DMA_K(t + 3, ((t + 3) & 3) * KT_BYTES);
          if (t + 2 < NT) ATT_DMA_V(t + 2, 4 * KT_BYTES + ((t + 2) & 3) * VT_BYTES);
          const int kc = (t & 3) * KT_BYTES + 32 * 256, kn = ((t + 1) & 3) * KT_BYTES;
          const int vp_ = 4 * KT_BYTES + ((t - 1) & 3) * VT_BYTES + 2 * 4096, vc = 4 * KT_BYTES + (t & 3) * VT_BYTES;
          const bool act = (t >= 0 && t < my_nt), v0 = (t >= 1 && t <= my_nt), q1 = (t + 1 < my_nt);
          if (act && v0 && q1) {
              ATT_HALF(aY, kc, pY0, pY1, vp_, aX, pX0, pX1);
              ATT_HALF(aX, kn, pX0, pX1, vc, aY, pY0, pY1);
          } else {
              if (act) ATT_QKH(aY, kc);
              if (v0) ATT_PVH(pY0, pY1, vp_);
              if (act) ATT_EXPH(aX, pX0, pX1);
              __builtin_amdgcn_sched_barrier(0);
              if (q1) ATT_QKH(aX, kn);
              if (act) { ATT_PVH(pX0, pX1, vc); ATT_EXPH(aY, pY0, pY1); }
              __builtin_amdgcn_sched_barrier(0);
          }
      } }
#undef ATT_HALF
#undef ATT_E
#undef ATT_PV1
#undef ATT_VF
#undef ATT_PVH
#undef ATT_EXPH
#undef ATT_QKH
    l_run = xhalf_sum(l_run);
#undef ATT_STEP
#undef ATT_STAGES
#undef ATT_CHUNK
#undef ATT_QK1
    { const int spos = q0 + 32 * wid + c; const float sc = pg8::o_row_scale(spos) / l_run;
      unsigned char* op = (unsigned char*)O + (row0 + spos) * 2048 + h * HV;
#pragma unroll
      for (int d = 0; d < 4; ++d)
          { u32x4 w;
#pragma unroll
            for (int j = 0; j < 2; ++j) { const int g0 = j, g1 = j + 2;
              const unsigned w0 = pg8::q8x4(o[d][4 * g0] * sc, o[d][4 * g0 + 1] * sc, o[d][4 * g0 + 2] * sc, o[d][4 * g0 + 3] * sc);
              const unsigned w1 = pg8::q8x4(o[d][4 * g1] * sc, o[d][4 * g1 + 1] * sc, o[d][4 * g1 + 2] * sc, o[d][4 * g1 + 3] * sc);
              auto rr = __builtin_amdgcn_permlane32_swap(w0, w1, false, false);
              if (j == 0) { w.x = rr[0]; w.y = rr[1]; } else { w.z = rr[0]; w.w = rr[1]; } }
            *(u32x4*)(op + 32 * d + (hi ? 16 : 0)) = w; } }
#undef ATT_DMA_K
#undef ATT_DMA_V
}
__device__ __forceinline__ void attn_phase(ATT_LAS unsigned char* lds, const bf16_t* Q, const bf16_t* KV, bf16_t* O, const float* qn, const float* CS, unsigned* queues, int xcc) {
    ATT_LAS unsigned* tk = (ATT_LAS unsigned*)(lds + LDS_BYTES);
    for (int s = 0; s < 8; ++s) {
        const int qx = (xcc + s) & 7;
        for (;;) {
            if (threadIdx.x == 0) *tk = __hip_atomic_fetch_add(queues + 64 * qx, 1u, __ATOMIC_RELAXED, __HIP_MEMORY_SCOPE_AGENT);
            asm volatile("s_waitcnt vmcnt(0) lgkmcnt(0)\n\ts_barrier" ::: "memory");
            const unsigned pr = (unsigned)__builtin_amdgcn_readfirstlane((int)*tk);
            asm volatile("s_waitcnt lgkmcnt(0)\n\ts_barrier" ::: "memory");
            if (pr >= 128u) break;
            const int pair = qx * 128 + (int)pr, bh = pair >> 3, x = pair & 7, b = bh >> 4, h = bh & 15;
#pragma nounroll
            for (int u = 0; u < 2; ++u) attn_unit(lds, Q, KV, O, qn, CS, b, h, u ? x : 15 - x);
        }
    }
    asm volatile("s_waitcnt vmcnt(0) lgkmcnt(0)\n\ts_barrier" ::: "memory");
}
}
#ifndef MK_MULTI
#define MK_MULTI 0
#endif
constexpr int NWAVES = 8;
constexpr int T = 32768, DM = 2048, SEQ = 4096, NB = 8, NH = 16;
constexpr int NPHASE = 20;
constexpr float EPS = 1e-6f;
constexpr int PSLOTS = 81920;
constexpr size_t MiB = 1u << 20;
constexpr size_t WS_CTL = 0, CTL_ZERO_BYTES = 1 * MiB;
constexpr size_t WS_WIN = 1 * MiB;
constexpr size_t WS_WQ = 6 * MiB;
constexpr size_t WS_WKV = 9 * MiB;
constexpr size_t WS_WO = 13 * MiB;
constexpr size_t WS_PWIN = 21 * MiB;
constexpr size_t WS_WG = 29 * MiB;
constexpr size_t WS_PWO = 31 * MiB;
constexpr size_t WS_RW = 39 * MiB;
constexpr size_t WS_CS = 41 * MiB;
constexpr size_t WS_GUT = 50 * MiB;
constexpr size_t WS_DT = 562 * MiB;
constexpr size_t WS_XB0 = 818 * MiB;
constexpr size_t WS_LOG = 946 * MiB;
constexpr size_t WS_MISC = 956 * MiB;
constexpr size_t WS_U = 960 * MiB;
constexpr size_t WS_C = WS_U, WS_CQ = WS_U + 80 * MiB, WS_CKV = WS_U + 112 * MiB, WS_Q = WS_U + 144 * MiB, WS_KV = WS_U + 336 * MiB, WS_O = WS_U + 656 * MiB;
constexpr size_t WS_CQ8 = WS_U + 80 * MiB;
constexpr size_t WS_XQ = WS_U;
constexpr size_t WS_XS = WS_U, WS_H = WS_U + 320 * MiB, WS_Y = WS_U + 400 * MiB;
constexpr size_t WS_LOG1 = WS_U + 736 * MiB;
constexpr size_t WS_SSQC = WS_U + 746 * MiB;
constexpr size_t WS_UU = WS_U, WS_PM = WS_U + 128 * MiB, WS_Y2 = WS_U + 256 * MiB;
constexpr size_t WS_XB1 = WS_U + 784 * MiB;
constexpr size_t WS_SSQP = WS_XB1 + 128 * MiB;
constexpr size_t WS_WPT = WS_SSQP + 4 * MiB;
constexpr size_t WS_END = WS_WPT + 8 * MiB;
constexpr size_t MS_TOKE = 0;
constexpr size_t MS_TOKW = 256 * 1024;
constexpr size_t MS_SLOT = 512 * 1024;
constexpr size_t MS_BC = 768 * 1024;
constexpr size_t MS_TILE = 896 * 1024;
constexpr size_t MS_RSTD0 = 1024 * 1024;
constexpr size_t MS_RSTD2 = 1152 * 1024;
constexpr size_t MS_RSTOK = 1280 * 1024;
constexpr size_t MS_RSSLOT = 1408 * 1024;
constexpr size_t MS_STOK = 1792 * 1024;
constexpr int CW_BAR = 4096;
constexpr int LDS_TILE_OFF = 143360;
constexpr int CW_ATTQ = 8192;
constexpr int CW_CONVQ = 8192 + 1024;
constexpr int NCONV = 6;

#define GAS __attribute__((address_space(1)))
#define LAS __attribute__((address_space(3)))
typedef unsigned short bf16;
typedef unsigned v4u __attribute__((ext_vector_type(4)));
typedef unsigned v2u __attribute__((ext_vector_type(2)));
typedef float f32x4 __attribute__((ext_vector_type(4)));
#define RLX_AGENT __ATOMIC_RELAXED, __HIP_MEMORY_SCOPE_AGENT
__device__ __forceinline__ unsigned pk2(float lo, float hi) { return pg8::cvt_pk_bf16(lo, hi); }
__device__ __forceinline__ float bf_lo(unsigned w) { return __uint_as_float(w << 16); }
__device__ __forceinline__ float bf_hi(unsigned w) { return __uint_as_float(w & 0xffff0000u); }

#define XB_TMO      128
#define XB_XCNT(j)  (256  + 64 * (j))
#define XB_XSUB(j)  (1280 + 64 * (j))
#define XB_XGEN(j)  (2304 + 64 * (j))
#define XB_TOP      3328
#define XB_TOPGEN   3392
#define XCD_BAR_WORDS 3456
#define XB_SPIN_CAP (1u << 18)
__device__ __forceinline__ unsigned xb_ld(unsigned* p)              { return __hip_atomic_load(p, __ATOMIC_RELAXED, __HIP_MEMORY_SCOPE_AGENT); }
__device__ __forceinline__ unsigned xb_add(unsigned* p, unsigned v) { return __hip_atomic_fetch_add(p, v, __ATOMIC_RELAXED, __HIP_MEMORY_SCOPE_AGENT); }
__device__ __forceinline__ unsigned xb_xcc_id() { return (unsigned)__builtin_amdgcn_s_getreg((3 << 11) | 20) & 0xFu; }
#define XB_SPIN(cond, bar) do { unsigned _sp = 0; while (cond) { __builtin_amdgcn_s_sleep(1); \
    if ((++_sp & 255u) == 0u) { if (xb_ld(&(bar)[XB_TMO])) break; if (_sp > XB_SPIN_CAP) { atomicAdd(&(bar)[XB_TMO], 1u); break; } } } } while (0)
struct XcdBarrier { unsigned* bar; unsigned x; volatile LAS unsigned* st; };
__device__ __forceinline__ XcdBarrier xcd_barrier_post(unsigned* bar, volatile LAS unsigned* st) {
    XcdBarrier b; b.bar = bar; b.x = xb_xcc_id(); b.st = st;
    if (threadIdx.x == 0) (void)xb_add(&bar[XB_XCNT(b.x)], 1u);
    return b;
}
__device__ __forceinline__ void xcd_barrier_complete(unsigned* bar, unsigned x, unsigned& nloc, unsigned& nx) {
    const unsigned G = gridDim.x * gridDim.y * gridDim.z;
    unsigned sum, cnt, mine, sp = 0u;
    for (;;) {
        sum = 0u; cnt = 0u; mine = 0u;
#pragma unroll
        for (unsigned j = 0; j < 16; ++j) { const unsigned c = xb_ld(&bar[XB_XCNT(j)]); sum += c; cnt += (c > 0u) ? 1u : 0u; mine = (j == x) ? c : mine; }
        if (sum == G) break;
        __builtin_amdgcn_s_sleep(1);
        if ((++sp & 255u) == 0u) { if (xb_ld(&bar[XB_TMO])) break; if (sp > XB_SPIN_CAP) { atomicAdd(&bar[XB_TMO], 1u); break; } }
    }
    nloc = mine > 0u ? mine : 1u; nx = cnt > 0u ? cnt : 1u;
}
__device__ __forceinline__ void xcd_barrier(const XcdBarrier& b) {
    asm volatile("s_waitcnt vmcnt(0)" ::: "memory");
    __syncthreads();
    if (threadIdx.x == 0) {
        unsigned* bar = b.bar;
        __builtin_amdgcn_s_waitcnt(0);
        unsigned nloc = b.st[0], nx = b.st[1];
        if (nloc == 0u) { xcd_barrier_complete(bar, b.x, nloc, nx); b.st[0] = nloc; b.st[1] = nx; }
        const unsigned old = xb_add(&bar[XB_XSUB(b.x)], 1u);
        const unsigned gen = old / nloc;
        if (old + 1u == (gen + 1u) * nloc) {
            __builtin_amdgcn_fence(__ATOMIC_RELEASE, "agent");
            asm volatile("s_waitcnt vmcnt(0)" ::: "memory");
            const unsigned og = xb_add(&bar[XB_TOP], 1u);
            const unsigned tg = og / nx;
            if (og + 1u == (tg + 1u) * nx) xb_add(&bar[XB_TOPGEN], 1u);
            else XB_SPIN(xb_ld(&bar[XB_TOPGEN]) == tg, bar);
            __builtin_amdgcn_fence(__ATOMIC_ACQUIRE, "agent");
            xb_add(&bar[XB_XGEN(b.x)], 1u);
            asm volatile("s_waitcnt vmcnt(0)" ::: "memory");
        } else {
            XB_SPIN(xb_ld(&bar[XB_XGEN(b.x)]) == gen, bar);
            __builtin_amdgcn_fence(__ATOMIC_ACQUIRE, "agent");
            asm volatile("s_waitcnt vmcnt(0)" ::: "memory");
        }
    }
    __syncthreads();
}

__device__ __forceinline__ void ld8(const bf16* p, float (&v)[8]) { const v4u a = *(const v4u*)p;
    v[0] = bf_lo(a.x); v[1] = bf_hi(a.x); v[2] = bf_lo(a.y); v[3] = bf_hi(a.y); v[4] = bf_lo(a.z); v[5] = bf_hi(a.z); v[6] = bf_lo(a.w); v[7] = bf_hi(a.w); }
#define SWZ_XOR(k) (((k) << 10) | 0x1F)
__device__ __forceinline__ float wave_sum(float v) {
    v += __int_as_float(__builtin_amdgcn_ds_swizzle(__float_as_int(v), SWZ_XOR(1)));
    v += __int_as_float(__builtin_amdgcn_ds_swizzle(__float_as_int(v), SWZ_XOR(2)));
    v += __int_as_float(__builtin_amdgcn_ds_swizzle(__float_as_int(v), SWZ_XOR(4)));
    v += __int_as_float(__builtin_amdgcn_ds_swizzle(__float_as_int(v), SWZ_XOR(8)));
    v += __int_as_float(__builtin_amdgcn_ds_swizzle(__float_as_int(v), SWZ_XOR(16)));
    auto rr = __builtin_amdgcn_permlane32_swap(__float_as_uint(v), __float_as_uint(v), false, false);
    return __uint_as_float(rr[0]) + __uint_as_float(rr[1]);
}
struct Ctx { LAS unsigned char* lds; int tid, lane, wave, vcu, G, gw, NGW, bx; };
__device__ __forceinline__ Ctx make_ctx(LAS unsigned char* lds) {
    Ctx X; X.lds = lds;
    int tid = threadIdx.x, G = gridDim.x, bx = blockIdx.x; asm volatile("" : "+v"(tid)); asm volatile("" : "+s"(G), "+s"(bx));
    X.tid = tid; X.lane = tid & 63; X.wave = __builtin_amdgcn_readfirstlane(tid >> 6); X.G = G; X.bx = bx;
    X.vcu = (G % 8 == 0) ? (bx % 8) * (G / 8) + bx / 8 : bx;
    X.gw = X.vcu * NWAVES + X.wave; X.NGW = G * NWAVES;
    return X;
}

__device__ __forceinline__ void tr_item(const float* __restrict__ W, int N, bf16* __restrict__ WT, int ldk, int k0, int n0, int orow0, const float* __restrict__ kscale, int lane) {
    const int c = lane & 15, g = lane >> 4;
    const float* src = W + (size_t)(k0 + 8 * g) * N + n0 + 4 * c;
    f32x4 v[2][8];
#pragma unroll
    for (int hh = 0; hh < 2; ++hh)
#pragma unroll
        for (int j = 0; j < 8; ++j) v[hh][j] = *(const f32x4*)(src + (size_t)(32 * hh + j) * N);
    if (kscale) {
#pragma unroll
        for (int hh = 0; hh < 2; ++hh) { const f32x4 s0 = *(const f32x4*)(kscale + k0 + 32 * hh + 8 * g), s1 = *(const f32x4*)(kscale + k0 + 32 * hh + 8 * g + 4);
#pragma unroll
            for (int j = 0; j < 8; ++j) v[hh][j] = v[hh][j] * (j < 4 ? s0[j & 3] : s1[j & 3]); }
    }
#pragma unroll
    for (int hh = 0; hh < 2; ++hh)
#pragma unroll
        for (int jj = 0; jj < 4; ++jj) {
            v4u o; o.x = pk2(v[hh][0][jj], v[hh][1][jj]); o.y = pk2(v[hh][2][jj], v[hh][3][jj]); o.z = pk2(v[hh][4][jj], v[hh][5][jj]); o.w = pk2(v[hh][6][jj], v[hh][7][jj]);
            *(v4u*)(WT + (size_t)(orow0 + 4 * c + jj) * ldk + k0 + 32 * hh + 8 * g) = o;
        }
}
__device__ __forceinline__ float store_row_rstd(const f32x4 (&v)[8], bf16* __restrict__ orow, int lane) {
    float s = 0.f;
#pragma unroll
    for (int j = 0; j < 8; ++j) s += (v[j][0] * v[j][0] + v[j][1] * v[j][1]) + (v[j][2] * v[j][2] + v[j][3] * v[j][3]);
#pragma unroll
    for (int j = 0; j < 8; ++j) { v2u w; w.x = pk2(v[j][0], v[j][1]); w.y = pk2(v[j][2], v[j][3]); *(v2u*)(orow + 4 * lane + 256 * j) = w; }
    return 1.0f / sqrtf(wave_sum(s) * (1.0f / DM) + EPS);
}

struct Params {
    const float* in[23]; float* out; unsigned char* ws; int ph_lo, ph_hi;
};
typedef const __attribute__((address_space(4))) Params* KP;
__device__ __forceinline__ KP kargs() { KP k = (KP)__builtin_amdgcn_kernarg_segment_ptr(); asm volatile("" : "+s"(k)); return k; }

constexpr int MOE_ITEMS = 128 * 768, CONV_CHUNK = 8, CONV_TICKETS = MOE_ITEMS / CONV_CHUNK;
struct TrJob { const float* W; unsigned char* WT; int N, ldk, k0, n0, orow0; float scale; const float* ks; };
constexpr float QS_Q = 16.f;
constexpr float QS_Y = 32.f;
constexpr float QS_A = 16.f, QS_WGU = 1024.f, QS_H = 16.f, QS_WD = 512.f, QS_X = 16.f, QS_WIN = 1024.f, QS_C = 16.f, QS_WQK = 512.f;
__device__ __forceinline__ TrJob moe_job(KP p, int r) {
    unsigned char* GUT = (unsigned char*)(p->ws + WS_GUT); unsigned char* DT = (unsigned char*)(p->ws + WS_DT);
    const int le = r / 768, rr = r % 768, which = rr / 256, id = rr % 256; TrJob j;
    if (which < 2) { const int kb = id / 16, nb = id % 16, n0 = 32 * nb;
        j.W = p->in[20 + which] + (size_t)le * 2048 * 512; j.N = 512; j.WT = GUT + (size_t)le * 1024 * 2048; j.ldk = 2048; j.k0 = 128 * kb; j.n0 = n0; j.orow0 = 256 * (n0 >> 7) + (n0 & 127) + 128 * which; j.scale = QS_WGU; j.ks = nullptr;
    } else { const int kb = id / 64, nb = id % 64;
        j.W = p->in[22] + (size_t)le * 512 * 2048; j.N = 2048; j.WT = DT + (size_t)le * 2048 * 512; j.ldk = 512; j.k0 = 128 * kb; j.n0 = 32 * nb; j.orow0 = 32 * nb; j.scale = QS_WD; j.ks = nullptr; }
    return j;
}
__device__ __forceinline__ void tr_load(const TrJob& j, f32x4 (&v)[16], int lane) {
    const int c = lane & 7, g = lane >> 3; const float* src = j.W + (size_t)(j.k0 + 16 * g) * j.N + j.n0 + 4 * c;
#pragma unroll
    for (int q = 0; q < 16; ++q) v[q] = __builtin_nontemporal_load((const f32x4*)(src + (size_t)q * j.N));
}
__device__ __forceinline__ void tr_store(const TrJob& j, f32x4 (&v)[16], int lane) {
    const int c = lane & 7, g = lane >> 3;
    if (j.ks) {
#pragma unroll
        for (int q4 = 0; q4 < 4; ++q4) { const f32x4 s = *(const f32x4*)(j.ks + j.k0 + 16 * g + 4 * q4);
#pragma unroll
            for (int e = 0; e < 4; ++e) v[4 * q4 + e] = v[4 * q4 + e] * s[e]; } }
#pragma unroll
    for (int jj = 0; jj < 4; ++jj) {
        v4u o; o.x = pg8::q8x4(v[0][jj] * j.scale, v[1][jj] * j.scale, v[2][jj] * j.scale, v[3][jj] * j.scale); o.y = pg8::q8x4(v[4][jj] * j.scale, v[5][jj] * j.scale, v[6][jj] * j.scale, v[7][jj] * j.scale);
        o.z = pg8::q8x4(v[8][jj] * j.scale, v[9][jj] * j.scale, v[10][jj] * j.scale, v[11][jj] * j.scale); o.w = pg8::q8x4(v[12][jj] * j.scale, v[13][jj] * j.scale, v[14][jj] * j.scale, v[15][jj] * j.scale);
        *(v4u*)(j.WT + (size_t)(j.orow0 + 4 * c + jj) * j.ldk + j.k0 + 16 * g) = o;
    }
}
__device__ __forceinline__ void moe_convert_drain(KP p, unsigned* q, int lane) {
    for (;;) {
        unsigned t = 0u; if (lane == 0) t = __hip_atomic_fetch_add(q, 1u, RLX_AGENT);
        t = (unsigned)__builtin_amdgcn_readfirstlane((int)t);
        if (t >= (unsigned)CONV_TICKETS) break;
        for (int i = 0; i < CONV_CHUNK; i += 2) {
            const TrJob ja = moe_job(p, (int)t * CONV_CHUNK + i), jb = moe_job(p, (int)t * CONV_CHUNK + i + 1);
            f32x4 va[16], vb[16]; tr_load(ja, va, lane); tr_load(jb, vb, lane); tr_store(ja, va, lane); tr_store(jb, vb, lane); }
    }
}

__device__ __forceinline__ void phase_prologue(const Ctx& X, KP p) {
    unsigned char* ws = p->ws;
    bf16* WinT = (bf16*)(ws + WS_WIN); bf16* WqT = (bf16*)(ws + WS_WQ); bf16* WkvT = (bf16*)(ws + WS_WKV); bf16* WoT = (bf16*)(ws + WS_WO);
    bf16* PwinT = (bf16*)(ws + WS_PWIN); bf16* WgT = (bf16*)(ws + WS_WG); bf16* PwoT = (bf16*)(ws + WS_PWO); bf16* RW = (bf16*)(ws + WS_RW);
    float* CS = (float*)(ws + WS_CS); bf16* XB0 = (bf16*)(ws + WS_XB0); float* RSTD0 = (float*)(ws + WS_MISC + MS_RSTD0);
    constexpr int I_WIN = 16 * 34, I_WQ = 4 * 96, I_WKV = 4 * 128, I_SQ = 32 * 32, I_WG = 4 * 64;
    constexpr int NITEMS = I_WIN + I_WQ + I_WKV + 2 * I_SQ + I_WG;
    const int lane = X.lane;
#pragma clang loop unroll(disable)
    for (int it = X.gw; it < NITEMS; it += X.NGW) {
        int r = it;
        if (r < I_WIN) { const int kb = r / 34, nb = r % 34; TrJob j{p->in[3], (unsigned char*)WinT, 1088, 2048, 128 * kb, 32 * nb, 32 * nb, QS_WIN, p->in[2]}; f32x4 v[16]; tr_load(j, v, lane); tr_store(j, v, lane); continue; } r -= I_WIN;
        if (r < I_WQ) { const int kb = r / 96, nb = r % 96; TrJob j{p->in[6], (unsigned char*)WqT, 3072, 512, 128 * kb, 32 * nb, 32 * nb, QS_WQK, p->in[4]}; f32x4 v[16]; tr_load(j, v, lane); tr_store(j, v, lane); continue; } r -= I_WQ;
        if (r < I_WKV) { const int kb = r / 128, nb = r % 128; TrJob j{p->in[7], (unsigned char*)WkvT, 4096, 512, 128 * kb, 32 * nb, 32 * nb, QS_WQK, p->in[5]}; f32x4 v[16]; tr_load(j, v, lane); tr_store(j, v, lane); continue; } r -= I_WKV;
        if (r < I_SQ) { const int kb = r / 64, nb = r % 64; TrJob j{p->in[10], (unsigned char*)WoT, 2048, 2048, 128 * kb, 32 * nb, 32 * nb, QS_WIN, nullptr}; f32x4 v[16]; tr_load(j, v, lane); tr_store(j, v, lane); continue; } r -= I_SQ;
        if (r < I_SQ) { const int kb = r / 32, nb = r % 32; tr_item(p->in[14], 2048, PwoT, 2048, 64 * kb, 64 * nb, 64 * nb, nullptr, lane); continue; } r -= I_SQ;
        if (r < I_WG) { const int g = r / 64, q = r % 64, kb = q / 8, nb = q % 8; tr_item(p->in[12] + (size_t)g * 512 * 512, 512, WgT, 512, 64 * kb, 64 * nb, g * 512 + 64 * nb, nullptr, lane); }
    }
    const int gt = X.vcu * (NWAVES * 64) + X.tid, NGT = X.G * NWAVES * 64;
    for (int i = gt; i < 2048 * 2048 / 8; i += NGT) { const f32x4 a = *(const f32x4*)(p->in[11] + (size_t)i * 8), b = *(const f32x4*)(p->in[11] + (size_t)i * 8 + 4);
        v4u o; o.x = pk2(a[0], a[1]); o.y = pk2(a[2], a[3]); o.z = pk2(b[0], b[1]); o.w = pk2(b[2], b[3]); *(v4u*)(PwinT + (size_t)i * 8) = o; }
    for (int i = gt; i < 192 * 128; i += NGT) *(v4u*)((unsigned char*)WinT + (size_t)1088 * 2048 + (size_t)i * 16) = (v4u){0u, 0u, 0u, 0u};
    for (int i = gt; i < 2 * 256 * 256; i += NGT) {
        const int l = i >> 16, n = (i >> 8) & 255, k0 = (i & 255) * 8; float v[8];
#pragma unroll
        for (int j = 0; j < 8; ++j) v[j] = (n < 8 ? p->in[16][((size_t)l * 2048 + k0 + j) * 8 + n] : (n < 72 ? p->in[18][((size_t)l * 2048 + k0 + j) * 64 + (n - 8)] : 0.f)) * p->in[15][l * 2048 + k0 + j];
        v4u o; o.x = pk2(v[0], v[1]); o.y = pk2(v[2], v[3]); o.z = pk2(v[4], v[5]); o.w = pk2(v[6], v[7]);
        *(v4u*)(RW + ((size_t)l * 256 + n) * 2048 + k0) = o;
    }
    { const int* pos = (const int*)p->in[1];
      for (int i = gt; i < T * 32; i += NGT) { const int t = i >> 5, j = i & 31;
          const float inv_freq = __builtin_amdgcn_exp2f(-(float)j * 0.41524101186092029f);
          const float ang = (float)pos[t] * inv_freq;
          double rev = (double)ang * 0.15915494309189535; rev -= rint(rev);
          const float xr = (float)rev;
          CS[(size_t)t * 64 + j] = __builtin_amdgcn_cosf(xr); CS[(size_t)t * 64 + 32 + j] = __builtin_amdgcn_sinf(xr); } }
#pragma clang loop unroll(disable)
    for (int m = X.gw; m < T; m += X.NGW) { const float* xr = p->in[0] + (size_t)m * DM; f32x4 v[8];
#pragma unroll
        for (int j = 0; j < 8; ++j) v[j] = *(const f32x4*)(xr + 4 * lane + 256 * j);
        const float rs = store_row_rstd(v, XB0 + (size_t)m * DM, lane);
        if (lane == 0) RSTD0[m] = rs;
        unsigned char* xq0 = (unsigned char*)(p->ws + WS_XB1) + (size_t)m * DM;
#pragma unroll
        for (int j = 0; j < 8; ++j) *(unsigned*)(xq0 + 4 * lane + 256 * j) = pg8::q8x4(v[j][0] * QS_X, v[j][1] * QS_X, v[j][2] * QS_X, v[j][3] * QS_X); }
}

__device__ __forceinline__ void phase_latent(const Ctx& X, KP p) {
    const bf16* C = (const bf16*)(p->ws + WS_C); bf16* CQ = (bf16*)(p->ws + WS_CQ); bf16* CKV = (bf16*)(p->ws + WS_CKV);
    const int lane = X.lane;
#pragma clang loop unroll(disable)
    for (int t = X.gw; t < T; t += X.NGW) {
        const v4u a = *(const v4u*)(C + (size_t)t * 1280 + 8 * lane), b = *(const v4u*)(C + (size_t)t * 1280 + 512 + 8 * lane);
        float xa[8] = {bf_lo(a.x), bf_hi(a.x), bf_lo(a.y), bf_hi(a.y), bf_lo(a.z), bf_hi(a.z), bf_lo(a.w), bf_hi(a.w)};
        float xb[8] = {bf_lo(b.x), bf_hi(b.x), bf_lo(b.y), bf_hi(b.y), bf_lo(b.z), bf_hi(b.z), bf_lo(b.w), bf_hi(b.w)};
        float sa = 0.f, sb = 0.f;
#pragma unroll
        for (int j = 0; j < 8; ++j) { sa += xa[j] * xa[j]; sb += xb[j] * xb[j]; }
        const float ra = 1.0f / sqrtf(wave_sum(sa) * (1.0f / 512.f) + EPS), rb = 1.0f / sqrtf(wave_sum(sb) * (1.0f / 512.f) + EPS);
        const f32x4 ga0 = *(const f32x4*)(p->in[4] + 8 * lane), ga1 = *(const f32x4*)(p->in[4] + 8 * lane + 4);
        const f32x4 gb0 = *(const f32x4*)(p->in[5] + 8 * lane), gb1 = *(const f32x4*)(p->in[5] + 8 * lane + 4);
        v4u oa, ob;
        oa.x = pk2(xa[0] * ra * ga0[0], xa[1] * ra * ga0[1]); oa.y = pk2(xa[2] * ra * ga0[2], xa[3] * ra * ga0[3]); oa.z = pk2(xa[4] * ra * ga1[0], xa[5] * ra * ga1[1]); oa.w = pk2(xa[6] * ra * ga1[2], xa[7] * ra * ga1[3]);
        ob.x = pk2(xb[0] * rb * gb0[0], xb[1] * rb * gb0[1]); ob.y = pk2(xb[2] * rb * gb0[2], xb[3] * rb * gb0[3]); ob.z = pk2(xb[4] * rb * gb1[0], xb[5] * rb * gb1[1]); ob.w = pk2(xb[6] * rb * gb1[2], xb[7] * rb * gb1[3]);
        *(v4u*)(CQ + (size_t)t * 512 + 8 * lane) = oa; *(v4u*)(CKV + (size_t)t * 512 + 8 * lane) = ob;
    }
}

__device__ __forceinline__ void phase_knorm(const Ctx& X, KP p) {
    bf16* KV = (bf16*)(p->ws + WS_KV); const bf16* C = (const bf16*)(p->ws + WS_C); const float* CS = (const float*)(p->ws + WS_CS); const float* gain = p->in[9];
    const int lane = X.lane, hd = lane >> 2, q = lane & 3;
    float gk[32], g1[8], g2[8];
#pragma unroll
    for (int i = 0; i < 32; ++i) gk[i] = gain[32 * q + i];
#pragma unroll
    for (int i = 0; i < 8; ++i) { g1[i] = gain[128 + 8 * q + i]; g2[i] = gain[160 + 8 * q + i]; }
#pragma clang loop unroll(disable)
    for (int t = X.gw; t < T; t += X.NGW) {
        bf16* kp = KV + (size_t)t * 5120 + hd * 320 + 32 * q;
        float kx[32], r1[8], r2[8];
#pragma unroll
        for (int i = 0; i < 4; ++i) { float v[8]; ld8(kp + 8 * i, v);
#pragma unroll
            for (int e = 0; e < 8; ++e) kx[8 * i + e] = v[e]; }
        ld8(C + (size_t)t * 1280 + 1024 + 8 * q, r1); ld8(C + (size_t)t * 1280 + 1056 + 8 * q, r2);
        float ss = 0.f;
#pragma unroll
        for (int i = 0; i < 32; ++i) ss += kx[i] * kx[i];
#pragma unroll
        for (int i = 0; i < 8; ++i) ss += r1[i] * r1[i] + r2[i] * r2[i];
        ss += __int_as_float(__builtin_amdgcn_ds_swizzle(__float_as_int(ss), SWZ_XOR(1))); ss += __int_as_float(__builtin_amdgcn_ds_swizzle(__float_as_int(ss), SWZ_XOR(2)));
        const float rstd = 1.0f / sqrtf(ss * (1.0f / 192.f) + EPS);
#pragma unroll
        for (int i = 0; i < 4; ++i) { v4u w;
            w.x = pk2(kx[8 * i] * rstd * gk[8 * i], kx[8 * i + 1] * rstd * gk[8 * i + 1]); w.y = pk2(kx[8 * i + 2] * rstd * gk[8 * i + 2], kx[8 * i + 3] * rstd * gk[8 * i + 3]);
            w.z = pk2(kx[8 * i + 4] * rstd * gk[8 * i + 4], kx[8 * i + 5] * rstd * gk[8 * i + 5]); w.w = pk2(kx[8 * i + 6] * rstd * gk[8 * i + 6], kx[8 * i + 7] * rstd * gk[8 * i + 7]);
            *(v4u*)(kp + 8 * i) = w; }
        const float* cs = CS + (size_t)t * 64 + 8 * q;
        const f32x4 c0 = *(const f32x4*)cs, c1 = *(const f32x4*)(cs + 4), s0 = *(const f32x4*)(cs + 32), s1 = *(const f32x4*)(cs + 36);
        float o1[8], o2[8];
#pragma unroll
        for (int e = 0; e < 8; ++e) { const float n1 = r1[e] * rstd * g1[e], n2 = r2[e] * rstd * g2[e], cc = e < 4 ? c0[e & 3] : c1[e & 3], sn = e < 4 ? s0[e & 3] : s1[e & 3];
            o1[e] = n1 * cc - n2 * sn; o2[e] = n2 * cc + n1 * sn; }
        v4u w1, w2; w1.x = pk2(o1[0], o1[1]); w1.y = pk2(o1[2], o1[3]); w1.z = pk2(o1[4], o1[5]); w1.w = pk2(o1[6], o1[7]);
        w2.x = pk2(o2[0], o2[1]); w2.y = pk2(o2[2], o2[3]); w2.z = pk2(o2[4], o2[5]); w2.w = pk2(o2[6], o2[7]);
        bf16* rp = KV + (size_t)t * 5120 + hd * 320 + 128 + 8 * q;
        *(v4u*)rp = w1; *(v4u*)(rp + 32) = w2;
    }
}

__device__ __forceinline__ unsigned dpp_x1(unsigned v) { return (unsigned)__builtin_amdgcn_mov_dpp((int)v, 0xB1, 0xF, 0xF, true); }
__device__ __forceinline__ unsigned dpp_x2(unsigned v) { return (unsigned)__builtin_amdgcn_mov_dpp((int)v, 0x4E, 0xF, 0xF, true); }
__device__ __forceinline__ void quad_tr(unsigned (&a)[4], int lane) {
    const bool o1 = lane & 1, o2 = lane & 2;
    unsigned b[4];
#pragma unroll
    for (int m = 0; m < 2; ++m) { const unsigned r = dpp_x1(o1 ? a[2 * m] : a[2 * m + 1]); b[2 * m] = o1 ? r : a[2 * m]; b[2 * m + 1] = o1 ? a[2 * m + 1] : r; }
#pragma unroll
    for (int j = 0; j < 2; ++j) { const unsigned r = dpp_x2(o2 ? b[j] : b[2 + j]); a[j] = o2 ? r : b[j]; a[2 + j] = o2 ? b[2 + j] : r; }
}
__device__ __forceinline__ void pair_tr(v2u& a0, v2u& a1, int lane) {
    const bool o1 = lane & 1; v2u s = o1 ? a0 : a1, r; r.x = dpp_x1(s.x); r.y = dpp_x1(s.y);
    if (o1) a0 = r; else a1 = r;
}
template <bool FINAL>
__device__ __forceinline__ void phase_combine(const Ctx& X, KP p, const bf16* __restrict__ xin, bf16* __restrict__ xout, float* __restrict__ rstd, float* __restrict__ outf) {
    const unsigned char* Y = (const unsigned char*)(p->ws + WS_Y); const int* SLOT = (const int*)(p->ws + WS_MISC + MS_SLOT); const float* TOKW = (const float*)(p->ws + WS_MISC + MS_TOKW);
    const int lane = X.lane;
    const int xo = 256 * (lane & 1) + 8 * (lane >> 1), yo = 256 * (lane & 3) + 16 * (lane >> 2);
#pragma clang loop unroll(disable)
    for (int m = X.gw; m < T; m += X.NGW) {
        const int s0 = (int)__hip_atomic_load((const unsigned*)SLOT + 2 * m, RLX_AGENT), s1 = (int)__hip_atomic_load((const unsigned*)SLOT + 2 * m + 1, RLX_AGENT);
        const float w0 = __uint_as_float(__hip_atomic_load((const unsigned*)TOKW + 2 * m, RLX_AGENT)), w1 = __uint_as_float(__hip_atomic_load((const unsigned*)TOKW + 2 * m + 1, RLX_AGENT));
        const bf16* xr = xin + (size_t)m * DM; const unsigned char* y0 = Y + (size_t)s0 * DM, * y1 = Y + (size_t)s1 * DM; f32x4 v[8];
        const float u0 = w0 * (1.0f / QS_Y), u1 = w1 * (1.0f / QS_Y);
        v4u xw[4], ya[2], yb[2];
#pragma unroll
        for (int g = 0; g < 4; ++g) xw[g] = *(const v4u*)(xr + 512 * g + xo);
#pragma unroll
        for (int g = 0; g < 2; ++g) { ya[g] = *(const v4u*)(y0 + 1024 * g + yo); yb[g] = *(const v4u*)(y1 + 1024 * g + yo); }
#pragma unroll
        for (int g = 0; g < 2; ++g) { unsigned a[4] = {ya[g].x, ya[g].y, ya[g].z, ya[g].w}, b[4] = {yb[g].x, yb[g].y, yb[g].z, yb[g].w}; quad_tr(a, lane); quad_tr(b, lane);
#pragma unroll
            for (int k = 0; k < 4; ++k) { const int j = 4 * g + k; v2u lo, hi; lo.x = xw[j >> 1].x; lo.y = xw[j >> 1].y; hi.x = xw[j >> 1].z; hi.y = xw[j >> 1].w;
                if ((k & 1) == 0) { pair_tr(lo, hi, lane); xw[j >> 1].x = lo.x; xw[j >> 1].y = lo.y; xw[j >> 1].z = hi.x; xw[j >> 1].w = hi.y; }
                v2u xv; xv.x = (k & 1) ? xw[j >> 1].z : xw[j >> 1].x; xv.y = (k & 1) ? xw[j >> 1].w : xw[j >> 1].y;
                const int aa = (int)a[k], bb = (int)b[k];
                f32x4 q;
                q[0] = bf_lo(xv.x) + (u0 * (float)((aa << 24) >> 24) + u1 * (float)((bb << 24) >> 24)); q[1] = bf_hi(xv.x) + (u0 * (float)((aa << 16) >> 24) + u1 * (float)((bb << 16) >> 24));
                q[2] = bf_lo(xv.y) + (u0 * (float)((aa << 8) >> 24) + u1 * (float)((bb << 8) >> 24)); q[3] = bf_hi(xv.y) + (u0 * (float)(aa >> 24) + u1 * (float)(bb >> 24));
                v[j] = q; if (FINAL) *(f32x4*)(outf + (size_t)m * DM + 4 * lane + 256 * j) = q; } }
        if (!FINAL) { const float rs = store_row_rstd(v, xout + (size_t)m * DM, lane); if (lane == 0) rstd[m] = rs; }
    }
}

__device__ __forceinline__ void phase_pool(const Ctx& X, KP p) {
    const bf16* U = (const bf16*)(p->ws + WS_UU); bf16* PM = (bf16*)(p->ws + WS_Y2); const float* scl = p->in[13];
    const int gt = X.vcu * (NWAVES * 64) + X.tid, NGT = X.G * NWAVES * 64;
#pragma clang loop unroll(disable)
    for (int task = gt; task < (T / 32) * 256; task += NGT) {
        const int run = task >> 8, cc = task & 255, col = cc * 8, w = 2 << (col >> 9);
        const int t0 = run * 32, s0 = t0 & (SEQ - 1);
        const f32x4 sc0 = *(const f32x4*)(scl + col), sc1 = *(const f32x4*)(scl + col + 4);
        float sum[8];
#pragma unroll
        for (int e = 0; e < 8; ++e) sum[e] = 0.f;
        { v4u wu[16];
#pragma unroll
          for (int j = 0; j < 16; ++j) { const int i = s0 - 1 - j; const bool ok = (j < w) && (i >= 0); wu[j] = *(const v4u*)(U + (size_t)(ok ? t0 - s0 + i : t0) * DM + col); }
#pragma unroll
          for (int j = 0; j < 16; ++j) { const int i = s0 - 1 - j; const bool ok = (j < w) && (i >= 0);
              if (ok) { sum[0] += bf_lo(wu[j].x); sum[1] += bf_hi(wu[j].x); sum[2] += bf_lo(wu[j].y); sum[3] += bf_hi(wu[j].y); sum[4] += bf_lo(wu[j].z); sum[5] += bf_hi(wu[j].z); sum[6] += bf_lo(wu[j].w); sum[7] += bf_hi(wu[j].w); } } }
#pragma clang loop unroll(disable)
        for (int kb = 0; kb < 32; kb += 8) {
            v4u cur[8], old_[8];
#pragma unroll
            for (int j = 0; j < 8; ++j) { const int t = t0 + kb + j, s = s0 + kb + j; cur[j] = *(const v4u*)(U + (size_t)t * DM + col);
                old_[j] = *(const v4u*)(U + (size_t)(s >= w ? t - w : t) * DM + col); }
#pragma unroll
            for (int j = 0; j < 8; ++j) { const int t = t0 + kb + j, s = s0 + kb + j; float v[8], o[8];
                v[0] = bf_lo(cur[j].x); v[1] = bf_hi(cur[j].x); v[2] = bf_lo(cur[j].y); v[3] = bf_hi(cur[j].y); v[4] = bf_lo(cur[j].z); v[5] = bf_hi(cur[j].z); v[6] = bf_lo(cur[j].w); v[7] = bf_hi(cur[j].w);
                o[0] = bf_lo(old_[j].x); o[1] = bf_hi(old_[j].x); o[2] = bf_lo(old_[j].y); o[3] = bf_hi(old_[j].y); o[4] = bf_lo(old_[j].z); o[5] = bf_hi(old_[j].z); o[6] = bf_lo(old_[j].w); o[7] = bf_hi(old_[j].w);
#pragma unroll
                for (int e = 0; e < 8; ++e) sum[e] += v[e];
                if (s >= w) {
#pragma unroll
                    for (int e = 0; e < 8; ++e) sum[e] -= o[e]; }
                const float ic = 1.0f / (float)(s + 1 < w ? s + 1 : w);
                v4u r; r.x = pk2((sum[0] * ic - v[0]) * sc0[0], (sum[1] * ic - v[1]) * sc0[1]); r.y = pk2((sum[2] * ic - v[2]) * sc0[2], (sum[3] * ic - v[3]) * sc0[3]);
                r.z = pk2((sum[4] * ic - v[4]) * sc1[0], (sum[5] * ic - v[5]) * sc1[1]); r.w = pk2((sum[6] * ic - v[6]) * sc1[2], (sum[7] * ic - v[7]) * sc1[3]);
                *(v4u*)(PM + (size_t)t * DM + col) = r; } }
    }
}

__device__ __forceinline__ void phase_route(const Ctx& X, KP p, int layer) {
    const float* LOG = (const float*)(p->ws + WS_LOG); const float* LOG1 = (const float*)(p->ws + WS_LOG1); unsigned* TOKE = (unsigned*)(p->ws + WS_MISC + MS_TOKE); float* TOKW = (float*)(p->ws + WS_MISC + MS_TOKW);
    unsigned* BC = (unsigned*)(p->ws + WS_MISC + MS_BC);
    const float* brg = p->in[17] + layer * 8; const float* bre = p->in[19] + layer * 64;
    const float* SSQP = (const float*)(p->ws + WS_SSQP); float* RSTOK = (float*)(p->ws + WS_MISC + MS_RSTOK);
    LAS unsigned* hist = (LAS unsigned*)X.lds;
    { int* STOK = (int*)(p->ws + WS_MISC + MS_STOK); for (int i = X.vcu * (NWAVES * 64) + X.tid; i < PSLOTS; i += X.G * NWAVES * 64) STOK[i] = 0; }
#pragma clang loop unroll(disable)
    for (int ch = X.vcu; ch < 256; ch += X.G) {
        if (X.tid < 64) hist[X.tid] = 0u;
        __syncthreads();
        if (X.tid < 128) {
            const int t = ch * 128 + X.tid; const float* lg = LOG + (size_t)t * 72; const float* lh = LOG1 + (size_t)t * 72;
            float ssq = 0.f;
#pragma unroll
            for (int j = 0; j < 8; ++j) { const f32x4 q = *(const f32x4*)(SSQP + (size_t)t * 32 + 4 * j); ssq += (q[0] + q[1]) + (q[2] + q[3]); }
            const float rstd = 1.0f / sqrtf(ssq * (1.0f / DM) + EPS);
            RSTOK[t] = rstd;
            float g[8]; int gs = 0; float gm;
#pragma unroll
            for (int j = 0; j < 8; ++j) g[j] = (lg[j] + lh[j]) * rstd + brg[j];
            gm = g[0];
#pragma unroll
            for (int j = 1; j < 8; ++j) if (g[j] > gm) { gm = g[j]; gs = j; }
            float den = 0.f;
#pragma unroll
            for (int j = 0; j < 8; ++j) den += expf(g[j] - gm);
            const float psel = 1.0f / den;
            float e[8];
#pragma unroll
            for (int j = 0; j < 8; ++j) e[j] = (lg[8 + gs * 8 + j] + lh[8 + gs * 8 + j]) * rstd + bre[gs * 8 + j];
            int i1 = 0; float m1 = e[0];
#pragma unroll
            for (int j = 1; j < 8; ++j) if (e[j] > m1) { m1 = e[j]; i1 = j; }
            int i2 = -1; float m2 = -3.0e38f;
#pragma unroll
            for (int j = 0; j < 8; ++j) if (j != i1 && e[j] > m2) { m2 = e[j]; i2 = j; }
            const float a2 = expf(m2 - m1), q1 = 1.0f / (1.0f + a2), q2 = a2 / (1.0f + a2);
            const unsigned e1 = (unsigned)(gs * 8 + i1), e2 = (unsigned)(gs * 8 + i2);
            const unsigned r1 = __hip_atomic_fetch_add(&hist[e1], 1u, __ATOMIC_RELAXED, __HIP_MEMORY_SCOPE_WORKGROUP), r2 = __hip_atomic_fetch_add(&hist[e2], 1u, __ATOMIC_RELAXED, __HIP_MEMORY_SCOPE_WORKGROUP);
            TOKE[t] = e1 | (e2 << 8) | (r1 << 16) | (r2 << 24);
            TOKW[2 * t] = psel * q1; TOKW[2 * t + 1] = psel * q2;
        }
        __syncthreads();
        if (X.tid < 64) BC[ch * 64 + X.tid] = hist[X.tid];
        __syncthreads();
    }
}
__device__ __forceinline__ void phase_slots(const Ctx& X, KP p) {
    const unsigned* TOKE = (const unsigned*)(p->ws + WS_MISC + MS_TOKE); int* SLOT = (int*)(p->ws + WS_MISC + MS_SLOT);
    const unsigned* BC = (const unsigned*)(p->ws + WS_MISC + MS_BC); int* TILE = (int*)(p->ws + WS_MISC + MS_TILE);
    const bf16* HN = (const bf16*)(p->ws + WS_XB1); bf16* XS = (bf16*)(p->ws + WS_XS);
    const float* RSTOK = (const float*)(p->ws + WS_MISC + MS_RSTOK); float* RSSLOT = (float*)(p->ws + WS_MISC + MS_RSSLOT); int* STOK = (int*)(p->ws + WS_MISC + MS_STOK);
    LAS unsigned* part = (LAS unsigned*)X.lds;
    LAS unsigned* pstart = part + 512;
    LAS unsigned* cbase = pstart + 64;
    LAS int* slots = (LAS int*)(cbase + 64);
    { const int e = X.tid & 63, g = X.tid >> 6; unsigned s = 0u;
#pragma unroll
      for (int i = 0; i < 32; ++i) s += BC[(32 * g + i) * 64 + e];
      part[g * 64 + e] = s; }
    __syncthreads();
    if (X.tid < 64) { const int e = X.tid; unsigned tot = 0u;
#pragma unroll
        for (int g = 0; g < 8; ++g) tot += part[g * 64 + e];
        const unsigned ntile = (tot + 255u) >> 8;
        cbase[e] = ntile;
        __builtin_amdgcn_fence(__ATOMIC_RELEASE, "workgroup"); __builtin_amdgcn_wave_barrier(); __builtin_amdgcn_fence(__ATOMIC_ACQUIRE, "workgroup");
        unsigned excl = 0u;
#pragma unroll
        for (int j = 0; j < 64; ++j) { const unsigned v = cbase[j]; excl += (j < e) ? v : 0u; }
        pstart[e] = excl << 8;
        { LAS int* LT = (LAS int*)(X.lds + LDS_TILE_OFF); for (unsigned k = 0; k < ntile; ++k) if (excl + k < 320u) LT[64 + excl + k] = e; if (e == 63) LT[0] = (int)(excl + ntile); }
        if (blockIdx.x == 0) { for (unsigned k = 0; k < ntile; ++k) TILE[64 + excl + k] = e; if (e == 63) TILE[0] = (int)(excl + ntile); } }
    __syncthreads();
#pragma clang loop unroll(disable)
    for (int ch = X.vcu; ch < 256; ch += X.G) {
        if (X.tid < 64) { const int e = X.tid, g = ch >> 5; unsigned s = 0u;
            for (int gg = 0; gg < g; ++gg) s += part[gg * 64 + e];
#pragma unroll
            for (int i = 0; i < 31; ++i) { const int c = 32 * g + i; const unsigned v = BC[(c < ch ? c : 32 * g) * 64 + e]; s += (c < ch) ? v : 0u; }
            cbase[e] = s; }
        __syncthreads();
        if (X.tid < 128) { const int t = ch * 128 + X.tid; const unsigned te = TOKE[t];
            const unsigned e1 = te & 255u, e2 = (te >> 8) & 255u, r1 = (te >> 16) & 255u, r2 = te >> 24;
            const int s1 = (int)(pstart[e1] + cbase[e1] + r1), s2 = (int)(pstart[e2] + cbase[e2] + r2);
            SLOT[2 * t] = s1; SLOT[2 * t + 1] = s2; slots[2 * X.tid] = s1; slots[2 * X.tid + 1] = s2;
            const float rs = RSTOK[t]; RSSLOT[s1] = rs; RSSLOT[s2] = rs; STOK[s1] = t; STOK[s2] = t; }
        __syncthreads();
        __syncthreads();
    }
}

struct MoeOrder {
    LAS const int* tile; int ntile, nN, G, c; size_t bstride;
    __device__ void init(LAS const int* tile_, int nN_, int G_, int c_, size_t bstride_) { tile = tile_; nN = nN_; G = G_; c = c_; bstride = bstride_;
        ntile = tile_[0]; ntile = ntile < 320 ? ntile : 320; }
    __device__ bool next(int i, pg8::Unit& u) const {
        const long L = (long)i * G + c; if (L >= (long)ntile * nN) return false;
        u.pm = (int)(L / nN); u.pn = (int)(L % nN); u.aux = tile[64 + u.pm] & 63; return true;
    }
    __device__ __forceinline__ const char* abase(const pg8::Gemm& g, const pg8::Unit& u) const { return (const char*)g.A + (size_t)u.pm * 256 * g.lda * 2; }
    __device__ __forceinline__ const char* bbase(const pg8::Gemm& g, const pg8::Unit& u) const { return (const char*)g.Bt + (size_t)u.aux * bstride + (size_t)u.pn * 256 * g.K * 2; }
};
struct RouterOrder {
    int G, c;
    __device__ bool next(int i, pg8::Unit& u) const { const int L = i * G + c; if (L >= 256) return false; u.pm = L >> 1; u.pn = 0; u.aux = L & 1; return true; }
    __device__ __forceinline__ const char* abase(const pg8::Gemm& g, const pg8::Unit& u) const { return (const char*)g.A + (size_t)u.pm * 256 * g.lda * 2 + (size_t)u.aux * g.K * 2; }
    __device__ __forceinline__ const char* bbase(const pg8::Gemm& g, const pg8::Unit& u) const { return (const char*)g.Bt + (size_t)u.aux * g.K * 2; }
};
struct ProdOrder {
    int bx, G;
    __device__ bool next(int i, pg8::Unit& u) const { const int c = (bx + G - (128 % G)) % G, L = i * G + c; if (L >= 64) return false; u.pm = L >> 3; u.pn = L & 7; u.aux = 0; return true; }
    __device__ __forceinline__ const char* abase(const pg8::Gemm& g, const pg8::Unit& u) const { return (const char*)g.A + (size_t)u.pm * 256 * g.lda * 2; }
    __device__ __forceinline__ const char* bbase(const pg8::Gemm& g, const pg8::Unit& u) const { return (const char*)g.Bt + (size_t)u.pn * 256 * g.ldb * 2 + (size_t)(u.pm >> 1) * 512 * 2; }
};
struct Col4Order {
    int bx, G;
    __device__ bool next(int i, pg8::Unit& u) const { const int L = i * G + bx; if (L >= 128) return false; u.pm = L; u.pn = 4; u.aux = 0; return true; }
    __device__ __forceinline__ const char* abase(const pg8::Gemm& g, const pg8::Unit& u) const { return (const char*)g.A + (size_t)u.pm * 256 * g.lda * 2; }
    __device__ __forceinline__ const char* bbase(const pg8::Gemm& g, const pg8::Unit& u) const { return (const char*)g.Bt + (size_t)u.pn * 256 * g.ldb * 2; }
};
struct GroupOrder {
    pg8::StaticOrder so;
    __device__ bool next(int i, pg8::Unit& u) const { return so.next(i, u); }
    __device__ __forceinline__ const char* abase(const pg8::Gemm& g, const pg8::Unit& u) const { return (const char*)g.A + (size_t)u.pm * 256 * g.lda * 2 + (size_t)(u.pn >> 1) * 512 * 2; }
    __device__ __forceinline__ const char* bbase(const pg8::Gemm& g, const pg8::Unit& u) const { return (const char*)g.Bt + (size_t)u.pn * 256 * g.K * 2; }
};

constexpr int RING_BYTES = 131072, MISC_OFF = RING_BYTES, LDS_BYTES = 147456;
__global__ void __launch_bounds__(NWAVES * 64, 2) mk_fwd(Params p_unused) {
    extern __shared__ __attribute__((aligned(16))) unsigned char lds_raw[];
    LAS unsigned char* const lds0 = (LAS unsigned char*)lds_raw;
    volatile LAS unsigned* MISC = (volatile LAS unsigned*)(lds0 + MISC_OFF);
    for (int u = threadIdx.x; u < (LDS_BYTES - MISC_OFF) / 4; u += NWAVES * 64) ((LAS unsigned*)(lds0 + MISC_OFF))[u] = 0u;
    __syncthreads();
    XcdBarrier bar; int lo, hi;
    { KP k = kargs(); lo = k->ph_lo; hi = k->ph_hi; unsigned* bw = (unsigned*)(k->ws + WS_CTL) + CW_BAR;
      bar.bar = bw; bar.x = 0; bar.st = nullptr;
      if (!MK_MULTI) bar = xcd_barrier_post(bw, MISC + 8); }
#define IN(k_) (lo <= (k_) && (k_) < hi)
#define SEAM(k_) do { if (IN(k_) && IN((k_) + 1)) xcd_barrier(bar); } while (0)
#define PH_BEGIN KP k = kargs(); const Ctx X = make_ctx(lds0); unsigned char* ws = k->ws; const int G = X.G, bx = X.bx, vcu = X.vcu; (void)ws; (void)G; (void)bx; (void)vcu;
#ifdef PROBE_ATT
#define PROBE_ATT_BODY xcd_barrier(bar); if (bx == 0 && threadIdx.x < 8) __hip_atomic_store(ctl + CW_ATTQ + 64 * threadIdx.x, 0u, __ATOMIC_RELAXED, __HIP_MEMORY_SCOPE_AGENT); xcd_barrier(bar); \
    att::attn_phase(X.lds, (const bf16*)(ws + WS_Q), (const bf16*)(ws + WS_KV), (bf16*)(ws + WS_O), k->in[8], (const float*)(ws + WS_CS), ctl + CW_ATTQ, (int)(xb_xcc_id() & 7u));
#else
#define PROBE_ATT_BODY
#endif
#ifndef PROBE_REP
#define PROBE_REP 0u
#endif
#define PHASE(k_, ...) do { if (IN(k_)) { { PH_BEGIN __VA_ARGS__ } if ((PROBE_REP >> (k_)) & 1u) { xcd_barrier(bar); { PH_BEGIN __VA_ARGS__ } } } } while (0)

    PHASE(0, phase_prologue(X, k);); SEAM(0);
    PHASE(1, pg8::Gemm g{(const bf16*)(ws + WS_XB1), (const bf16*)(ws + WS_WIN), 1024, 1024, 1024, nullptr}; pg8::StaticOrder S; S.init(T, 1024, G, bx);
        typedef pg8::EpiBf16<pg8::i32x4, false, true, false, true, true, true, 4> EC; EC E{(bf16*)(ws + WS_C), 1280, 256, 128, nullptr, (const float*)(ws + WS_MISC + MS_RSTD0), nullptr, 0, 20, (float*)(ws + WS_SSQC), 1.0f / (QS_X * QS_WIN), (unsigned char*)(ws + WS_CQ8), 1280, QS_C, 4}; pg8::gemm_phase<EC, pg8::StaticOrder, false, true>(X.lds, g, S, E);
        { Col4Order S4; S4.bx = bx; S4.G = G;
          typedef pg8::EpiBf16<pg8::i32x4, false, true, false, true, false, true, -1, true> EC4; EC4 E4{(bf16*)(ws + WS_C), 1280, 256, 128, nullptr, (const float*)(ws + WS_MISC + MS_RSTD0), nullptr, 0, 20, (float*)(ws + WS_SSQC), 1.0f / (QS_X * QS_WIN), nullptr, 0, 0.f, -1};
          pg8::gemm_phase<EC4, Col4Order, false, true>(X.lds, g, S4, E4); }
        { pg8::Gemm g2{(const bf16*)(ws + WS_WG), (const bf16*)(ws + WS_PWIN), 512, 512, 2048, nullptr}; ProdOrder S2; S2.bx = bx; S2.G = G;
          typedef pg8::EpiBf16<pg8::f32x4, true> EP; EP E2{(bf16*)(ws + WS_WPT), 2048, 256, 128, k->in[2] + 2048, nullptr, nullptr, 0, 0, nullptr, 1.f, nullptr, 0, 0.f, -1}; pg8::gemm_phase(X.lds, g2, S2, E2); }); SEAM(1);
    PHASE(2,
        { pg8::Gemm g{(const bf16*)(ws + WS_CQ8), (const bf16*)(ws + WS_WQ), 256, 640, 256, nullptr}; pg8::StaticOrder S; S.init(T, 3072, G, bx);
          typedef pg8::EpiBf16<pg8::i32x4, false, false, true, false, true, false> EQ; EQ E{(bf16*)(ws + WS_Q), 3072, 256, 128, nullptr, nullptr, (const float*)(ws + WS_SSQC), 0, 20, nullptr, 1.0f / (QS_C * QS_WQK), (unsigned char*)(ws + WS_Q), 3072, QS_Q, 9999}; pg8::gemm_phase<EQ, pg8::StaticOrder, false, true>(X.lds, g, S, E); }
        { if (threadIdx.x < 48) ((LAS f32x4*)(X.lds + pg8::STAGE_BYTES + 4096 + 6144))[threadIdx.x] = *(const f32x4*)(k->in[9] + 4 * threadIdx.x);
          __syncthreads();
          pg8::Gemm g{(const bf16*)(ws + WS_CQ8) + 256, (const bf16*)(ws + WS_WKV), 256, 640, 256, nullptr}; pg8::StaticOrder S; S.init(T, 4096, G, bx);
          pg8::EpiKV<pg8::i32x4> E{(bf16*)(ws + WS_KV), (const float*)(ws + WS_SSQC), (const bf16*)(ws + WS_C), (const float*)(ws + WS_CS), k->in[9], X.lds + pg8::STAGE_BYTES + 4096, 0, 1.0f / (QS_C * QS_WQK)}; pg8::gemm_phase<pg8::EpiKV<pg8::i32x4>, pg8::StaticOrder, false, true>(X.lds, g, S, E); }); SEAM(2);
    PHASE(3, unsigned* ctl = (unsigned*)(ws + WS_CTL);
        if ((vcu & 31) >= 32 - NCONV) moe_convert_drain(k, ctl + CW_CONVQ, X.lane);
        att::attn_phase(X.lds, (const bf16*)(ws + WS_Q), (const bf16*)(ws + WS_KV), (bf16*)(ws + WS_O), k->in[8], (const float*)(ws + WS_CS), ctl + CW_ATTQ, (int)(xb_xcc_id() & 7u));
        { int ln = threadIdx.x; asm volatile("" : "+v"(ln)); moe_convert_drain(k, ctl + CW_CONVQ, ln & 63); }
        PROBE_ATT_BODY); SEAM(3);
    PHASE(4, pg8::Gemm g{(const bf16*)(ws + WS_O), (const bf16*)(ws + WS_WO), 1024, 1024, 1024, nullptr}; pg8::StaticOrder S; S.init(T, 2048, G, bx);
        pg8::EpiResBf16<pg8::i32x4> E{(const bf16*)(ws + WS_XB0), (bf16*)(ws + WS_XB1), 2048, (float*)(ws + WS_SSQP), k->in[15], (unsigned char*)(ws + WS_XQ), QS_A, 1.0f / QS_WIN}; pg8::gemm_phase<pg8::EpiResBf16<pg8::i32x4>, pg8::StaticOrder, false, true>(X.lds, g, S, E);); SEAM(4);
#define MOE_BLOCK(mb, layer) \
    PHASE(mb, pg8::Gemm g{(const bf16*)(ws + WS_XB1), (const bf16*)(ws + WS_RW) + (size_t)(layer) * 256 * 2048, 1024, 2048, 2048, nullptr}; RouterOrder S; S.G = G; S.c = vcu; \
        pg8::EpiLogits E{(float*)(ws + WS_LOG), 72, 72, (size_t)(WS_LOG1 - WS_LOG) / 4}; pg8::gemm_phase(X.lds, g, S, E);); SEAM(mb); \
    PHASE(mb + 1, phase_route(X, k, layer);); SEAM(mb + 1); \
    PHASE(mb + 2, phase_slots(X, k);); SEAM(mb + 2); \
    PHASE(mb + 3, pg8::Gemm g{(const bf16*)(ws + WS_XQ), (const bf16*)(ws + WS_GUT) + (size_t)(layer) * 64 * 1024 * 1024, 1024, 1024, 1024, (const int*)(ws + WS_MISC + MS_STOK)}; \
        MoeOrder S; S.init((LAS const int*)(X.lds + LDS_TILE_OFF), 4, G, vcu, (size_t)1024 * 2048); \
        pg8::EpiSwiGLU8 E{(unsigned char*)(ws + WS_H), 512, (const float*)(ws + WS_MISC + MS_RSSLOT), 1.0f / (QS_A * QS_WGU), QS_H, (LAS const float*)(X.lds + pg8::STAGE_BYTES + 4096 + 1024), 0}; pg8::gemm_phase<pg8::EpiSwiGLU8, MoeOrder, true, true>(X.lds, g, S, E);); SEAM(mb + 3); \
    PHASE(mb + 4, pg8::Gemm g{(const bf16*)(ws + WS_H), (const bf16*)(ws + WS_DT) + (size_t)(layer) * 64 * 2048 * 256, 256, 256, 256, nullptr}; \
        MoeOrder S; S.init((LAS const int*)(X.lds + LDS_TILE_OFF), 8, G, vcu, (size_t)2048 * 512); \
        pg8::EpiY8 E{(unsigned char*)(ws + WS_Y), 2048, QS_Y / (QS_H * QS_WD)}; pg8::gemm_phase<pg8::EpiY8, MoeOrder, false, true>(X.lds, g, S, E);); SEAM(mb + 4);
    MOE_BLOCK(5, 0)
    PHASE(10, phase_combine<false>(X, k, (const bf16*)(ws + WS_XB1), (bf16*)(ws + WS_XB0), (float*)(ws + WS_MISC + MS_RSTD2), nullptr);); SEAM(10);
    PHASE(11, pg8::Gemm g{(const bf16*)(ws + WS_XB0), (const bf16*)(ws + WS_WPT), 2048, 2048, 2048, nullptr}; pg8::StaticOrder S; S.init(T, 2048, G, bx);
        typedef pg8::EpiBf16<pg8::f32x4, false, true> EU; EU E{(bf16*)(ws + WS_UU), 2048, 256, 128, nullptr, (const float*)(ws + WS_MISC + MS_RSTD2), nullptr, 0, 0, nullptr, 1.f, nullptr, 0, 0.f, -1}; pg8::gemm_phase(X.lds, g, S, E);); SEAM(11);
    PHASE(12, phase_pool(X, k);); SEAM(12);
    PHASE(13, pg8::Gemm g{(const bf16*)(ws + WS_Y2), (const bf16*)(ws + WS_PWO), 2048, 2048, 2048, nullptr}; pg8::StaticOrder S; S.init(T, 2048, G, bx);
        pg8::EpiResBf16<> E{(const bf16*)(ws + WS_XB0), (bf16*)(ws + WS_XB1), 2048, (float*)(ws + WS_SSQP), k->in[15] + 2048, (unsigned char*)(ws + WS_XQ), QS_A, 0.f}; pg8::gemm_phase(X.lds, g, S, E);); SEAM(13);
    MOE_BLOCK(14, 1)
    PHASE(19, phase_combine<true>(X, k, (const bf16*)(ws + WS_XB1), nullptr, nullptr, k->out););
#undef MOE_BLOCK
#undef IN
#undef SEAM
#undef PH_BEGIN
#undef PHASE
}

extern "C" void kernel_launch(void* const* d_in, const int* in_sizes, int n_in, void* d_out, int out_size, void* d_ws, size_t ws_size, hipStream_t stream) {
    static int grid = 0;
    if (grid == 0) {
        if (n_in != 23 || out_size != T * DM || ws_size < WS_END) { fprintf(stderr, "kernel_launch: unexpected shapes (n_in %d out %d ws %zu); nothing launched\n", n_in, out_size, ws_size); grid = -1; return; }
        int dev = 0, cus = 0, per_cu = 0;
        if (hipGetDevice(&dev) != hipSuccess || hipDeviceGetAttribute(&cus, hipDeviceAttributeMultiprocessorCount, dev) != hipSuccess) { grid = -1; return; }
        if (hipFuncSetAttribute((const void*)mk_fwd, hipFuncAttributeMaxDynamicSharedMemorySize, LDS_BYTES) != hipSuccess) { fprintf(stderr, "kernel_launch: hipFuncSetAttribute failed\n"); grid = -1; return; }
        if (hipOccupancyMaxActiveBlocksPerMultiprocessor(&per_cu, (const void*)mk_fwd, NWAVES * 64, LDS_BYTES) != hipSuccess || per_cu < 1) { fprintf(stderr, "kernel_launch: occupancy query reports %d blocks per CU\n", per_cu); }
        (void)hipGetLastError();
        grid = cus;
    }
    if (grid < 0) return;
    if (hipMemsetAsync((char*)d_ws + WS_CTL, 0, CTL_ZERO_BYTES, stream) != hipSuccess) return;
    Params p{};
    for (int i = 0; i < 23; ++i) p.in[i] = (const float*)d_in[i];
    p.out = (float*)d_out; p.ws = (unsigned char*)d_ws;
#if MK_MULTI
    for (int k = 0; k < NPHASE; ++k) { p.ph_lo = k; p.ph_hi = k + 1; hipLaunchKernelGGL(mk_fwd, dim3(grid), dim3(NWAVES * 64), LDS_BYTES, stream, p); }
#else
    p.ph_lo = 0; p.ph_hi = NPHASE;
    hipLaunchKernelGGL(mk_fwd, dim3(grid), dim3(NWAVES * 64), LDS_BYTES, stream, p);
#endif
}
```
